# Optimizing an MI355X kernel written in HIP

```python
import jax, jax.numpy as jnp
from jax import lax
import numpy as np

D_MODEL = 1024
BATCH = 1
SEQ = 16384
DEPTH = 1

CHUNK = 64
CONV_DIM = 512
CONV_WIDTH = 3
HGRN_HEADS = 4
HGRN_DK = 128
HGRN_DV = 128
HGRN_QK = HGRN_HEADS * HGRN_DK
HGRN_V = HGRN_HEADS * HGRN_DV
N_EXPERTS = 256
TOP_K = 8
N_GROUPS = 8
TOPK_GROUPS = 4
EXPERT_FF = 256
SHARED_FF = 256
ROUTED_SCALE = 2.5
MOE_BLOCK = 128
NORM_EPS = 1e-6
IN_SIZES = [CONV_DIM, CONV_DIM, CONV_DIM, HGRN_QK, HGRN_QK, HGRN_V, HGRN_V, D_MODEL, D_MODEL]
IN_COLS = sum(IN_SIZES)

kernel_name = "hybrid_conv_hgrn2_moe_block"


def rmsnorm(x, w):
    xf = x.astype(jnp.float32)
    y = xf * lax.rsqrt(jnp.mean(xf * xf, axis=-1, keepdims=True) + NORM_EPS)
    return (y * w.astype(jnp.float32)).astype(x.dtype)


def hgrn2_recurrence(q, k, v, logf):
    B, S, H, DK = q.shape
    DV = v.shape[-1]
    NC = S // CHUNK

    def chunks(t):
        return t.astype(jnp.float32).reshape(B, NC, CHUNK, H, t.shape[-1]).transpose(1, 0, 3, 2, 4)

    causal = jnp.tril(jnp.ones((CHUNK, CHUNK), dtype=bool))[:, :, None]

    def step(state, inp):
        qc, kc, vc, gc = inp
        b = jnp.cumsum(gc, axis=2)
        diff = b[:, :, :, None, :] - b[:, :, None, :, :]
        decay = jnp.where(causal, jnp.exp(jnp.where(causal, diff, 0.0)), 0.0)
        attn = jnp.einsum('bhid,bhjd,bhijd->bhij', qc, kc, decay)
        o = (jnp.einsum('bhij,bhjv->bhiv', attn, vc)
             + jnp.einsum('bhid,bhdv->bhiv', qc * jnp.exp(b), state))
        b_last = b[:, :, -1:, :]
        state = (jnp.exp(b_last[:, :, 0, :])[..., None] * state
                 + jnp.einsum('bhjd,bhjv->bhdv', kc * jnp.exp(b_last - b), vc))
        return state, o

    s0 = jnp.zeros((B, H, DK, DV), jnp.float32)
    _, o = lax.scan(step, s0, (chunks(q), chunks(k), chunks(v), chunks(logf)))
    return o.transpose(1, 0, 3, 2, 4).reshape(B, S, H, DV)


def token_mixer(h, w_in, conv_w, w_conv_out, lb, hgrn_norm_w, w_hgrn_out, w_o):
    B, S, _ = h.shape
    proj = h @ w_in
    cb, cc, cx, q, f, i, g, ga, gb = jnp.split(proj, list(np.cumsum(IN_SIZES)[:-1]), axis=-1)
    u = cc * cx
    up = jnp.pad(u, ((0, 0), (CONV_WIDTH - 1, 0), (0, 0)))
    conv = sum(up[:, t:t + S, :] * conv_w[t] for t in range(CONV_WIDTH))
    y_a = (cb * conv) @ w_conv_out
    qh = jax.nn.silu(q).reshape(B, S, HGRN_HEADS, HGRN_DK)
    fg = lb + (1.0 - lb) * jax.nn.sigmoid(f.astype(jnp.float32))
    logf = jnp.log(fg).reshape(B, S, HGRN_HEADS, HGRN_DK)
    kh = (1.0 - fg).reshape(B, S, HGRN_HEADS, HGRN_DK)
    vh = i.reshape(B, S, HGRN_HEADS, HGRN_DV)
    o = hgrn2_recurrence(qh, kh, vh, logf)
    o = rmsnorm(o, hgrn_norm_w).reshape(B, S, HGRN_V).astype(h.dtype) * jax.nn.silu(g)
    y_b = o @ w_hgrn_out
    m = jax.nn.sigmoid(ga) * y_a + jax.nn.sigmoid(gb) * y_b
    return m @ w_o


def moe_ffn(h, w_router, router_bias, w_gate_e, w_up_e, w_down_e, w_gate_s, w_up_s, w_down_s):
    B, S, D = h.shape
    T = B * S
    hf = h.reshape(T, D)
    scores = jax.nn.sigmoid((hf @ w_router).astype(jnp.float32))
    sel = scores + router_bias.astype(jnp.float32)
    grp = sel.reshape(T, N_GROUPS, N_EXPERTS // N_GROUPS)
    gscore = jnp.sum(lax.top_k(grp, 2)[0], axis=-1)
    _, gidx = lax.top_k(gscore, TOPK_GROUPS)
    gmask = jnp.any(jax.nn.one_hot(gidx, N_GROUPS, dtype=jnp.bool_), axis=1)
    emask = jnp.repeat(gmask, N_EXPERTS // N_GROUPS, axis=-1)
    _, eidx = lax.top_k(jnp.where(emask, sel, -jnp.inf), TOP_K)
    wsel = jnp.take_along_axis(scores, eidx, axis=-1)
    wsel = wsel / (jnp.sum(wsel, axis=-1, keepdims=True) + 1e-20) * ROUTED_SCALE

    TK = T * TOP_K
    e_flat = eidx.reshape(TK)
    w_flat = wsel.reshape(TK)
    tok_flat = jnp.arange(TK, dtype=jnp.int32) // TOP_K
    order = jnp.argsort(e_flat)
    se = e_flat[order]
    counts = jnp.zeros((N_EXPERTS,), jnp.int32).at[e_flat].add(1)
    starts = jnp.cumsum(counts) - counts
    padded = (counts + MOE_BLOCK - 1) // MOE_BLOCK * MOE_BLOCK
    pad_ends = jnp.cumsum(padded)
    pad_starts = pad_ends - padded
    dest = pad_starts[se] + (jnp.arange(TK, dtype=jnp.int32) - starts[se])
    n_blocks = -(-TK // MOE_BLOCK) + N_EXPERTS
    P = n_blocks * MOE_BLOCK
    buf_tok = jnp.zeros((P,), jnp.int32).at[dest].set(tok_flat[order])
    buf_w = jnp.zeros((P,), jnp.float32).at[dest].set(w_flat[order])
    block_e = jnp.minimum(
        jnp.searchsorted(pad_ends, jnp.arange(n_blocks, dtype=jnp.int32) * MOE_BLOCK, side='right'),
        N_EXPERTS - 1).astype(jnp.int32)

    def block_step(out, inp):
        tok, wb, e = inp
        xb = hf[tok]
        yb = (jax.nn.silu(xb @ w_gate_e[e]) * (xb @ w_up_e[e])) @ w_down_e[e]
        return out.at[tok].add(yb.astype(jnp.float32) * wb[:, None]), None

    out0 = jnp.zeros((T, D), jnp.float32)
    routed, _ = lax.scan(block_step, out0,
                         (buf_tok.reshape(n_blocks, MOE_BLOCK), buf_w.reshape(n_blocks, MOE_BLOCK), block_e))
    shared = (jax.nn.silu(hf @ w_gate_s) * (hf @ w_up_s)) @ w_down_s
    return (routed + shared.astype(jnp.float32)).astype(h.dtype).reshape(B, S, D)


def setup_inputs(seed: int = 0) -> dict:
    key = jax.random.key(seed)
    ks = jax.random.split(key, 24)
    n = jax.random.normal
    D = D_MODEL
    f32 = jnp.float32
    return {
        "x": n(ks[0], (BATCH, SEQ, D), f32),
        "c": n(ks[1], (BATCH, D), f32),
        "w_ada": n(ks[2], (DEPTH, D, 6 * D), f32) * (0.5 * D ** -0.5),
        "b_ada": n(ks[3], (DEPTH, 6 * D), f32) * 0.01,
        "norm_pre_mix": 1.0 + 0.01 * n(ks[4], (DEPTH, D), f32),
        "norm_post_mix": 1.0 + 0.01 * n(ks[5], (DEPTH, D), f32),
        "w_in": n(ks[6], (DEPTH, D, IN_COLS), f32) * D ** -0.5,
        "conv_w": n(ks[7], (DEPTH, CONV_WIDTH, CONV_DIM), f32) * CONV_WIDTH ** -0.5,
        "w_conv_out": n(ks[8], (DEPTH, CONV_DIM, D), f32) * CONV_DIM ** -0.5,
        "hgrn_lower_bounds": n(ks[9], (DEPTH + 1, HGRN_QK), f32) * 0.1,
        "hgrn_norm_w": 1.0 + 0.01 * n(ks[10], (DEPTH, HGRN_DV), f32),
        "w_hgrn_out": n(ks[11], (DEPTH, HGRN_V, D), f32) * HGRN_V ** -0.5,
        "w_o": n(ks[12], (DEPTH, D, D), f32) * D ** -0.5,
        "norm_pre_ffn": 1.0 + 0.01 * n(ks[13], (DEPTH, D), f32),
        "norm_post_ffn": 1.0 + 0.01 * n(ks[14], (DEPTH, D), f32),
        "w_router": n(ks[15], (DEPTH, D, N_EXPERTS), f32) * D ** -0.5,
        "router_bias": n(ks[16], (DEPTH, N_EXPERTS), f32) * 0.01,
        "w_gate_e": n(ks[17], (DEPTH, N_EXPERTS, D, EXPERT_FF), f32) * D ** -0.5,
        "w_up_e": n(ks[18], (DEPTH, N_EXPERTS, D, EXPERT_FF), f32) * D ** -0.5,
        "w_down_e": n(ks[19], (DEPTH, N_EXPERTS, EXPERT_FF, D), f32) * EXPERT_FF ** -0.5,
        "w_gate_s": n(ks[20], (DEPTH, D, SHARED_FF), f32) * D ** -0.5,
        "w_up_s": n(ks[21], (DEPTH, D, SHARED_FF), f32) * D ** -0.5,
        "w_down_s": n(ks[22], (DEPTH, SHARED_FF, D), f32) * SHARED_FF ** -0.5,
    }


def reference(x, c, w_ada, b_ada, norm_pre_mix, norm_post_mix, w_in, conv_w, w_conv_out,
              hgrn_lower_bounds, hgrn_norm_w, w_hgrn_out, w_o, norm_pre_ffn, norm_post_ffn,
              w_router, router_bias, w_gate_e, w_up_e, w_down_e, w_gate_s, w_up_s, w_down_s):
    lb_all = jnp.cumsum(jax.nn.softmax(hgrn_lower_bounds.astype(jnp.float32), axis=0), axis=0)
    cs = jax.nn.silu(c)
    for l in range(DEPTH):
        mod = cs @ w_ada[l] + b_ada[l]
        sh1, sc1, g1, sh2, sc2, g2 = jnp.split(mod, 6, axis=-1)
        h = rmsnorm(x, norm_pre_mix[l]) * (1.0 + sc1[:, None, :]) + sh1[:, None, :]
        y = token_mixer(h, w_in[l], conv_w[l], w_conv_out[l], lb_all[l], hgrn_norm_w[l],
                        w_hgrn_out[l], w_o[l])
        x = x + g1[:, None, :] * rmsnorm(y, norm_post_mix[l])
        h = rmsnorm(x, norm_pre_ffn[l]) * (1.0 + sc2[:, None, :]) + sh2[:, None, :]
        y = moe_ffn(h, w_router[l], router_bias[l], w_gate_e[l], w_up_e[l], w_down_e[l],
                    w_gate_s[l], w_up_s[l], w_down_s[l])
        x = x + g2[:, None, :] * rmsnorm(y, norm_post_ffn[l])
    return x
```

```cpp
#include <hip/hip_runtime.h>
#include <stdint.h>
#include <string.h>
#include <stddef.h>

typedef unsigned short bf16_t;
#define DEV __device__ __forceinline__

constexpr int T = 16384, D = 1024, NIN = 5632, E = 256, FF = 256, TOPK = 8;
constexpr int OFF_CB = 0, OFF_CC = 512, OFF_CX = 1024, OFF_Q = 1536, OFF_F = 2048, OFF_I = 2560, OFF_G = 3072, OFF_GA = 3584, OFF_GB = 4608;
constexpr float EPS = 1e-6f;

DEV float bf2f(bf16_t v) { return __uint_as_float(((unsigned)v) << 16); }
DEV bf16_t f2bf(float f) { unsigned u = __float_as_uint(f); u += 0x7FFFu + ((u >> 16) & 1u); return (bf16_t)(u >> 16); }
DEV float sigmoidf_(float x) { return 1.f / (1.f + __expf(-x)); }
DEV float siluf_(float x) { return x / (1.f + __expf(-x)); }
DEV float wave_sum(float v) {
#pragma unroll
    for (int o = 32; o > 0; o >>= 1) v += __shfl_xor(v, o);
    return v;
}

struct WS {
    unsigned* ctrl;
    float* mod;
    bf16_t* h1;
    bf16_t* proj;
    float* o32;
    float* kcT;
    float* dec;
    bf16_t* ST;
    bf16_t* a1;
    bf16_t* ob;
    bf16_t* m;
    bf16_t* y;
    bf16_t* h2;
    float* logits;
    int* eidx;
    float* wsel;
    int* offs;
    int* items;
    int* lslot;
    float* lw;
    bf16_t* act;
    bf16_t* yslot;
    bf16_t* acts;
    bf16_t* shout;
};

struct AMapPlain { const bf16_t* A; int lda; int pad; DEV const bf16_t* operator()(int row) const { return A + (size_t)row * lda; } };
struct AMapGather {
    const bf16_t* A; int lda; const int* lslot; int base; int cnt;
    DEV const bf16_t* operator()(int row) const { int r = row < cnt ? row : cnt - 1; return A + (size_t)(lslot[base + r] >> 3) * lda; }
};
struct AMapClamp { const bf16_t* A; int lda; int cnt; DEV const bf16_t* operator()(int row) const { return A + (size_t)(row < cnt ? row : cnt - 1) * lda; } };
struct BMapPlain { const float* W; int ldb; int pad; DEV const float* operator()(int vb, int k) const { return W + (size_t)k * ldb + vb * 16; } };
struct BMapPair {
    const float* Wg; const float* Wu; int ldb; int pad;
    DEV const float* operator()(int vb, int k) const { return ((vb & 1) ? Wu : Wg) + (size_t)k * ldb + (vb >> 1) * 16; }
};
struct EpiStoreBf16 { bf16_t* C; int ldc; int pad; DEV void operator()(int r, int c, float v0, float v1) const { C[(size_t)r * ldc + c] = f2bf(v0); C[(size_t)r * ldc + c + 16] = f2bf(v1); } };
struct EpiStoreF32 { float* C; int ldc; int pad; DEV void operator()(int r, int c, float v0, float v1) const { C[(size_t)r * ldc + c] = v0; C[(size_t)r * ldc + c + 16] = v1; } };
struct EpiGateA {
    bf16_t* M; const bf16_t* proj;
    DEV void one(int r, int c, float v) const { M[(size_t)r * D + c] = f2bf(sigmoidf_(bf2f(proj[(size_t)r * NIN + OFF_GA + c])) * v); }
    DEV void operator()(int r, int c, float v0, float v1) const { one(r, c, v0); one(r, c + 16, v1); }
};
struct EpiGateB {
    bf16_t* M; const bf16_t* proj;
    DEV void one(int r, int c, float v) const { size_t i = (size_t)r * D + c; M[i] = f2bf(bf2f(M[i]) + sigmoidf_(bf2f(proj[(size_t)r * NIN + OFF_GB + c])) * v); }
    DEV void operator()(int r, int c, float v0, float v1) const { one(r, c, v0); one(r, c + 16, v1); }
};
struct EpiSwiGLU {
    bf16_t* act; int rowbase; int cnt;
    DEV void operator()(int r, int c, float g, float u) const { if (r < cnt) act[(size_t)(rowbase + r) * FF + ((c >> 5) * 16 + (c & 15))] = f2bf(siluf_(g) * u); }
};
struct EpiSwiGLUAll { bf16_t* act; DEV void operator()(int r, int c, float g, float u) const { act[(size_t)r * FF + ((c >> 5) * 16 + (c & 15))] = f2bf(siluf_(g) * u); } };
struct EpiSlot {
    bf16_t* yslot; const int* lslot; const float* lw; int base; int cnt;
    DEV void operator()(int r, int c, float v0, float v1) const {
        if (r < cnt) { int s = lslot[base + r]; float w = lw[base + r]; yslot[(size_t)s * D + c] = f2bf(w * v0); yslot[(size_t)s * D + c + 16] = f2bf(w * v1); }
    }
};

template <class AMap, class BMap, class Epi>
DEV void gemm_naive_tile(float* As, float* Bs, const AMap& amap, const BMap& bmap, const Epi& epi, int K, int row0, int arow0, int vcol0) {
    const int tid = threadIdx.x, tx = tid & 15, ty = tid >> 4;
    float acc[4][4];
#pragma unroll
    for (int i = 0; i < 4; ++i)
#pragma unroll
        for (int q = 0; q < 4; ++q) acc[i][q] = 0.f;
    for (int k0 = 0; k0 < K; k0 += 16) {
        { const int r = tid >> 2, kk = (tid & 3) * 4; const bf16_t* p = amap(arow0 + r) + k0 + kk;
#pragma unroll
          for (int i = 0; i < 4; ++i) As[r * 17 + kk + i] = bf2f(p[i]); }
        { const int kk = tid >> 4, vc = (tid & 15) * 4; const float* p = bmap((vcol0 + vc) >> 4, k0 + kk) + (vc & 15);
#pragma unroll
          for (int i = 0; i < 4; ++i) Bs[kk * 64 + vc + i] = p[i]; }
        __syncthreads();
#pragma unroll
        for (int kk = 0; kk < 16; ++kk) {
            float a[4], b[4];
#pragma unroll
            for (int i = 0; i < 4; ++i) a[i] = As[(ty * 4 + i) * 17 + kk];
#pragma unroll
            for (int q = 0; q < 4; ++q) b[q] = Bs[kk * 64 + tx + 16 * q];
#pragma unroll
            for (int i = 0; i < 4; ++i)
#pragma unroll
                for (int q = 0; q < 4; ++q) acc[i][q] += a[i] * b[q];
        }
        __syncthreads();
    }
#pragma unroll
    for (int i = 0; i < 4; ++i)
#pragma unroll
        for (int p = 0; p < 2; ++p) epi(row0 + ty * 4 + i, vcol0 + tx + 32 * p, acc[i][2 * p], acc[i][2 * p + 1]);
}

template <class AMap, class BMap, class Epi>
__global__ void __launch_bounds__(256) k_gemm_naive(AMap amap, BMap bmap, Epi epi, int K) {
    __shared__ float As[64 * 17];
    __shared__ float Bs[16 * 64];
    gemm_naive_tile(As, Bs, amap, bmap, epi, K, blockIdx.y * 64, blockIdx.y * 64, blockIdx.x * 64);
}


typedef short bf16x8 __attribute__((ext_vector_type(8)));
typedef short s16x4 __attribute__((ext_vector_type(4)));
typedef float f32x4 __attribute__((ext_vector_type(4)));
#define LAS __attribute__((address_space(3)))
constexpr int GEMM_LDS_BYTES = 2 * (256 * 128 + 32768);

typedef __bf16 hwbf16x2 __attribute__((ext_vector_type(2)));
DEV unsigned pack_bf16x2(float lo, float hi) { hwbf16x2 v = {(__bf16)lo, (__bf16)hi}; return __builtin_bit_cast(unsigned, v); }

struct FAMapPlain { const bf16_t* A; int lda; int row0; DEV const bf16_t* operator()(int r) const { return A + (size_t)(row0 + r) * lda; } };
struct FAMapGather { const bf16_t* A; int lda; const int* lslot; int base; int cnt; int r0;
    DEV const bf16_t* operator()(int r) const { int rr = r0 + r; rr = rr < cnt ? rr : cnt - 1; return A + (size_t)(lslot[base + rr] >> 3) * lda; } };
struct FAMapClamp { const bf16_t* A; int lda; int cnt; int r0;
    DEV const bf16_t* operator()(int r) const { int rr = r0 + r; rr = rr < cnt ? rr : cnt - 1; return A + (size_t)rr * lda; } };
struct FBMapPlain { const float* W; int ldb; int col0; DEV const float* ptr(int vb) const { return W + col0 + vb * 16; } DEV int ld() const { return ldb; } };
struct FBMapPair { const float* Wg; const float* Wu; int ldb; int col0;
    DEV const float* ptr(int vb) const { return Wg + (ptrdiff_t)(vb & 1) * (Wu - Wg) + col0 + (vb >> 1) * 16; } DEV int ld() const { return ldb; } };

template <int BM, class AMap, class BMap, class Epi>
DEV void gemm_unit(char* smem, const AMap& amap, const BMap& bmap, const Epi& epi, int K) {
    constexpr int NA = BM / 64, MI = BM / 32, ABYTES = BM * 128, STG = ABYTES + 32768;
    const int tid = threadIdx.x, lane = tid & 63, wid = tid >> 6, wr = wid >> 2, wc = wid & 3, fr = lane & 15, fq = lane >> 4;
    const bf16_t* aptr[NA];
#pragma unroll
    for (int i = 0; i < NA; ++i) { const int c = tid + 512 * i, row = c >> 3, pch = c & 7; aptr[i] = amap(row) + ((pch ^ (row & 7)) << 3); }
    const int g = lane >> 4, j16 = lane & 15, krow = j16 >> 2, c4 = j16 & 3, vg = wid & 3, kh = wid >> 2;
    const int ldb = bmap.ld();
    const float* bptr = bmap.ptr(vg * 4 + g) + 4 * c4 + (size_t)(4 * kh + krow) * ldb;
    unsigned bwr[2];
#pragma unroll
    for (int o = 0; o < 2; ++o) bwr[o] = ABYTES + (vg * 4 + g) * 256 + (((4 * kh + krow) ^ (o << 2)) * 32) + c4 * 8;
    unsigned ard[2];
#pragma unroll
    for (int ks = 0; ks < 2; ++ks) { const int row = wr * (BM / 2) + fr; ard[ks] = row * 128 + (((ks * 4 + fq) ^ (row & 7)) << 4); }
    unsigned brd[2];
    { const int q = j16 >> 2, p = j16 & 3;
#pragma unroll
      for (int t = 0; t < 2; ++t) brd[t] = ABYTES + (fq * 16) * 256 + (((4 * t + q) ^ ((fq & 1) << 2)) * 32) + p * 8; }

    f32x4 acc[MI][4];
#pragma unroll
    for (int mi = 0; mi < MI; ++mi)
#pragma unroll
        for (int nf = 0; nf < 4; ++nf) acc[mi][nf] = (f32x4){0.f, 0.f, 0.f, 0.f};

    float4 breg[4];
    const int nk = K >> 6;
#define G_LOAD_A(kt, buf) do { _Pragma("unroll") for (int i = 0; i < NA; ++i) \
        __builtin_amdgcn_global_load_lds((const unsigned*)(aptr[i] + (kt) * 64), (LAS unsigned*)(smem + (buf) * STG + (tid + 512 * i) * 16), 16, 0, 0); } while (0)
#define G_LOAD_B(kt, h) do { _Pragma("unroll") for (int i = 0; i < 4; ++i) breg[i] = *(const float4*)(bptr + (size_t)((kt) * 64 + 8 * ((h) * 4 + i)) * ldb); } while (0)
#define G_WRITE_B(buf, h) do { char* sb_ = smem + (buf) * STG; \
        _Pragma("unroll") for (int i = 0; i < 4; ++i) { uint2 w; w.x = pack_bf16x2(breg[i].x, breg[i].y); w.y = pack_bf16x2(breg[i].z, breg[i].w); \
            *(uint2*)(sb_ + bwr[i & 1] + ((h) * 4 + i) * 16 * 256) = w; } } while (0)
#define G_COMPUTE(sb, ks) do { bf16x8 bf[4]; \
        _Pragma("unroll") for (int nf = 0; nf < 4; ++nf) { \
            const int nb = (nf >> 1) * 8 + wc * 2 + (nf & 1); const unsigned base = (ks) * 4 * 16 * 256 + nb * 256; \
            s16x4 t0 = __builtin_amdgcn_ds_read_tr16_b64_v4i16((LAS s16x4*)((sb) + brd[0] + base)); \
            s16x4 t1 = __builtin_amdgcn_ds_read_tr16_b64_v4i16((LAS s16x4*)((sb) + brd[1] + base)); \
            bf[nf] = (bf16x8){t0[0], t0[1], t0[2], t0[3], t1[0], t1[1], t1[2], t1[3]}; } \
        _Pragma("unroll") for (int mi = 0; mi < MI; ++mi) { \
            const bf16x8 af = *(const bf16x8*)((sb) + ard[ks] + mi * 16 * 128); \
            _Pragma("unroll") for (int nf = 0; nf < 4; ++nf) acc[mi][nf] = __builtin_amdgcn_mfma_f32_16x16x32_bf16(bf[nf], af, acc[mi][nf], 0, 0, 0); } } while (0)
    G_LOAD_A(0, 0); G_LOAD_B(0, 0); G_WRITE_B(0, 0); G_LOAD_B(0, 1); G_WRITE_B(0, 1);
    __syncthreads();
    for (int kt = 0; kt < nk; ++kt) {
        const bool more = kt + 1 < nk;
        const char* sb = smem + (kt & 1) * STG;
        if (more) { G_LOAD_A(kt + 1, (kt + 1) & 1); G_LOAD_B(kt + 1, 0); }
        G_COMPUTE(sb, 0);
        if (more) { G_WRITE_B((kt + 1) & 1, 0); G_LOAD_B(kt + 1, 1); }
        G_COMPUTE(sb, 1);
        if (more) { G_WRITE_B((kt + 1) & 1, 1); }
        __syncthreads();
    }
#undef G_LOAD_A
#undef G_LOAD_B
#undef G_WRITE_B
#undef G_COMPUTE
#pragma unroll
    for (int mi = 0; mi < MI; ++mi)
#pragma unroll
        for (int bj = 0; bj < 2; ++bj) epi(wr * (BM / 2) + mi * 16 + fr, bj * 128 + wc * 32 + 4 * fq, acc[mi][bj * 2], acc[mi][bj * 2 + 1]);
}

struct FEpiStoreBf16 { bf16_t* C; int ldc; int row0; int col0;
    DEV void operator()(int r, int c, f32x4 v0, f32x4 v1) const { bf16_t* p = C + (size_t)(row0 + r) * ldc + col0 + c;
        uint2 a, b; a.x = pack_bf16x2(v0[0], v0[1]); a.y = pack_bf16x2(v0[2], v0[3]); b.x = pack_bf16x2(v1[0], v1[1]); b.y = pack_bf16x2(v1[2], v1[3]);
        *(uint2*)p = a; *(uint2*)(p + 16) = b; } };
struct FEpiStoreF32 { float* C; int ldc; int row0; int col0;
    DEV void operator()(int r, int c, f32x4 v0, f32x4 v1) const { float* p = C + (size_t)(row0 + r) * ldc + col0 + c; *(f32x4*)p = v0; *(f32x4*)(p + 16) = v1; } };
struct FEpiGateA { bf16_t* M; const bf16_t* proj; int row0; int col0;
    DEV void one(int r, int c, f32x4 v) const { const size_t row = row0 + r; const uint2 gr = *(const uint2*)(proj + row * NIN + OFF_GA + col0 + c);
        float g0 = sigmoidf_(__uint_as_float(gr.x << 16)), g1 = sigmoidf_(__uint_as_float(gr.x & 0xffff0000u)), g2 = sigmoidf_(__uint_as_float(gr.y << 16)), g3 = sigmoidf_(__uint_as_float(gr.y & 0xffff0000u));
        uint2 o; o.x = pack_bf16x2(g0 * v[0], g1 * v[1]); o.y = pack_bf16x2(g2 * v[2], g3 * v[3]); *(uint2*)(M + row * D + col0 + c) = o; }
    DEV void operator()(int r, int c, f32x4 v0, f32x4 v1) const { one(r, c, v0); one(r, c + 16, v1); } };
struct FEpiGateB { bf16_t* M; const bf16_t* proj; int row0; int col0;
    DEV void one(int r, int c, f32x4 v) const { const size_t row = row0 + r; const uint2 gr = *(const uint2*)(proj + row * NIN + OFF_GB + col0 + c);
        const uint2 mo = *(const uint2*)(M + row * D + col0 + c);
        float g0 = sigmoidf_(__uint_as_float(gr.x << 16)), g1 = sigmoidf_(__uint_as_float(gr.x & 0xffff0000u)), g2 = sigmoidf_(__uint_as_float(gr.y << 16)), g3 = sigmoidf_(__uint_as_float(gr.y & 0xffff0000u));
        float m0 = __uint_as_float(mo.x << 16), m1 = __uint_as_float(mo.x & 0xffff0000u), m2 = __uint_as_float(mo.y << 16), m3 = __uint_as_float(mo.y & 0xffff0000u);
        uint2 o; o.x = pack_bf16x2(m0 + g0 * v[0], m1 + g1 * v[1]); o.y = pack_bf16x2(m2 + g2 * v[2], m3 + g3 * v[3]); *(uint2*)(M + row * D + col0 + c) = o; }
    DEV void operator()(int r, int c, f32x4 v0, f32x4 v1) const { one(r, c, v0); one(r, c + 16, v1); } };
struct FEpiSwiGLU { bf16_t* act; int rowbase; int cnt; int r0; int col0;
    DEV void operator()(int r, int c, f32x4 g, f32x4 u) const { const int rr = r0 + r; if (rr < cnt) {
        uint2 o; o.x = pack_bf16x2(siluf_(g[0]) * u[0], siluf_(g[1]) * u[1]); o.y = pack_bf16x2(siluf_(g[2]) * u[2], siluf_(g[3]) * u[3]);
        *(uint2*)(act + (size_t)(rowbase + rr) * FF + col0 + (c >> 5) * 16 + (c & 15)) = o; } } };
struct FEpiSlot { bf16_t* yslot; const int* lslot; const float* lw; int base; int cnt; int r0; int col0;
    DEV void operator()(int r, int c, f32x4 v0, f32x4 v1) const { const int rr = r0 + r; if (rr < cnt) { const int s = lslot[base + rr]; const float w = lw[base + rr];
        bf16_t* p = yslot + (size_t)s * D + col0 + c; uint2 a, b; a.x = pack_bf16x2(w * v0[0], w * v0[1]); a.y = pack_bf16x2(w * v0[2], w * v0[3]); b.x = pack_bf16x2(w * v1[0], w * v1[1]); b.y = pack_bf16x2(w * v1[2], w * v1[3]);
        *(uint2*)p = a; *(uint2*)(p + 16) = b; } } };

struct GemmArgs { const bf16_t* A; const float* B; const float* B2; void* C; const bf16_t* aux; int M; int N; int K; int lda; int ldb; int ldc; int epi; int pad; };
template <int EPI>
__global__ void __launch_bounds__(512, 2) k_gemm_fast(GemmArgs ga) {
    extern __shared__ __attribute__((aligned(16))) char smem[];
    const int nN = ga.N / 256, nU = (ga.M / 256) * nN;
    for (int u = blockIdx.x; u < nU; u += gridDim.x) {
        const int pm = u / nN, pn = u % nN;
        FAMapPlain am{ga.A, ga.lda, pm * 256};
        if constexpr (EPI == 0) { FBMapPlain bm{ga.B, ga.ldb, pn * 256}; gemm_unit<256>(smem, am, bm, FEpiStoreBf16{(bf16_t*)ga.C, ga.ldc, pm * 256, pn * 256}, ga.K); }
        else if constexpr (EPI == 1) { FBMapPlain bm{ga.B, ga.ldb, pn * 256}; gemm_unit<256>(smem, am, bm, FEpiStoreF32{(float*)ga.C, ga.ldc, pm * 256, pn * 256}, ga.K); }
        else if constexpr (EPI == 2) { FBMapPlain bm{ga.B, ga.ldb, pn * 256}; gemm_unit<256>(smem, am, bm, FEpiGateA{(bf16_t*)ga.C, ga.aux, pm * 256, pn * 256}, ga.K); }
        else if constexpr (EPI == 3) { FBMapPlain bm{ga.B, ga.ldb, pn * 256}; gemm_unit<256>(smem, am, bm, FEpiGateB{(bf16_t*)ga.C, ga.aux, pm * 256, pn * 256}, ga.K); }
        else { FBMapPair bm{ga.B, ga.B2, ga.ldb, pn * 128}; gemm_unit<256>(smem, am, bm, FEpiSwiGLU{(bf16_t*)ga.C, 0, ga.M, pm * 256, pn * 128}, ga.K); }
        __syncthreads();
    }
}

__global__ void __launch_bounds__(512, 2) k_exp1_fast(WS ws, const float* wg, const float* wu) {
    extern __shared__ __attribute__((aligned(16))) char smem[];
    const int ni = (int)ws.ctrl[512];
    for (int it = blockIdx.x; it < ni * 2; it += gridDim.x) {
        const int item = it >> 1, pn = it & 1;
        const int e = ws.items[2 * item], r0 = ws.items[2 * item + 1];
        const int base = ws.offs[e], cnt = ws.offs[e + 1] - base;
        FAMapGather am{ws.h2, D, ws.lslot, base, cnt, r0};
        FBMapPair bm{wg + (size_t)e * D * FF, wu + (size_t)e * D * FF, FF, pn * 128};
        gemm_unit<256>(smem, am, bm, FEpiSwiGLU{ws.act, base, cnt, r0, pn * 128}, D);
        __syncthreads();
    }
}
__global__ void __launch_bounds__(512, 2) k_exp2_fast(WS ws, const float* wd) {
    extern __shared__ __attribute__((aligned(16))) char smem[];
    const int ni = (int)ws.ctrl[512];
    for (int it = blockIdx.x; it < ni * 4; it += gridDim.x) {
        const int item = it >> 2, pn = it & 3;
        const int e = ws.items[2 * item], r0 = ws.items[2 * item + 1];
        const int base = ws.offs[e], cnt = ws.offs[e + 1] - base;
        FAMapClamp am{ws.act + (size_t)base * FF, FF, cnt, r0};
        FBMapPlain bm{wd + (size_t)e * FF * D, D, pn * 256};
        gemm_unit<256>(smem, am, bm, FEpiSlot{ws.yslot, ws.lslot, ws.lw, base, cnt, r0, pn * 256}, FF);
        __syncthreads();
    }
}

DEV unsigned sw128(int row, int chunk) { return (unsigned)(row * 128 + ((chunk ^ (row & 7)) << 4)); }
DEV unsigned sw256(int row, int chunk) { return (unsigned)(row * 256 + ((chunk ^ (row & 15)) << 4)); }
constexpr int HG_LDS_BYTES = 96 * 1024;

DEV void hgrn_gates(const bf16_t* proj, const float* lbt, int t0, int h, int d, int seg, float* red, float (&fgv)[16], float (&b)[16], float& blast) {
    const float a0 = lbt[h * 128 + d], a1 = lbt[512 + h * 128 + d];
    const float lb = 1.f / (1.f + __expf(a1 - a0));
    float run = 0.f;
#pragma unroll
    for (int i = 0; i < 16; ++i) {
        const float f = bf2f(proj[(size_t)(t0 + 16 * seg + i) * NIN + OFF_F + h * 128 + d]);
        const float fg = lb + (1.f - lb) * sigmoidf_(f);
        fgv[i] = fg; run += __logf(fg); b[i] = run;
    }
    red[seg * 128 + d] = run;
    __syncthreads();
    const float r0 = red[d], r1 = red[128 + d], r2 = red[256 + d], r3 = red[384 + d];
    const float pre = (seg > 0 ? r0 : 0.f) + (seg > 1 ? r1 : 0.f) + (seg > 2 ? r2 : 0.f);
    blast = r0 + r1 + r2 + r3;
#pragma unroll
    for (int i = 0; i < 16; ++i) b[i] += pre;
}
DEV void pack16_store(char* smem, unsigned a0, unsigned a1, const float (&v)[16]) {
    uint4 lo, hi;
    lo.x = pack_bf16x2(v[0], v[1]); lo.y = pack_bf16x2(v[2], v[3]); lo.z = pack_bf16x2(v[4], v[5]); lo.w = pack_bf16x2(v[6], v[7]);
    hi.x = pack_bf16x2(v[8], v[9]); hi.y = pack_bf16x2(v[10], v[11]); hi.z = pack_bf16x2(v[12], v[13]); hi.w = pack_bf16x2(v[14], v[15]);
    *(uint4*)(smem + a0) = lo; *(uint4*)(smem + a1) = hi;
}

DEV void hgrn_phase1(char* smem, const bf16_t* proj, const float* lbt, float* kcT, float* dec, int c, int h) {
    const int tid = threadIdx.x, d = tid & 127, seg = tid >> 7, t0 = c * 64;
    const int lane = tid & 63, w = tid >> 6, fr = lane & 15, fq = lane >> 4;
    float* red = (float*)(smem + 32768);
    float fgv[16], b[16], blast;
    hgrn_gates(proj, lbt, t0, h, d, seg, red, fgv, b, blast);
    float kd[16], vv[16];
#pragma unroll
    for (int i = 0; i < 16; ++i) {
        kd[i] = (1.f - fgv[i]) * __expf(blast - b[i]);
        vv[i] = bf2f(proj[(size_t)(t0 + 16 * seg + i) * NIN + OFF_I + h * 128 + d]);
    }
    pack16_store(smem, sw128(d, 2 * seg), sw128(d, 2 * seg + 1), kd);
    pack16_store(smem + 16384, sw128(d, 2 * seg), sw128(d, 2 * seg + 1), vv);
    if (seg == 3) dec[(size_t)(c * 4 + h) * 128 + d] = __expf(blast);
    __syncthreads();
    f32x4 acc[8];
#pragma unroll
    for (int nv = 0; nv < 8; ++nv) acc[nv] = (f32x4){0.f, 0.f, 0.f, 0.f};
#pragma unroll
    for (int ks = 0; ks < 2; ++ks) {
        const bf16x8 xf = *(const bf16x8*)(smem + sw128(16 * w + fr, ks * 4 + fq));
#pragma unroll
        for (int nv = 0; nv < 8; ++nv) {
            const bf16x8 yf = *(const bf16x8*)(smem + 16384 + sw128(16 * nv + fr, ks * 4 + fq));
            acc[nv] = __builtin_amdgcn_mfma_f32_16x16x32_bf16(xf, yf, acc[nv], 0, 0, 0);
        }
    }
    float* out = kcT + (size_t)(c * 4 + h) * 16384;
#pragma unroll
    for (int nv = 0; nv < 8; ++nv) *(f32x4*)(out + (16 * nv + fr) * 128 + 16 * w + 4 * fq) = acc[nv];
    __syncthreads();
}

DEV void hgrn_phase2(const float* kcT, const float* dec, bf16_t* ST, int e) {
    const int h = e >> 14, d = e & 127;
    float S = 0.f;
    for (int c0 = 0; c0 < 256; c0 += 16) {
        float kc[16], dc[16];
#pragma unroll
        for (int i = 0; i < 16; ++i) { kc[i] = kcT[(size_t)(c0 + i) * 65536 + e]; dc[i] = dec[(size_t)((c0 + i) * 4 + h) * 128 + d]; }
#pragma unroll
        for (int i = 0; i < 16; ++i) { ST[(size_t)(c0 + i) * 65536 + e] = f2bf(S); S = dc[i] * S + kc[i]; }
    }
}

DEV void hgrn_phase3(char* smem, const bf16_t* proj, const float* lbt, const bf16_t* ST, const float* hw, bf16_t* ob, int c, int h) {
    constexpr int O_QT = 0, O_KT = 16384, O_VT = 32768, O_ST = 49152, O_AT = 81920, O_RED = 90112, O_SSQ = 92160;
    const int tid = threadIdx.x, d = tid & 127, seg = tid >> 7, t0 = c * 64;
    const int lane = tid & 63, w = tid >> 6, fr = lane & 15, fq = lane >> 4;
    {
        float fgv[16], b[16], blast;
        hgrn_gates(proj, lbt, t0, h, d, seg, (float*)(smem + O_RED), fgv, b, blast);
        float vv[16];
#pragma unroll
        for (int i = 0; i < 16; ++i) {
            const int t = 16 * seg + i;
            const float qv = bf2f(proj[(size_t)(t0 + t) * NIN + OFF_Q + h * 128 + d]);
            const float eb = __expf(b[i]);
            const float qt = siluf_(qv) * eb, kt = (1.f - fgv[i]) / eb;
            const unsigned off = sw256(t, d >> 3) + (d & 7) * 2;
            *(bf16_t*)(smem + O_QT + off) = f2bf(qt);
            *(bf16_t*)(smem + O_KT + off) = f2bf(kt);
            vv[i] = bf2f(proj[(size_t)(t0 + t) * NIN + OFF_I + h * 128 + d]);
        }
        pack16_store(smem + O_VT, sw128(d, 2 * seg), sw128(d, 2 * seg + 1), vv);
        const bf16_t* sp = ST + (size_t)(c * 4 + h) * 16384;
#pragma unroll
        for (int i = 0; i < 4; ++i) { const int idx = tid + 512 * i, row = idx >> 4, ch = idx & 15; *(uint4*)(smem + O_ST + sw256(row, ch)) = *(const uint4*)(sp + row * 128 + ch * 8); }
    }
    __syncthreads();
    {
        const int tb = w & 3;
#pragma unroll
        for (int u = 0; u < 2; ++u) {
            const int sb = (w >> 2) * 2 + u;
            f32x4 acc = (f32x4){0.f, 0.f, 0.f, 0.f};
            if (sb <= tb) {
#pragma unroll
                for (int ks = 0; ks < 4; ++ks) {
                    const bf16x8 xf = *(const bf16x8*)(smem + O_KT + sw256(16 * sb + fr, ks * 4 + fq));
                    const bf16x8 yf = *(const bf16x8*)(smem + O_QT + sw256(16 * tb + fr, ks * 4 + fq));
                    acc = __builtin_amdgcn_mfma_f32_16x16x32_bf16(xf, yf, acc, 0, 0, 0);
                }
                const int t = 16 * tb + fr, s0 = 16 * sb + 4 * fq;
#pragma unroll
                for (int jj = 0; jj < 4; ++jj) if (s0 + jj > t) acc[jj] = 0.f;
            }
            uint2 o; o.x = pack_bf16x2(acc[0], acc[1]); o.y = pack_bf16x2(acc[2], acc[3]);
            *(uint2*)(smem + O_AT + sw128(16 * tb + fr, 2 * sb + (fq >> 1)) + 8 * (fq & 1)) = o;
        }
    }
    __syncthreads();
    const int tb = w & 3, vh = w >> 2;
    f32x4 acc[4];
#pragma unroll
    for (int n = 0; n < 4; ++n) acc[n] = (f32x4){0.f, 0.f, 0.f, 0.f};
#pragma unroll
    for (int ks = 0; ks < 2; ++ks) {
        const bf16x8 yf = *(const bf16x8*)(smem + O_AT + sw128(16 * tb + fr, ks * 4 + fq));
#pragma unroll
        for (int n = 0; n < 4; ++n) {
            const bf16x8 xf = *(const bf16x8*)(smem + O_VT + sw128(16 * (4 * vh + n) + fr, ks * 4 + fq));
            acc[n] = __builtin_amdgcn_mfma_f32_16x16x32_bf16(xf, yf, acc[n], 0, 0, 0);
        }
    }
#pragma unroll
    for (int ks = 0; ks < 4; ++ks) {
        const bf16x8 yf = *(const bf16x8*)(smem + O_QT + sw256(16 * tb + fr, ks * 4 + fq));
#pragma unroll
        for (int n = 0; n < 4; ++n) {
            const bf16x8 xf = *(const bf16x8*)(smem + O_ST + sw256(16 * (4 * vh + n) + fr, ks * 4 + fq));
            acc[n] = __builtin_amdgcn_mfma_f32_16x16x32_bf16(xf, yf, acc[n], 0, 0, 0);
        }
    }
    float ss = 0.f;
#pragma unroll
    for (int n = 0; n < 4; ++n)
#pragma unroll
        for (int jj = 0; jj < 4; ++jj) ss += acc[n][jj] * acc[n][jj];
    ss += __shfl_xor(ss, 16); ss += __shfl_xor(ss, 32);
    float* ssq = (float*)(smem + O_SSQ);
    if (fq == 0) ssq[vh * 64 + 16 * tb + fr] = ss;
    __syncthreads();
    const float tot = ssq[16 * tb + fr] + ssq[64 + 16 * tb + fr];
    const float rs = rsqrtf(tot * (1.f / 128.f) + EPS);
    const size_t trow = (size_t)(t0 + 16 * tb + fr);
#pragma unroll
    for (int n = 0; n < 4; ++n) {
        const int v0 = 16 * (4 * vh + n) + 4 * fq;
        const uint2 gr = *(const uint2*)(proj + trow * NIN + OFF_G + h * 128 + v0);
        const f32x4 wv = *(const f32x4*)(hw + v0);
        const float g0 = siluf_(__uint_as_float(gr.x << 16)), g1 = siluf_(__uint_as_float(gr.x & 0xffff0000u)), g2 = siluf_(__uint_as_float(gr.y << 16)), g3 = siluf_(__uint_as_float(gr.y & 0xffff0000u));
        uint2 o; o.x = pack_bf16x2(acc[n][0] * rs * wv[0] * g0, acc[n][1] * rs * wv[1] * g1); o.y = pack_bf16x2(acc[n][2] * rs * wv[2] * g2, acc[n][3] * rs * wv[3] * g3);
        *(uint2*)(ob + trow * 512 + h * 128 + v0) = o;
    }
    __syncthreads();
}

__global__ void __launch_bounds__(512, 2) k_hgrn1(const bf16_t* proj, const float* lbt, float* kcT, float* dec) {
    extern __shared__ __attribute__((aligned(16))) char smem[];
    for (int u = blockIdx.x; u < 1024; u += gridDim.x) hgrn_phase1(smem, proj, lbt, kcT, dec, u >> 2, u & 3);
}
__global__ void __launch_bounds__(512, 2) k_hgrn2(const float* kcT, const float* dec, bf16_t* ST) {
    hgrn_phase2(kcT, dec, ST, blockIdx.x * 512 + threadIdx.x);
}
__global__ void __launch_bounds__(512, 2) k_hgrn3(const bf16_t* proj, const float* lbt, const bf16_t* ST, const float* hw, bf16_t* ob) {
    extern __shared__ __attribute__((aligned(16))) char smem[];
    for (int u = blockIdx.x; u < 1024; u += gridDim.x) hgrn_phase3(smem, proj, lbt, ST, hw, ob, u >> 2, u & 3);
}

__global__ void k_mod(const float* c, const float* w_ada, const float* b_ada, float* mod) {
    int j = blockIdx.x * 256 + threadIdx.x;
    if (j >= 6 * D) return;
    float acc = b_ada[j];
    for (int k = 0; k < D; ++k) acc += siluf_(c[k]) * w_ada[(size_t)k * 6 * D + j];
    mod[j] = acc;
}

__global__ void k_norm1(const float* x, const float* w, const float* mod, bf16_t* h1) {
    int row = blockIdx.x * 4 + (threadIdx.x >> 6), lane = threadIdx.x & 63;
    const float* xr = x + (size_t)row * D;
    float v[16]; float ss = 0.f;
#pragma unroll
    for (int i = 0; i < 4; ++i) { float4 t = *(const float4*)(xr + i * 256 + lane * 4); v[4 * i] = t.x; v[4 * i + 1] = t.y; v[4 * i + 2] = t.z; v[4 * i + 3] = t.w; ss += t.x * t.x + t.y * t.y + t.z * t.z + t.w * t.w; }
    ss = wave_sum(ss);
    float rs = rsqrtf(ss / D + EPS);
#pragma unroll
    for (int i = 0; i < 4; ++i)
#pragma unroll
        for (int j = 0; j < 4; ++j) { int c = i * 256 + lane * 4 + j; h1[(size_t)row * D + c] = f2bf(v[4 * i + j] * rs * w[c] * (1.f + mod[D + c]) + mod[c]); }
}

__global__ void k_conv(const bf16_t* proj, const float* conv_w, bf16_t* a1) {
    size_t i = (size_t)blockIdx.x * 256 + threadIdx.x;
    int t = (int)(i / 512), c = (int)(i % 512);
    float acc = 0.f;
#pragma unroll
    for (int j = 0; j < 3; ++j) { int tt = t - 2 + j; if (tt >= 0) { const bf16_t* p = proj + (size_t)tt * NIN; acc += conv_w[j * 512 + c] * bf2f(p[OFF_CC + c]) * bf2f(p[OFF_CX + c]); } }
    a1[i] = f2bf(bf2f(proj[(size_t)t * NIN + OFF_CB + c]) * acc);
}

__global__ void __launch_bounds__(128) k_hgrn_naive(const bf16_t* proj, const float* lbt, float* o32) {
    const int h = blockIdx.x, dv = threadIdx.x;
    __shared__ float fs[128], ks[128], qs[128];
    float S[128];
#pragma unroll
    for (int d = 0; d < 128; ++d) S[d] = 0.f;
    const float a0 = lbt[h * 128 + dv], a1 = lbt[512 + h * 128 + dv];
    const float lb = 1.f / (1.f + __expf(a1 - a0));
    for (int t = 0; t < T; ++t) {
        const bf16_t* p = proj + (size_t)t * NIN;
        float f = bf2f(p[OFF_F + h * 128 + dv]);
        float fg = lb + (1.f - lb) * sigmoidf_(f);
        fs[dv] = fg; ks[dv] = 1.f - fg; qs[dv] = siluf_(bf2f(p[OFF_Q + h * 128 + dv]));
        float iv = bf2f(p[OFF_I + h * 128 + dv]);
        __syncthreads();
        float o = 0.f;
#pragma unroll
        for (int d = 0; d < 128; ++d) { S[d] = fs[d] * S[d] + ks[d] * iv; o += S[d] * qs[d]; }
        o32[(size_t)t * 512 + h * 128 + dv] = o;
        __syncthreads();
    }
}

__global__ void k_hnorm(const float* o32, const float* hw, const bf16_t* proj, bf16_t* ob) {
    int idx = blockIdx.x * 4 + (threadIdx.x >> 6), lane = threadIdx.x & 63;
    int t = idx >> 2, h = idx & 3;
    const float* p = o32 + (size_t)t * 512 + h * 128;
    float v0 = p[lane], v1 = p[lane + 64];
    float ss = wave_sum(v0 * v0 + v1 * v1);
    float rs = rsqrtf(ss / 128.f + EPS);
    const bf16_t* g = proj + (size_t)t * NIN + OFF_G + h * 128;
    ob[(size_t)t * 512 + h * 128 + lane] = f2bf(v0 * rs * hw[lane] * siluf_(bf2f(g[lane])));
    ob[(size_t)t * 512 + h * 128 + lane + 64] = f2bf(v1 * rs * hw[lane + 64] * siluf_(bf2f(g[lane + 64])));
}

__global__ void k_mid(const float* x, const bf16_t* y, const float* wpost, const float* wpre2, const float* mod, float* x1, bf16_t* h2) {
    int row = blockIdx.x * 4 + (threadIdx.x >> 6), lane = threadIdx.x & 63;
    float yv[16], xv[16]; float ss = 0.f;
#pragma unroll
    for (int i = 0; i < 4; ++i)
#pragma unroll
        for (int j = 0; j < 4; ++j) { int c = i * 256 + lane * 4 + j; float v = bf2f(y[(size_t)row * D + c]); yv[4 * i + j] = v; ss += v * v; }
    ss = wave_sum(ss);
    float rs = rsqrtf(ss / D + EPS);
    float ss2 = 0.f;
#pragma unroll
    for (int i = 0; i < 4; ++i)
#pragma unroll
        for (int j = 0; j < 4; ++j) { int c = i * 256 + lane * 4 + j; float v = x[(size_t)row * D + c] + mod[2 * D + c] * (yv[4 * i + j] * rs * wpost[c]); xv[4 * i + j] = v; ss2 += v * v; x1[(size_t)row * D + c] = v; }
    ss2 = wave_sum(ss2);
    float rs2 = rsqrtf(ss2 / D + EPS);
#pragma unroll
    for (int i = 0; i < 4; ++i)
#pragma unroll
        for (int j = 0; j < 4; ++j) { int c = i * 256 + lane * 4 + j; h2[(size_t)row * D + c] = f2bf(xv[4 * i + j] * rs2 * wpre2[c] * (1.f + mod[4 * D + c]) + mod[3 * D + c]); }
}

__global__ void k_route(const float* logits, const float* rbias, int* eidx, float* wsel, unsigned* counts) {
    int t = blockIdx.x * 4 + (threadIdx.x >> 6), lane = threadIdx.x & 63;
    float4 lg = *(const float4*)(logits + (size_t)t * E + lane * 4);
    float4 rb = *(const float4*)(rbias + lane * 4);
    float s[4] = {sigmoidf_(lg.x), sigmoidf_(lg.y), sigmoidf_(lg.z), sigmoidf_(lg.w)};
    float sel[4] = {s[0] + rb.x, s[1] + rb.y, s[2] + rb.z, s[3] + rb.w};
    float m1 = -INFINITY, m2 = -INFINITY;
#pragma unroll
    for (int i = 0; i < 4; ++i) { float v = sel[i]; if (v > m1) { m2 = m1; m1 = v; } else if (v > m2) m2 = v; }
#pragma unroll
    for (int o = 1; o < 8; o <<= 1) { float o1 = __shfl_xor(m1, o), o2 = __shfl_xor(m2, o); float n1 = fmaxf(m1, o1); float n2 = fmaxf(fminf(m1, o1), fmaxf(m2, o2)); m1 = n1; m2 = n2; }
    const float gs = m1 + m2; const int g = lane >> 3;
    int rank = 0;
#pragma unroll
    for (int j = 0; j < 8; ++j) { float gj = __shfl(gs, j * 8); rank += (gj > gs || (gj == gs && j < g)) ? 1 : 0; }
    const bool gsel = rank < 4;
    float val[4];
#pragma unroll
    for (int i = 0; i < 4; ++i) val[i] = gsel ? sel[i] : -INFINITY;
    float wk = 0.f; int ek = 0; float wsum = 0.f;
    for (int r = 0; r < TOPK; ++r) {
        float bv = -INFINITY; int bi = lane * 4;
#pragma unroll
        for (int i = 0; i < 4; ++i) if (val[i] > bv) { bv = val[i]; bi = lane * 4 + i; }
#pragma unroll
        for (int o = 1; o < 64; o <<= 1) { float ov = __shfl_xor(bv, o); int oi = __shfl_xor(bi, o); if (ov > bv || (ov == bv && oi < bi)) { bv = ov; bi = oi; } }
        const int owner = bi >> 2, sub = bi & 3;
        float sv = sub == 0 ? s[0] : sub == 1 ? s[1] : sub == 2 ? s[2] : s[3];
        sv = __shfl(sv, owner);
        if (lane == owner) {
#pragma unroll
            for (int i = 0; i < 4; ++i) if (i == sub) val[i] = -INFINITY;
        }
        wsum += sv;
        if (lane == r) { wk = sv; ek = bi; }
    }
    if (lane < TOPK) {
        eidx[t * TOPK + lane] = ek;
        wsel[t * TOPK + lane] = wk / (wsum + 1e-20f) * 2.5f;
        atomicAdd(&counts[ek], 1u);
    }
}

__global__ void k_offsets(const unsigned* counts, int* offs, int* items, unsigned* nitems, int TM) {
    if (threadIdx.x != 0) return;
    int acc = 0, ni = 0;
    for (int e = 0; e < E; ++e) { offs[e] = acc; int c = (int)counts[e]; for (int r = 0; r < c; r += TM) { items[2 * ni] = e; items[2 * ni + 1] = r; ++ni; } acc += c; }
    offs[E] = acc; *nitems = (unsigned)ni;
}
__global__ void k_fill(const int* eidx, const float* wsel, const int* offs, unsigned* cursors, int* lslot, float* lw) {
    int i = blockIdx.x * 256 + threadIdx.x;
    int e = eidx[i];
    int p = offs[e] + (int)atomicAdd(&cursors[e], 1u);
    lslot[p] = i; lw[p] = wsel[i];
}

__global__ void __launch_bounds__(256) k_exp1_naive(WS ws, const float* wg, const float* wu) {
    __shared__ float As[64 * 17];
    __shared__ float Bs[16 * 64];
    const int ni = (int)ws.ctrl[512];
    for (int it = blockIdx.x; it < ni * 8; it += gridDim.x) {
        const int item = it >> 3, nt = it & 7;
        const int e = ws.items[2 * item], r0 = ws.items[2 * item + 1];
        const int base = ws.offs[e], cnt = ws.offs[e + 1] - base;
        AMapGather am{ws.h2, D, ws.lslot, base, cnt};
        BMapPair bm{wg + (size_t)e * D * FF, wu + (size_t)e * D * FF, FF};
        EpiSwiGLU ep{ws.act, base, cnt};
        gemm_naive_tile(As, Bs, am, bm, ep, D, r0, r0, nt * 64);
    }
}
__global__ void __launch_bounds__(256) k_exp2_naive(WS ws, const float* wd) {
    __shared__ float As[64 * 17];
    __shared__ float Bs[16 * 64];
    const int ni = (int)ws.ctrl[512];
    for (int it = blockIdx.x; it < ni * 16; it += gridDim.x) {
        const int item = it >> 4, nt = it & 15;
        const int e = ws.items[2 * item], r0 = ws.items[2 * item + 1];
        const int base = ws.offs[e], cnt = ws.offs[e + 1] - base;
        AMapClamp amc{ws.act + (size_t)base * FF, FF, cnt};
        BMapPlain bm{wd + (size_t)e * FF * D, D};
        EpiSlot ep{ws.yslot, ws.lslot, ws.lw, base, cnt};
        gemm_naive_tile(As, Bs, amc, bm, ep, FF, r0, r0, nt * 64);
    }
}

__global__ void k_final(const bf16_t* shout, const bf16_t* yslot, const float* wpost2, const float* mod, float* out) {
    int row = blockIdx.x * 4 + (threadIdx.x >> 6), lane = threadIdx.x & 63;
    float mv[16]; float ss = 0.f;
#pragma unroll
    for (int i = 0; i < 4; ++i)
#pragma unroll
        for (int j = 0; j < 4; ++j) {
            int c = i * 256 + lane * 4 + j;
            float v = bf2f(shout[(size_t)row * D + c]);
            for (int k = 0; k < TOPK; ++k) v += bf2f(yslot[((size_t)row * TOPK + k) * D + c]);
            mv[4 * i + j] = v; ss += v * v;
        }
    ss = wave_sum(ss);
    float rs = rsqrtf(ss / D + EPS);
#pragma unroll
    for (int i = 0; i < 4; ++i)
#pragma unroll
        for (int j = 0; j < 4; ++j) { int c = i * 256 + lane * 4 + j; size_t o = (size_t)row * D + c; out[o] = out[o] + mod[5 * D + c] * (mv[4 * i + j] * rs * wpost2[c]); }
}

static WS make_ws(void* d_ws) {
    char* p = (char*)d_ws; size_t off = 0;
    auto take = [&](size_t bytes) { char* r = p + off; off += (bytes + 255) & ~(size_t)255; return r; };
    WS w;
    w.ctrl = (unsigned*)take(65536);
    w.mod = (float*)take(6 * D * 4);
    w.h1 = (bf16_t*)take((size_t)T * D * 2);
    w.proj = (bf16_t*)take((size_t)T * NIN * 2);
    w.o32 = (float*)take((size_t)T * 512 * 4);
    w.kcT = (float*)take((size_t)256 * 65536 * 4);
    w.dec = (float*)take((size_t)256 * 512 * 4);
    w.ST = (bf16_t*)take((size_t)256 * 65536 * 2);
    w.a1 = (bf16_t*)take((size_t)T * 512 * 2);
    w.ob = (bf16_t*)take((size_t)T * 512 * 2);
    w.m = (bf16_t*)take((size_t)T * D * 2);
    w.y = (bf16_t*)take((size_t)T * D * 2);
    w.h2 = (bf16_t*)take((size_t)T * D * 2);
    w.logits = (float*)take((size_t)T * E * 4);
    w.eidx = (int*)take((size_t)T * TOPK * 4);
    w.wsel = (float*)take((size_t)T * TOPK * 4);
    w.offs = (int*)take(4096);
    w.items = (int*)take(65536);
    w.lslot = (int*)take((size_t)T * TOPK * 4);
    w.lw = (float*)take((size_t)T * TOPK * 4);
    w.act = (bf16_t*)take((size_t)T * TOPK * FF * 2);
    w.yslot = (bf16_t*)take((size_t)T * TOPK * D * 2);
    w.acts = (bf16_t*)take((size_t)T * FF * 2);
    w.shout = (bf16_t*)take((size_t)T * D * 2);
    return w;
}

static void launch_gemm(hipStream_t stream, const bf16_t* A, const float* B, const float* B2, void* C, const bf16_t* aux, int M, int N, int K, int lda, int ldb, int ldc, int epi) {
    static bool attr = false;
    if (!attr) {
        (void)hipFuncSetAttribute((const void*)k_gemm_fast<0>, hipFuncAttributeMaxDynamicSharedMemorySize, GEMM_LDS_BYTES);
        (void)hipFuncSetAttribute((const void*)k_gemm_fast<1>, hipFuncAttributeMaxDynamicSharedMemorySize, GEMM_LDS_BYTES);
        (void)hipFuncSetAttribute((const void*)k_gemm_fast<2>, hipFuncAttributeMaxDynamicSharedMemorySize, GEMM_LDS_BYTES);
        (void)hipFuncSetAttribute((const void*)k_gemm_fast<3>, hipFuncAttributeMaxDynamicSharedMemorySize, GEMM_LDS_BYTES);
        (void)hipFuncSetAttribute((const void*)k_gemm_fast<4>, hipFuncAttributeMaxDynamicSharedMemorySize, GEMM_LDS_BYTES);
        attr = true; }
    GemmArgs ga; memset(&ga, 0, sizeof(ga));
    ga.A = A; ga.B = B; ga.B2 = B2; ga.C = C; ga.aux = aux; ga.M = M; ga.N = N; ga.K = K; ga.lda = lda; ga.ldb = ldb; ga.ldc = ldc; ga.epi = epi;
    switch (epi) {
        case 0: k_gemm_fast<0><<<256, 512, GEMM_LDS_BYTES, stream>>>(ga); break;
        case 1: k_gemm_fast<1><<<256, 512, GEMM_LDS_BYTES, stream>>>(ga); break;
        case 2: k_gemm_fast<2><<<256, 512, GEMM_LDS_BYTES, stream>>>(ga); break;
        case 3: k_gemm_fast<3><<<256, 512, GEMM_LDS_BYTES, stream>>>(ga); break;
        default: k_gemm_fast<4><<<256, 512, GEMM_LDS_BYTES, stream>>>(ga); break;
    }
}

extern "C" void kernel_launch(void* const* d_in, const int* in_sizes, int n_in, void* d_out, int out_size, void* d_ws, size_t ws_size, hipStream_t stream) {
    const float* x = (const float*)d_in[0];
    const float* c = (const float*)d_in[1];
    const float* w_ada = (const float*)d_in[2];
    const float* b_ada = (const float*)d_in[3];
    const float* norm_pre_mix = (const float*)d_in[4];
    const float* norm_post_mix = (const float*)d_in[5];
    const float* w_in = (const float*)d_in[6];
    const float* conv_w = (const float*)d_in[7];
    const float* w_conv_out = (const float*)d_in[8];
    const float* hgrn_lb = (const float*)d_in[9];
    const float* hgrn_norm_w = (const float*)d_in[10];
    const float* w_hgrn_out = (const float*)d_in[11];
    const float* w_o = (const float*)d_in[12];
    const float* norm_pre_ffn = (const float*)d_in[13];
    const float* norm_post_ffn = (const float*)d_in[14];
    const float* w_router = (const float*)d_in[15];
    const float* router_bias = (const float*)d_in[16];
    const float* w_gate_e = (const float*)d_in[17];
    const float* w_up_e = (const float*)d_in[18];
    const float* w_down_e = (const float*)d_in[19];
    const float* w_gate_s = (const float*)d_in[20];
    const float* w_up_s = (const float*)d_in[21];
    const float* w_down_s = (const float*)d_in[22];
    float* out = (float*)d_out;
    WS ws = make_ws(d_ws);

    (void)hipMemsetAsync(ws.ctrl, 0, 65536, stream);
    k_mod<<<24, 256, 0, stream>>>(c, w_ada, b_ada, ws.mod);
    k_norm1<<<T / 4, 256, 0, stream>>>(x, norm_pre_mix, ws.mod, ws.h1);
    launch_gemm(stream, ws.h1, w_in, nullptr, ws.proj, nullptr, T, NIN, D, D, NIN, NIN, 0);
    k_conv<<<T * 512 / 256, 256, 0, stream>>>(ws.proj, conv_w, ws.a1);
    {
        static bool attr3 = false;
        if (!attr3) { (void)hipFuncSetAttribute((const void*)k_hgrn1, hipFuncAttributeMaxDynamicSharedMemorySize, HG_LDS_BYTES);
                      (void)hipFuncSetAttribute((const void*)k_hgrn3, hipFuncAttributeMaxDynamicSharedMemorySize, HG_LDS_BYTES); attr3 = true; }
        k_hgrn1<<<256, 512, HG_LDS_BYTES, stream>>>(ws.proj, hgrn_lb, ws.kcT, ws.dec);
        k_hgrn2<<<128, 512, 0, stream>>>(ws.kcT, ws.dec, ws.ST);
        k_hgrn3<<<256, 512, HG_LDS_BYTES, stream>>>(ws.proj, hgrn_lb, ws.ST, hgrn_norm_w, ws.ob);
    }
    launch_gemm(stream, ws.a1, w_conv_out, nullptr, ws.m, ws.proj, T, D, 512, 512, D, D, 2);
    launch_gemm(stream, ws.ob, w_hgrn_out, nullptr, ws.m, ws.proj, T, D, 512, 512, D, D, 3);
    launch_gemm(stream, ws.m, w_o, nullptr, ws.y, nullptr, T, D, D, D, D, D, 0);
    k_mid<<<T / 4, 256, 0, stream>>>(x, ws.y, norm_post_mix, norm_pre_ffn, ws.mod, out, ws.h2);
    launch_gemm(stream, ws.h2, w_router, nullptr, ws.logits, nullptr, T, E, D, D, E, E, 1);
    k_route<<<T / 4, 256, 0, stream>>>(ws.logits, router_bias, ws.eidx, ws.wsel, ws.ctrl);
    k_offsets<<<1, 64, 0, stream>>>(ws.ctrl, ws.offs, ws.items, ws.ctrl + 512, 256);
    k_fill<<<T * TOPK / 256, 256, 0, stream>>>(ws.eidx, ws.wsel, ws.offs, ws.ctrl + 256, ws.lslot, ws.lw);
    {
        static bool attr2 = false;
        if (!attr2) { (void)hipFuncSetAttribute((const void*)k_exp1_fast, hipFuncAttributeMaxDynamicSharedMemorySize, GEMM_LDS_BYTES);
                      (void)hipFuncSetAttribute((const void*)k_exp2_fast, hipFuncAttributeMaxDynamicSharedMemorySize, GEMM_LDS_BYTES); attr2 = true; }
        k_exp1_fast<<<256, 512, GEMM_LDS_BYTES, stream>>>(ws, w_gate_e, w_up_e);
        k_exp2_fast<<<256, 512, GEMM_LDS_BYTES, stream>>>(ws, w_down_e);
    }
    {
        launch_gemm(stream, ws.h2, w_gate_s, w_up_s, ws.acts, nullptr, T, 512, D, D, FF, FF, 4);
        launch_gemm(stream, ws.acts, w_down_s, nullptr, ws.shout, nullptr, T, D, FF, FF, D, D, 0);
    }
    k_final<<<T / 4, 256, 0, stream>>>(ws.shout, ws.yslot, norm_post_ffn, ws.mod, out);
}
```

```cpp
#include <hip/hip_runtime.h>
#include <stdint.h>
#include <string.h>
#include <stddef.h>

typedef unsigned short bf16_t;
#define DEV __device__ __forceinline__

constexpr int T = 16384, D = 1024, NIN = 5632, E = 256, FF = 256, TOPK = 8;
constexpr int OFF_CB = 0, OFF_CC = 512, OFF_CX = 1024, OFF_Q = 1536, OFF_F = 2048, OFF_I = 2560, OFF_G = 3072, OFF_GA = 3584, OFF_GB = 4608;
constexpr float EPS = 1e-6f;

DEV float bf2f(bf16_t v) { return __uint_as_float(((unsigned)v) << 16); }
DEV bf16_t f2bf(float f) { unsigned u = __float_as_uint(f); u += 0x7FFFu + ((u >> 16) & 1u); return (bf16_t)(u >> 16); }
DEV float sigmoidf_(float x) { return 1.f / (1.f + __expf(-x)); }
DEV float siluf_(float x) { return x / (1.f + __expf(-x)); }
DEV float wave_sum(float v) {
#pragma unroll
    for (int o = 32; o > 0; o >>= 1) v += __shfl_xor(v, o);
    return v;
}
DEV int opaque_tid() { int t = threadIdx.x; asm volatile("" : "+v"(t)); return t; }
DEV float lo_bf(unsigned u) { return __uint_as_float(u << 16); }
DEV float hi_bf(unsigned u) { return __uint_as_float(u & 0xffff0000u); }

#define XB_TMO      128
#define XB_XCNT(j)  (256  + 64 * (j))
#define XB_XSUB(j)  (1280 + 64 * (j))
#define XB_XGEN(j)  (2304 + 64 * (j))
#define XB_TOP      3328
#define XB_TOPGEN   3392
#define XCD_BAR_WORDS 3456
#define XB_SPIN_CAP (1u << 18)
#define LAS __attribute__((address_space(3)))
__device__ __forceinline__ unsigned xb_ld(unsigned* p)              { return __hip_atomic_load(p, __ATOMIC_RELAXED, __HIP_MEMORY_SCOPE_AGENT); }
__device__ __forceinline__ unsigned xb_add(unsigned* p, unsigned v) { return __hip_atomic_fetch_add(p, v, __ATOMIC_RELAXED, __HIP_MEMORY_SCOPE_AGENT); }
__device__ __forceinline__ unsigned xb_xcc_id() { return (unsigned)__builtin_amdgcn_s_getreg((3 << 11) | 20) & 0xFu; }
#define XB_SPIN(cond, bar) do { unsigned _sp = 0; while (cond) { __builtin_amdgcn_s_sleep(1); \
    if ((++_sp & 255u) == 0u) { if (xb_ld(&(bar)[XB_TMO])) break; if (_sp > XB_SPIN_CAP) { atomicAdd(&(bar)[XB_TMO], 1u); break; } } } } while (0)
struct XcdBarrier { unsigned* bar; unsigned x; volatile LAS unsigned* st; };
__device__ __forceinline__ XcdBarrier xcd_barrier_post(unsigned* bar, volatile LAS unsigned* st) {
    XcdBarrier b; b.bar = bar; b.x = xb_xcc_id(); b.st = st;
    if (threadIdx.x == 0) (void)xb_add(&bar[XB_XCNT(b.x)], 1u);
    return b;
}
__device__ __forceinline__ void xcd_barrier_complete(unsigned* bar, unsigned x, unsigned& nloc, unsigned& nx) {
    const unsigned G = gridDim.x * gridDim.y * gridDim.z;
    unsigned sum, cnt, mine, sp = 0u;
    for (;;) {
        sum = 0u; cnt = 0u; mine = 0u;
#pragma unroll
        for (unsigned j = 0; j < 16; ++j) { const unsigned c = xb_ld(&bar[XB_XCNT(j)]); sum += c; cnt += (c > 0u) ? 1u : 0u; mine = (j == x) ? c : mine; }
        if (sum == G) break;
        __builtin_amdgcn_s_sleep(1);
        if ((++sp & 255u) == 0u) { if (xb_ld(&bar[XB_TMO])) break; if (sp > XB_SPIN_CAP) { atomicAdd(&bar[XB_TMO], 1u); break; } }
    }
    nloc = mine > 0u ? mine : 1u; nx = cnt > 0u ? cnt : 1u;
}
__device__ __forceinline__ void xcd_barrier(const XcdBarrier& b) {
    asm volatile("s_waitcnt vmcnt(0)" ::: "memory");
    __syncthreads();
    if (threadIdx.x == 0) {
        unsigned* bar = b.bar;
        __builtin_amdgcn_s_waitcnt(0);
        unsigned nloc = b.st[0], nx = b.st[1];
        if (nloc == 0u) { xcd_barrier_complete(bar, b.x, nloc, nx); b.st[0] = nloc; b.st[1] = nx; }
        const unsigned old = xb_add(&bar[XB_XSUB(b.x)], 1u);
        const unsigned gen = old / nloc;
        if (old + 1u == (gen + 1u) * nloc) {
            __builtin_amdgcn_fence(__ATOMIC_RELEASE, "agent");
            asm volatile("s_waitcnt vmcnt(0)" ::: "memory");
            const unsigned og = xb_add(&bar[XB_TOP], 1u);
            const unsigned tg = og / nx;
            if (og + 1u == (tg + 1u) * nx) xb_add(&bar[XB_TOPGEN], 1u);
            else XB_SPIN(xb_ld(&bar[XB_TOPGEN]) == tg, bar);
            __builtin_amdgcn_fence(__ATOMIC_ACQUIRE, "agent");
            xb_add(&bar[XB_XGEN(b.x)], 1u);
            asm volatile("s_waitcnt vmcnt(0)" ::: "memory");
        } else {
            XB_SPIN(xb_ld(&bar[XB_XGEN(b.x)]) == gen, bar);
            __builtin_amdgcn_fence(__ATOMIC_ACQUIRE, "agent");
            asm volatile("s_waitcnt vmcnt(0)" ::: "memory");
        }
    }
    __syncthreads();
}

struct Params {
    const float *x, *c, *w_ada, *b_ada, *npm, *npostm, *w_in, *conv_w, *w_conv_out, *lbt, *hnw, *w_hgrn_out, *w_o, *npf, *npostf, *w_router, *rbias, *wge, *wue, *wde, *wgs, *wus, *wds;
    float* out;
    unsigned* bar;
    unsigned* counts;
    float* mod;
    bf16_t* h1;
    bf16_t* proj;
    float* kcT;
    float* dec;
    bf16_t* ST;
    bf16_t* a1;
    bf16_t* ob;
    bf16_t* m;
    bf16_t* y;
    bf16_t* h2;
    float* logits;
    int* lslot;
    float* lw;
    bf16_t* act;
    bf16_t* yslot;
    bf16_t* acts;
    bf16_t* shout;
};
typedef short bf16x8 __attribute__((ext_vector_type(8)));
typedef short s16x4 __attribute__((ext_vector_type(4)));
typedef float f32x4 __attribute__((ext_vector_type(4)));
#define LAS __attribute__((address_space(3)))
constexpr int GEMM_LDS_BYTES = 2 * (256 * 128 + 32768);

typedef __bf16 hwbf16x2 __attribute__((ext_vector_type(2)));
DEV unsigned pack_bf16x2(float lo, float hi) { hwbf16x2 v = {(__bf16)lo, (__bf16)hi}; return __builtin_bit_cast(unsigned, v); }

struct FAMapPlain { const bf16_t* A; int lda; int row0; DEV const bf16_t* operator()(int r) const { return A + (size_t)(row0 + r) * lda; } };
struct FAMapGather { const bf16_t* A; int lda; const int* lslot; int base; int cnt; int r0;
    DEV const bf16_t* operator()(int r) const { int rr = r0 + r; rr = rr < cnt ? rr : cnt - 1; return A + (size_t)(lslot[base + rr] >> 3) * lda; } };
struct FAMapSlot { const bf16_t* A; int lda; const int* lslot; int base; int cnt; int r0;
    DEV const bf16_t* operator()(int r) const { int rr = r0 + r; rr = rr < cnt ? rr : cnt - 1; return A + (size_t)lslot[base + rr] * lda; } };
struct FBMapPlain { const float* W; int ldb; int col0; DEV const float* ptr(int vb) const { return W + col0 + vb * 16; } DEV int ld() const { return ldb; } };
struct FBMapPair { const float* Wg; const float* Wu; int ldb; int col0;
    DEV const float* ptr(int vb) const { return Wg + (ptrdiff_t)(vb & 1) * (Wu - Wg) + col0 + (vb >> 1) * 16; } DEV int ld() const { return ldb; } };

template <int BM, class AMap, class BMap, class Epi>
DEV void gemm_unit(char* smem, const AMap& amap, const BMap& bmap, const Epi& epi, int K) {
    constexpr int NA = BM / 64, MI = BM / 32, ABYTES = BM * 128, STG = ABYTES + 32768;
    const int tid = opaque_tid(), lane = tid & 63, wid = tid >> 6, wr = wid >> 2, wc = wid & 3, fr = lane & 15, fq = lane >> 4;
    const bf16_t* aptr[NA];
#pragma unroll
    for (int i = 0; i < NA; ++i) { const int c = tid + 512 * i, row = c >> 3, pch = c & 7; aptr[i] = amap(row) + ((pch ^ (row & 7)) << 3); }
    const int g = lane >> 4, j16 = lane & 15, krow = j16 >> 2, c4 = j16 & 3, vg = wid & 3, kh = wid >> 2;
    const int ldb = bmap.ld();
    const float* bptr = bmap.ptr(vg * 4 + g) + 4 * c4 + (size_t)(4 * kh + krow) * ldb;
    unsigned bwr[2];
#pragma unroll
    for (int o = 0; o < 2; ++o) bwr[o] = ABYTES + (vg * 4 + g) * 256 + (((4 * kh + krow) ^ (o << 2)) * 32) + c4 * 8;
    unsigned ard[2];
#pragma unroll
    for (int ks = 0; ks < 2; ++ks) { const int row = wr * (BM / 2) + fr; ard[ks] = row * 128 + (((ks * 4 + fq) ^ (row & 7)) << 4); }
    unsigned brd[2];
    { const int q = j16 >> 2, p = j16 & 3;
#pragma unroll
      for (int t = 0; t < 2; ++t) brd[t] = ABYTES + (fq * 16) * 256 + (((4 * t + q) ^ ((fq & 1) << 2)) * 32) + p * 8; }

    f32x4 acc[MI][4];
#pragma unroll
    for (int mi = 0; mi < MI; ++mi)
#pragma unroll
        for (int nf = 0; nf < 4; ++nf) acc[mi][nf] = (f32x4){0.f, 0.f, 0.f, 0.f};

    float4 breg[4];
    const int nk = K >> 6;
#define G_LOAD_A(kt, buf) do { _Pragma("unroll") for (int i = 0; i < NA; ++i) \
        __builtin_amdgcn_global_load_lds((const unsigned*)(aptr[i] + (kt) * 64), (LAS unsigned*)(smem + (buf) * STG + (tid + 512 * i) * 16), 16, 0, 0); } while (0)
#define G_LOAD_B(kt, h) do { _Pragma("unroll") for (int i = 0; i < 4; ++i) breg[i] = *(const float4*)(bptr + (size_t)((kt) * 64 + 8 * ((h) * 4 + i)) * ldb); } while (0)
#define G_WRITE_B(buf, h) do { char* sb_ = smem + (buf) * STG; \
        _Pragma("unroll") for (int i = 0; i < 4; ++i) { uint2 w; w.x = pack_bf16x2(breg[i].x, breg[i].y); w.y = pack_bf16x2(breg[i].z, breg[i].w); \
            *(uint2*)(sb_ + bwr[i & 1] + ((h) * 4 + i) * 16 * 256) = w; } } while (0)
#define G_COMPUTE(sb, ks) do { bf16x8 bf[4]; \
        _Pragma("unroll") for (int nf = 0; nf < 4; ++nf) { \
            const int nb = (nf >> 1) * 8 + wc * 2 + (nf & 1); const unsigned base = (ks) * 4 * 16 * 256 + nb * 256; \
            s16x4 t0 = __builtin_amdgcn_ds_read_tr16_b64_v4i16((LAS s16x4*)((sb) + brd[0] + base)); \
            s16x4 t1 = __builtin_amdgcn_ds_read_tr16_b64_v4i16((LAS s16x4*)((sb) + brd[1] + base)); \
            bf[nf] = (bf16x8){t0[0], t0[1], t0[2], t0[3], t1[0], t1[1], t1[2], t1[3]}; } \
        _Pragma("unroll") for (int mi = 0; mi < MI; ++mi) { \
            const bf16x8 af = *(const bf16x8*)((sb) + ard[ks] + mi * 16 * 128); \
            _Pragma("unroll") for (int nf = 0; nf < 4; ++nf) acc[mi][nf] = __builtin_amdgcn_mfma_f32_16x16x32_bf16(bf[nf], af, acc[mi][nf], 0, 0, 0); } } while (0)
    G_LOAD_A(0, 0); G_LOAD_B(0, 0); G_WRITE_B(0, 0); G_LOAD_B(0, 1); G_WRITE_B(0, 1);
    __syncthreads();
    for (int kt = 0; kt < nk; ++kt) {
        const bool more = kt + 1 < nk;
        const char* sb = smem + (kt & 1) * STG;
        if (more) { G_LOAD_A(kt + 1, (kt + 1) & 1); G_LOAD_B(kt + 1, 0); }
        G_COMPUTE(sb, 0);
        if (more) { G_WRITE_B((kt + 1) & 1, 0); G_LOAD_B(kt + 1, 1); }
        G_COMPUTE(sb, 1);
        if (more) { G_WRITE_B((kt + 1) & 1, 1); }
        __syncthreads();
    }
#undef G_LOAD_A
#undef G_LOAD_B
#undef G_WRITE_B
#undef G_COMPUTE
#pragma unroll
    for (int mi = 0; mi < MI; ++mi)
#pragma unroll
        for (int bj = 0; bj < 2; ++bj) epi(wr * (BM / 2) + mi * 16 + fr, bj * 128 + wc * 32 + 4 * fq, acc[mi][bj * 2], acc[mi][bj * 2 + 1]);
}

struct FEpiStoreBf16 { bf16_t* C; int ldc; int row0; int col0;
    DEV void operator()(int r, int c, f32x4 v0, f32x4 v1) const { bf16_t* p = C + (size_t)(row0 + r) * ldc + col0 + c;
        uint2 a, b; a.x = pack_bf16x2(v0[0], v0[1]); a.y = pack_bf16x2(v0[2], v0[3]); b.x = pack_bf16x2(v1[0], v1[1]); b.y = pack_bf16x2(v1[2], v1[3]);
        *(uint2*)p = a; *(uint2*)(p + 16) = b; } };
struct FEpiStoreF32 { float* C; int ldc; int row0; int col0;
    DEV void operator()(int r, int c, f32x4 v0, f32x4 v1) const { float* p = C + (size_t)(row0 + r) * ldc + col0 + c; *(f32x4*)p = v0; *(f32x4*)(p + 16) = v1; } };
struct FEpiGateA { bf16_t* M; const bf16_t* proj; int row0; int col0;
    DEV void one(int r, int c, f32x4 v) const { const size_t row = row0 + r; const uint2 gr = *(const uint2*)(proj + row * NIN + OFF_GA + col0 + c);
        float g0 = sigmoidf_(__uint_as_float(gr.x << 16)), g1 = sigmoidf_(__uint_as_float(gr.x & 0xffff0000u)), g2 = sigmoidf_(__uint_as_float(gr.y << 16)), g3 = sigmoidf_(__uint_as_float(gr.y & 0xffff0000u));
        uint2 o; o.x = pack_bf16x2(g0 * v[0], g1 * v[1]); o.y = pack_bf16x2(g2 * v[2], g3 * v[3]); *(uint2*)(M + row * D + col0 + c) = o; }
    DEV void operator()(int r, int c, f32x4 v0, f32x4 v1) const { one(r, c, v0); one(r, c + 16, v1); } };
struct FEpiGateB { bf16_t* M; const bf16_t* proj; int row0; int col0;
    DEV void one(int r, int c, f32x4 v) const { const size_t row = row0 + r; const uint2 gr = *(const uint2*)(proj + row * NIN + OFF_GB + col0 + c);
        const uint2 mo = *(const uint2*)(M + row * D + col0 + c);
        float g0 = sigmoidf_(__uint_as_float(gr.x << 16)), g1 = sigmoidf_(__uint_as_float(gr.x & 0xffff0000u)), g2 = sigmoidf_(__uint_as_float(gr.y << 16)), g3 = sigmoidf_(__uint_as_float(gr.y & 0xffff0000u));
        float m0 = __uint_as_float(mo.x << 16), m1 = __uint_as_float(mo.x & 0xffff0000u), m2 = __uint_as_float(mo.y << 16), m3 = __uint_as_float(mo.y & 0xffff0000u);
        uint2 o; o.x = pack_bf16x2(m0 + g0 * v[0], m1 + g1 * v[1]); o.y = pack_bf16x2(m2 + g2 * v[2], m3 + g3 * v[3]); *(uint2*)(M + row * D + col0 + c) = o; }
    DEV void operator()(int r, int c, f32x4 v0, f32x4 v1) const { one(r, c, v0); one(r, c + 16, v1); } };
struct FEpiSwiGLU { bf16_t* act; int row0; int col0;
    DEV void operator()(int r, int c, f32x4 g, f32x4 u) const {
        uint2 o; o.x = pack_bf16x2(siluf_(g[0]) * u[0], siluf_(g[1]) * u[1]); o.y = pack_bf16x2(siluf_(g[2]) * u[2], siluf_(g[3]) * u[3]);
        *(uint2*)(act + (size_t)(row0 + r) * FF + col0 + (c >> 5) * 16 + (c & 15)) = o; } };
struct FEpiSwiGLUSlot { bf16_t* act; const int* lslot; int base; int cnt; int r0; int col0;
    DEV void operator()(int r, int c, f32x4 g, f32x4 u) const { const int rr = r0 + r; if (rr < cnt) {
        uint2 o; o.x = pack_bf16x2(siluf_(g[0]) * u[0], siluf_(g[1]) * u[1]); o.y = pack_bf16x2(siluf_(g[2]) * u[2], siluf_(g[3]) * u[3]);
        *(uint2*)(act + (size_t)lslot[base + rr] * FF + col0 + (c >> 5) * 16 + (c & 15)) = o; } } };
struct FEpiSlot { bf16_t* yslot; const int* lslot; const float* lw; int base; int cnt; int r0; int col0;
    DEV void operator()(int r, int c, f32x4 v0, f32x4 v1) const { const int rr = r0 + r; if (rr < cnt) { const int s = lslot[base + rr]; const float w = lw[base + rr];
        bf16_t* p = yslot + (size_t)s * D + col0 + c; uint2 a, b; a.x = pack_bf16x2(w * v0[0], w * v0[1]); a.y = pack_bf16x2(w * v0[2], w * v0[3]); b.x = pack_bf16x2(w * v1[0], w * v1[1]); b.y = pack_bf16x2(w * v1[2], w * v1[3]);
        *(uint2*)p = a; *(uint2*)(p + 16) = b; } } };

DEV unsigned sw128(int row, int chunk) { return (unsigned)(row * 128 + ((chunk ^ (row & 7)) << 4)); }
DEV unsigned sw256(int row, int chunk) { return (unsigned)(row * 256 + ((chunk ^ (row & 15)) << 4)); }
constexpr int HG_LDS_BYTES = 96 * 1024;

DEV void hgrn_gates(const bf16_t* proj, const float* lbt, int t0, int h, int d, int seg, float* red, float (&fgv)[16], float (&b)[16], float& blast) {
    const float a0 = lbt[h * 128 + d], a1 = lbt[512 + h * 128 + d];
    const float lb = 1.f / (1.f + __expf(a1 - a0));
    float run = 0.f;
#pragma unroll
    for (int i = 0; i < 16; ++i) {
        const float f = bf2f(proj[(size_t)(t0 + 16 * seg + i) * NIN + OFF_F + h * 128 + d]);
        const float fg = lb + (1.f - lb) * sigmoidf_(f);
        fgv[i] = fg; run += __logf(fg); b[i] = run;
    }
    red[seg * 128 + d] = run;
    __syncthreads();
    const float r0 = red[d], r1 = red[128 + d], r2 = red[256 + d], r3 = red[384 + d];
    const float pre = (seg > 0 ? r0 : 0.f) + (seg > 1 ? r1 : 0.f) + (seg > 2 ? r2 : 0.f);
    blast = r0 + r1 + r2 + r3;
#pragma unroll
    for (int i = 0; i < 16; ++i) b[i] += pre;
}
DEV void pack16_store(char* smem, unsigned a0, unsigned a1, const float (&v)[16]) {
    uint4 lo, hi;
    lo.x = pack_bf16x2(v[0], v[1]); lo.y = pack_bf16x2(v[2], v[3]); lo.z = pack_bf16x2(v[4], v[5]); lo.w = pack_bf16x2(v[6], v[7]);
    hi.x = pack_bf16x2(v[8], v[9]); hi.y = pack_bf16x2(v[10], v[11]); hi.z = pack_bf16x2(v[12], v[13]); hi.w = pack_bf16x2(v[14], v[15]);
    *(uint4*)(smem + a0) = lo; *(uint4*)(smem + a1) = hi;
}

DEV void hgrn_phase1(char* smem, const bf16_t* proj, const float* lbt, float* kcT, float* dec, int c, int h) {
    const int tid = opaque_tid(), d = tid & 127, seg = tid >> 7, t0 = c * 64;
    const int lane = tid & 63, w = tid >> 6, fr = lane & 15, fq = lane >> 4;
    float* red = (float*)(smem + 32768);
    float fgv[16], b[16], blast;
    hgrn_gates(proj, lbt, t0, h, d, seg, red, fgv, b, blast);
    float kd[16], vv[16];
#pragma unroll
    for (int i = 0; i < 16; ++i) {
        kd[i] = (1.f - fgv[i]) * __expf(blast - b[i]);
        vv[i] = bf2f(proj[(size_t)(t0 + 16 * seg + i) * NIN + OFF_I + h * 128 + d]);
    }
    pack16_store(smem, sw128(d, 2 * seg), sw128(d, 2 * seg + 1), kd);
    pack16_store(smem + 16384, sw128(d, 2 * seg), sw128(d, 2 * seg + 1), vv);
    if (seg == 3) dec[(size_t)(c * 4 + h) * 128 + d] = __expf(blast);
    __syncthreads();
    f32x4 acc[8];
#pragma unroll
    for (int nv = 0; nv < 8; ++nv) acc[nv] = (f32x4){0.f, 0.f, 0.f, 0.f};
#pragma unroll
    for (int ks = 0; ks < 2; ++ks) {
        const bf16x8 xf = *(const bf16x8*)(smem + sw128(16 * w + fr, ks * 4 + fq));
#pragma unroll
        for (int nv = 0; nv < 8; ++nv) {
            const bf16x8 yf = *(const bf16x8*)(smem + 16384 + sw128(16 * nv + fr, ks * 4 + fq));
            acc[nv] = __builtin_amdgcn_mfma_f32_16x16x32_bf16(xf, yf, acc[nv], 0, 0, 0);
        }
    }
    float* out = kcT + (size_t)(c * 4 + h) * 16384;
#pragma unroll
    for (int nv = 0; nv < 8; ++nv) *(f32x4*)(out + (16 * nv + fr) * 128 + 16 * w + 4 * fq) = acc[nv];
    __syncthreads();
}

DEV void hgrn_phase2(const float* kcT, const float* dec, bf16_t* ST, int e) {
    const int h = e >> 14, d = e & 127;
    float S = 0.f;
    for (int c0 = 0; c0 < 256; c0 += 16) {
        float kc[16], dc[16];
#pragma unroll
        for (int i = 0; i < 16; ++i) { kc[i] = kcT[(size_t)(c0 + i) * 65536 + e]; dc[i] = dec[(size_t)((c0 + i) * 4 + h) * 128 + d]; }
#pragma unroll
        for (int i = 0; i < 16; ++i) { ST[(size_t)(c0 + i) * 65536 + e] = f2bf(S); S = dc[i] * S + kc[i]; }
    }
}

DEV void hgrn_phase3(char* smem, const bf16_t* proj, const float* lbt, const bf16_t* ST, const float* hw, bf16_t* ob, int c, int h) {
    constexpr int O_QT = 0, O_KT = 16384, O_VT = 32768, O_ST = 49152, O_AT = 81920, O_RED = 90112, O_SSQ = 92160;
    const int tid = opaque_tid(), d = tid & 127, seg = tid >> 7, t0 = c * 64;
    const int lane = tid & 63, w = tid >> 6, fr = lane & 15, fq = lane >> 4;
    {
        float fgv[16], b[16], blast;
        hgrn_gates(proj, lbt, t0, h, d, seg, (float*)(smem + O_RED), fgv, b, blast);
        float vv[16];
#pragma unroll
        for (int i = 0; i < 16; ++i) {
            const int t = 16 * seg + i;
            const float qv = bf2f(proj[(size_t)(t0 + t) * NIN + OFF_Q + h * 128 + d]);
            const float eb = __expf(b[i]);
            const float qt = siluf_(qv) * eb, kt = (1.f - fgv[i]) / eb;
            const unsigned off = sw256(t, d >> 3) + (d & 7) * 2;
            *(bf16_t*)(smem + O_QT + off) = f2bf(qt);
            *(bf16_t*)(smem + O_KT + off) = f2bf(kt);
            vv[i] = bf2f(proj[(size_t)(t0 + t) * NIN + OFF_I + h * 128 + d]);
        }
        pack16_store(smem + O_VT, sw128(d, 2 * seg), sw128(d, 2 * seg + 1), vv);
        const bf16_t* sp = ST + (size_t)(c * 4 + h) * 16384;
#pragma unroll
        for (int i = 0; i < 4; ++i) { const int idx = tid + 512 * i, row = idx >> 4, ch = idx & 15; *(uint4*)(smem + O_ST + sw256(row, ch)) = *(const uint4*)(sp + row * 128 + ch * 8); }
    }
    __syncthreads();
    {
        const int tb = w & 3;
#pragma unroll
        for (int u = 0; u < 2; ++u) {
            const int sb = (w >> 2) * 2 + u;
            f32x4 acc = (f32x4){0.f, 0.f, 0.f, 0.f};
            if (sb <= tb) {
#pragma unroll
                for (int ks = 0; ks < 4; ++ks) {
                    const bf16x8 xf = *(const bf16x8*)(smem + O_KT + sw256(16 * sb + fr, ks * 4 + fq));
                    const bf16x8 yf = *(const bf16x8*)(smem + O_QT + sw256(16 * tb + fr, ks * 4 + fq));
                    acc = __builtin_amdgcn_mfma_f32_16x16x32_bf16(xf, yf, acc, 0, 0, 0);
                }
                const int t = 16 * tb + fr, s0 = 16 * sb + 4 * fq;
#pragma unroll
                for (int jj = 0; jj < 4; ++jj) if (s0 + jj > t) acc[jj] = 0.f;
            }
            uint2 o; o.x = pack_bf16x2(acc[0], acc[1]); o.y = pack_bf16x2(acc[2], acc[3]);
            *(uint2*)(smem + O_AT + sw128(16 * tb + fr, 2 * sb + (fq >> 1)) + 8 * (fq & 1)) = o;
        }
    }
    __syncthreads();
    const int tb = w & 3, vh = w >> 2;
    f32x4 acc[4];
#pragma unroll
    for (int n = 0; n < 4; ++n) acc[n] = (f32x4){0.f, 0.f, 0.f, 0.f};
#pragma unroll
    for (int ks = 0; ks < 2; ++ks) {
        const bf16x8 yf = *(const bf16x8*)(smem + O_AT + sw128(16 * tb + fr, ks * 4 + fq));
#pragma unroll
        for (int n = 0; n < 4; ++n) {
            const bf16x8 xf = *(const bf16x8*)(smem + O_VT + sw128(16 * (4 * vh + n) + fr, ks * 4 + fq));
            acc[n] = __builtin_amdgcn_mfma_f32_16x16x32_bf16(xf, yf, acc[n], 0, 0, 0);
        }
    }
#pragma unroll
    for (int ks = 0; ks < 4; ++ks) {
        const bf16x8 yf = *(const bf16x8*)(smem + O_QT + sw256(16 * tb + fr, ks * 4 + fq));
#pragma unroll
        for (int n = 0; n < 4; ++n) {
            const bf16x8 xf = *(const bf16x8*)(smem + O_ST + sw256(16 * (4 * vh + n) + fr, ks * 4 + fq));
            acc[n] = __builtin_amdgcn_mfma_f32_16x16x32_bf16(xf, yf, acc[n], 0, 0, 0);
        }
    }
    float ss = 0.f;
#pragma unroll
    for (int n = 0; n < 4; ++n)
#pragma unroll
        for (int jj = 0; jj < 4; ++jj) ss += acc[n][jj] * acc[n][jj];
    ss += __shfl_xor(ss, 16); ss += __shfl_xor(ss, 32);
    float* ssq = (float*)(smem + O_SSQ);
    if (fq == 0) ssq[vh * 64 + 16 * tb + fr] = ss;
    __syncthreads();
    const float tot = ssq[16 * tb + fr] + ssq[64 + 16 * tb + fr];
    const float rs = rsqrtf(tot * (1.f / 128.f) + EPS);
    const size_t trow = (size_t)(t0 + 16 * tb + fr);
#pragma unroll
    for (int n = 0; n < 4; ++n) {
        const int v0 = 16 * (4 * vh + n) + 4 * fq;
        const uint2 gr = *(const uint2*)(proj + trow * NIN + OFF_G + h * 128 + v0);
        const f32x4 wv = *(const f32x4*)(hw + v0);
        const float g0 = siluf_(__uint_as_float(gr.x << 16)), g1 = siluf_(__uint_as_float(gr.x & 0xffff0000u)), g2 = siluf_(__uint_as_float(gr.y << 16)), g3 = siluf_(__uint_as_float(gr.y & 0xffff0000u));
        uint2 o; o.x = pack_bf16x2(acc[n][0] * rs * wv[0] * g0, acc[n][1] * rs * wv[1] * g1); o.y = pack_bf16x2(acc[n][2] * rs * wv[2] * g2, acc[n][3] * rs * wv[3] * g3);
        *(uint2*)(ob + trow * 512 + h * 128 + v0) = o;
    }
    __syncthreads();
}


constexpr int LDS_BAR_OFF = GEMM_LDS_BYTES;
constexpr int LDS_PREF_OFF = GEMM_LDS_BYTES + 256;
constexpr int LDS_TOTAL = GEMM_LDS_BYTES + 256 + 2048;

DEV void phase_mod(const Params& p, char* smem) {
    const int tid = opaque_tid(), ks = tid >> 3, sub = tid & 7;
    float* red = (float*)smem;
    for (int cb = blockIdx.x; cb < 256; cb += gridDim.x) {
        const int j0 = cb * 24;
        float a0 = 0.f, a1 = 0.f, a2 = 0.f;
#pragma unroll 4
        for (int i = 0; i < 16; ++i) {
            const int k = ks + 64 * i;
            const float sc = siluf_(p.c[k]);
            const float* w = p.w_ada + (size_t)k * (6 * D) + j0 + 3 * sub;
            a0 += sc * w[0]; a1 += sc * w[1]; a2 += sc * w[2];
        }
        red[ks * 24 + 3 * sub] = a0; red[ks * 24 + 3 * sub + 1] = a1; red[ks * 24 + 3 * sub + 2] = a2;
        __syncthreads();
        if (tid < 24) { float sacc = p.b_ada[j0 + tid]; for (int q = 0; q < 64; ++q) sacc += red[q * 24 + tid]; p.mod[j0 + tid] = sacc; }
        __syncthreads();
    }
}

DEV void phase_norm1(const Params& p) {
    const int tid_ = opaque_tid(), lane = tid_ & 63, gw = blockIdx.x * 8 + (tid_ >> 6), nw = gridDim.x * 8;
    for (int row = gw; row < T; row += nw) {
        const float* xr = p.x + (size_t)row * D;
        float4 v[4]; float ss = 0.f;
#pragma unroll
        for (int i = 0; i < 4; ++i) { v[i] = *(const float4*)(xr + i * 256 + lane * 4); ss += v[i].x * v[i].x + v[i].y * v[i].y + v[i].z * v[i].z + v[i].w * v[i].w; }
        ss = wave_sum(ss);
        const float rs = rsqrtf(ss * (1.f / D) + EPS);
#pragma unroll
        for (int i = 0; i < 4; ++i) {
            const int c = i * 256 + lane * 4;
            const float4 w = *(const float4*)(p.npm + c), sc = *(const float4*)(p.mod + D + c), sh = *(const float4*)(p.mod + c);
            uint2 o; o.x = pack_bf16x2(v[i].x * rs * w.x * (1.f + sc.x) + sh.x, v[i].y * rs * w.y * (1.f + sc.y) + sh.y);
            o.y = pack_bf16x2(v[i].z * rs * w.z * (1.f + sc.z) + sh.z, v[i].w * rs * w.w * (1.f + sc.w) + sh.w);
            *(uint2*)(p.h1 + (size_t)row * D + c) = o;
        }
    }
}

DEV void phase_conv(const Params& p) {
    const int gt = blockIdx.x * 512 + opaque_tid(), nt = gridDim.x * 512;
    for (int idx = gt; idx < T * 64; idx += nt) {
        const int t = idx >> 6, c8 = (idx & 63) * 8;
        float acc[8];
#pragma unroll
        for (int q = 0; q < 8; ++q) acc[q] = 0.f;
#pragma unroll
        for (int j = 0; j < 3; ++j) {
            const int tt = t - 2 + j;
            if (tt >= 0) {
                const uint4 cc = *(const uint4*)(p.proj + (size_t)tt * NIN + OFF_CC + c8), cx = *(const uint4*)(p.proj + (size_t)tt * NIN + OFF_CX + c8);
                const float4 w0 = *(const float4*)(p.conv_w + j * 512 + c8), w1 = *(const float4*)(p.conv_w + j * 512 + c8 + 4);
                acc[0] += w0.x * lo_bf(cc.x) * lo_bf(cx.x); acc[1] += w0.y * hi_bf(cc.x) * hi_bf(cx.x);
                acc[2] += w0.z * lo_bf(cc.y) * lo_bf(cx.y); acc[3] += w0.w * hi_bf(cc.y) * hi_bf(cx.y);
                acc[4] += w1.x * lo_bf(cc.z) * lo_bf(cx.z); acc[5] += w1.y * hi_bf(cc.z) * hi_bf(cx.z);
                acc[6] += w1.z * lo_bf(cc.w) * lo_bf(cx.w); acc[7] += w1.w * hi_bf(cc.w) * hi_bf(cx.w);
            }
        }
        const uint4 cb = *(const uint4*)(p.proj + (size_t)t * NIN + OFF_CB + c8);
        uint4 o;
        o.x = pack_bf16x2(lo_bf(cb.x) * acc[0], hi_bf(cb.x) * acc[1]); o.y = pack_bf16x2(lo_bf(cb.y) * acc[2], hi_bf(cb.y) * acc[3]);
        o.z = pack_bf16x2(lo_bf(cb.z) * acc[4], hi_bf(cb.z) * acc[5]); o.w = pack_bf16x2(lo_bf(cb.w) * acc[6], hi_bf(cb.w) * acc[7]);
        *(uint4*)(p.a1 + (size_t)t * 512 + c8) = o;
    }
}

DEV void phase_mid(const Params& p) {
    const int tid_ = opaque_tid(), lane = tid_ & 63, gw = blockIdx.x * 8 + (tid_ >> 6), nw = gridDim.x * 8;
    for (int row = gw; row < T; row += nw) {
        float yv[16], xv[16]; float ss = 0.f;
#pragma unroll
        for (int i = 0; i < 4; ++i) {
            const uint2 r = *(const uint2*)(p.y + (size_t)row * D + i * 256 + lane * 4);
            yv[4 * i] = lo_bf(r.x); yv[4 * i + 1] = hi_bf(r.x); yv[4 * i + 2] = lo_bf(r.y); yv[4 * i + 3] = hi_bf(r.y);
#pragma unroll
            for (int j = 0; j < 4; ++j) ss += yv[4 * i + j] * yv[4 * i + j];
        }
        ss = wave_sum(ss);
        const float rs = rsqrtf(ss * (1.f / D) + EPS);
        float ss2 = 0.f;
#pragma unroll
        for (int i = 0; i < 4; ++i) {
            const int c = i * 256 + lane * 4;
            const float4 xx = *(const float4*)(p.x + (size_t)row * D + c), g1 = *(const float4*)(p.mod + 2 * D + c), w = *(const float4*)(p.npostm + c);
            float4 o;
            o.x = xx.x + g1.x * (yv[4 * i] * rs * w.x); o.y = xx.y + g1.y * (yv[4 * i + 1] * rs * w.y); o.z = xx.z + g1.z * (yv[4 * i + 2] * rs * w.z); o.w = xx.w + g1.w * (yv[4 * i + 3] * rs * w.w);
            xv[4 * i] = o.x; xv[4 * i + 1] = o.y; xv[4 * i + 2] = o.z; xv[4 * i + 3] = o.w;
            ss2 += o.x * o.x + o.y * o.y + o.z * o.z + o.w * o.w;
            *(float4*)(p.out + (size_t)row * D + c) = o;
        }
        ss2 = wave_sum(ss2);
        const float rs2 = rsqrtf(ss2 * (1.f / D) + EPS);
#pragma unroll
        for (int i = 0; i < 4; ++i) {
            const int c = i * 256 + lane * 4;
            const float4 w = *(const float4*)(p.npf + c), sc = *(const float4*)(p.mod + 4 * D + c), sh = *(const float4*)(p.mod + 3 * D + c);
            uint2 o; o.x = pack_bf16x2(xv[4 * i] * rs2 * w.x * (1.f + sc.x) + sh.x, xv[4 * i + 1] * rs2 * w.y * (1.f + sc.y) + sh.y);
            o.y = pack_bf16x2(xv[4 * i + 2] * rs2 * w.z * (1.f + sc.z) + sh.z, xv[4 * i + 3] * rs2 * w.w * (1.f + sc.w) + sh.w);
            *(uint2*)(p.h2 + (size_t)row * D + c) = o;
        }
    }
}

DEV void phase_route(const Params& p) {
    const int tid_ = opaque_tid(), lane = tid_ & 63, gw = blockIdx.x * 8 + (tid_ >> 6), nw = gridDim.x * 8;
    const float4 rb = *(const float4*)(p.rbias + lane * 4);
    for (int t = gw; t < T; t += nw) {
        const float4 lg = *(const float4*)(p.logits + (size_t)t * E + lane * 4);
        float s[4] = {sigmoidf_(lg.x), sigmoidf_(lg.y), sigmoidf_(lg.z), sigmoidf_(lg.w)};
        float sel[4] = {s[0] + rb.x, s[1] + rb.y, s[2] + rb.z, s[3] + rb.w};
        float m1 = -INFINITY, m2 = -INFINITY;
#pragma unroll
        for (int i = 0; i < 4; ++i) { const float v = sel[i]; if (v > m1) { m2 = m1; m1 = v; } else if (v > m2) m2 = v; }
#pragma unroll
        for (int o = 1; o < 8; o <<= 1) { const float o1 = __shfl_xor(m1, o), o2 = __shfl_xor(m2, o); const float n1 = fmaxf(m1, o1), n2 = fmaxf(fminf(m1, o1), fmaxf(m2, o2)); m1 = n1; m2 = n2; }
        const float gs = m1 + m2; const int g = lane >> 3;
        int rank = 0;
#pragma unroll
        for (int j = 0; j < 8; ++j) { const float gj = __shfl(gs, j * 8); rank += (gj > gs || (gj == gs && j < g)) ? 1 : 0; }
        const bool gsel = rank < 4;
        float val[4];
#pragma unroll
        for (int i = 0; i < 4; ++i) val[i] = gsel ? sel[i] : -INFINITY;
        float wk = 0.f; int ek = 0; float wsum = 0.f;
        for (int r = 0; r < TOPK; ++r) {
            float bv = -INFINITY; int bi = lane * 4;
#pragma unroll
            for (int i = 0; i < 4; ++i) if (val[i] > bv) { bv = val[i]; bi = lane * 4 + i; }
#pragma unroll
            for (int o = 1; o < 64; o <<= 1) { const float ov = __shfl_xor(bv, o); const int oi = __shfl_xor(bi, o); if (ov > bv || (ov == bv && oi < bi)) { bv = ov; bi = oi; } }
            const int owner = bi >> 2, sub = bi & 3;
            float sv = sub == 0 ? s[0] : sub == 1 ? s[1] : sub == 2 ? s[2] : s[3];
            sv = __shfl(sv, owner);
            if (lane == owner) {
#pragma unroll
                for (int i = 0; i < 4; ++i) if (i == sub) val[i] = -INFINITY;
            }
            wsum += sv;
            if (lane == r) { wk = sv; ek = bi; }
        }
        if (lane < TOPK) {
            const int pos = (int)atomicAdd(&p.counts[ek], 1u);
            p.lslot[(size_t)ek * T + pos] = t * TOPK + lane;
            p.lw[(size_t)ek * T + pos] = wk / (wsum + 1e-20f) * 2.5f;
        }
    }
}

DEV void phase_final(const Params& p) {
    const int tid_ = opaque_tid(), lane = tid_ & 63, gw = blockIdx.x * 8 + (tid_ >> 6), nw = gridDim.x * 8;
    for (int row = gw; row < T; row += nw) {
        float mv[16]; float ss = 0.f;
#pragma unroll
        for (int i = 0; i < 4; ++i) {
            const int c = i * 256 + lane * 4;
            const uint2 r = *(const uint2*)(p.shout + (size_t)row * D + c);
            float a0 = lo_bf(r.x), a1 = hi_bf(r.x), a2 = lo_bf(r.y), a3 = hi_bf(r.y);
#pragma unroll
            for (int k = 0; k < TOPK; ++k) { const uint2 q = *(const uint2*)(p.yslot + ((size_t)row * TOPK + k) * D + c); a0 += lo_bf(q.x); a1 += hi_bf(q.x); a2 += lo_bf(q.y); a3 += hi_bf(q.y); }
            mv[4 * i] = a0; mv[4 * i + 1] = a1; mv[4 * i + 2] = a2; mv[4 * i + 3] = a3;
            ss += a0 * a0 + a1 * a1 + a2 * a2 + a3 * a3;
        }
        ss = wave_sum(ss);
        const float rs = rsqrtf(ss * (1.f / D) + EPS);
#pragma unroll
        for (int i = 0; i < 4; ++i) {
            const int c = i * 256 + lane * 4;
            float4 o = *(const float4*)(p.out + (size_t)row * D + c);
            const float4 g2 = *(const float4*)(p.mod + 5 * D + c), w = *(const float4*)(p.npostf + c);
            o.x += g2.x * (mv[4 * i] * rs * w.x); o.y += g2.y * (mv[4 * i + 1] * rs * w.y); o.z += g2.z * (mv[4 * i + 2] * rs * w.z); o.w += g2.w * (mv[4 * i + 3] * rs * w.w);
            *(float4*)(p.out + (size_t)row * D + c) = o;
        }
    }
}

DEV bool dense_unit(int r, int nM, int nN, int& pm, int& pn) {
    const int b = blockIdx.x, G = gridDim.x;
    if ((G & 7) == 0 && (nM & 7) == 0) {
        const int per = nM >> 3, nlb = G >> 3, li = r * nlb + (b >> 3);
        if (li >= per * nN) return false;
        pm = (b & 7) * per + li % per; pn = li / per; return true;
    }
    const int u = r * G + b; if (u >= nM * nN) return false;
    pm = u / nN; pn = u % nN; return true;
}

DEV void build_pref(const Params& p, char* smem) {
    int* sp = (int*)(smem + LDS_PREF_OFF);
    const int tid = opaque_tid();
    if (tid < 256) sp[tid + 1] = (int)((p.counts[tid] + 255u) >> 8);
    if (tid == 0) sp[0] = 0;
    __syncthreads();
    for (int off = 1; off < 256; off <<= 1) {
        int v = 0;
        if (tid < 256 && tid + 1 - off >= 1) v = sp[tid + 1 - off];
        __syncthreads();
        if (tid < 256) sp[tid + 1] += v;
        __syncthreads();
    }
}
DEV int find_expert(const int* sp, int item) {
    int lo = 0, hi = 256;
    while (hi - lo > 1) { const int mid = (lo + hi) >> 1; if (sp[mid] <= item) lo = mid; else hi = mid; }
    return lo;
}

__global__ void __launch_bounds__(512, 2) k_mega(Params p) {
    extern __shared__ __attribute__((aligned(16))) char smem[];
    volatile LAS unsigned* st = (volatile LAS unsigned*)(smem + LDS_BAR_OFF);
    if (threadIdx.x == 0) { st[0] = 0u; st[1] = 0u; st[2] = 0u; st[3] = 0u; }
    __syncthreads();
    const XcdBarrier bar = xcd_barrier_post(p.bar, st);

    phase_mod(p, smem);
    xcd_barrier(bar);
    phase_norm1(p);
    xcd_barrier(bar);
    for (int r = 0;; ++r) { int pm, pn; if (!dense_unit(r, T / 256, NIN / 256, pm, pn)) break;
        gemm_unit<256>(smem, FAMapPlain{p.h1, D, pm * 256}, FBMapPlain{p.w_in, NIN, pn * 256}, FEpiStoreBf16{p.proj, NIN, pm * 256, pn * 256}, D); __syncthreads(); }
    xcd_barrier(bar);
    phase_conv(p);
    for (int u = blockIdx.x; u < 1024; u += gridDim.x) hgrn_phase1(smem, p.proj, p.lbt, p.kcT, p.dec, u >> 2, u & 3);
    xcd_barrier(bar);
    {
        const int G = gridDim.x, b = blockIdx.x;
        const int nscan = G >= 256 ? 128 : G;
        if (b < nscan) for (int e = b * 512 + opaque_tid(); e < 65536; e += nscan * 512) hgrn_phase2(p.kcT, p.dec, p.ST, e);
        const int ngemm = G - nscan;
        if (ngemm > 0) { if (b >= nscan) for (int u = b - nscan; u < 256; u += ngemm) { const int pm = u >> 2, pn = u & 3;
            gemm_unit<256>(smem, FAMapPlain{p.a1, 512, pm * 256}, FBMapPlain{p.w_conv_out, D, pn * 256}, FEpiGateA{p.m, p.proj, pm * 256, pn * 256}, 512); __syncthreads(); } }
        else for (int u = b; u < 256; u += G) { const int pm = u >> 2, pn = u & 3;
            gemm_unit<256>(smem, FAMapPlain{p.a1, 512, pm * 256}, FBMapPlain{p.w_conv_out, D, pn * 256}, FEpiGateA{p.m, p.proj, pm * 256, pn * 256}, 512); __syncthreads(); }
    }
    xcd_barrier(bar);
    for (int u = blockIdx.x; u < 1024; u += gridDim.x) hgrn_phase3(smem, p.proj, p.lbt, p.ST, p.hnw, p.ob, u >> 2, u & 3);
    xcd_barrier(bar);
    for (int r = 0;; ++r) { int pm, pn; if (!dense_unit(r, T / 256, D / 256, pm, pn)) break;
        gemm_unit<256>(smem, FAMapPlain{p.ob, 512, pm * 256}, FBMapPlain{p.w_hgrn_out, D, pn * 256}, FEpiGateB{p.m, p.proj, pm * 256, pn * 256}, 512); __syncthreads(); }
    xcd_barrier(bar);
    for (int r = 0;; ++r) { int pm, pn; if (!dense_unit(r, T / 256, D / 256, pm, pn)) break;
        gemm_unit<256>(smem, FAMapPlain{p.m, D, pm * 256}, FBMapPlain{p.w_o, D, pn * 256}, FEpiStoreBf16{p.y, D, pm * 256, pn * 256}, D); __syncthreads(); }
    xcd_barrier(bar);
    phase_mid(p);
    xcd_barrier(bar);
    for (int u = blockIdx.x; u < 192; u += gridDim.x) {
        if (u < 64) gemm_unit<256>(smem, FAMapPlain{p.h2, D, u * 256}, FBMapPlain{p.w_router, E, 0}, FEpiStoreF32{p.logits, E, u * 256, 0}, D);
        else { const int v = u - 64, pm = v >> 1, pn = v & 1;
            gemm_unit<256>(smem, FAMapPlain{p.h2, D, pm * 256}, FBMapPair{p.wgs, p.wus, FF, pn * 128}, FEpiSwiGLU{p.acts, pm * 256, pn * 128}, D); }
        __syncthreads();
    }
    xcd_barrier(bar);
    phase_route(p);
    for (int r = 0;; ++r) { int pm, pn; if (!dense_unit(r, T / 256, D / 256, pm, pn)) break;
        gemm_unit<256>(smem, FAMapPlain{p.acts, FF, pm * 256}, FBMapPlain{p.wds, D, pn * 256}, FEpiStoreBf16{p.shout, D, pm * 256, pn * 256}, FF); __syncthreads(); }
    xcd_barrier(bar);
    build_pref(p, smem);
    {
        const int* sp = (const int*)(smem + LDS_PREF_OFF);
        const int ni = sp[256];
        for (int it = blockIdx.x; it < ni * 2; it += gridDim.x) {
            const int item = it >> 1, pn = it & 1, e = find_expert(sp, item), r0 = (item - sp[e]) * 256, cnt = (int)p.counts[e];
            gemm_unit<256>(smem, FAMapGather{p.h2, D, p.lslot, e * T, cnt, r0}, FBMapPair{p.wge + (size_t)e * D * FF, p.wue + (size_t)e * D * FF, FF, pn * 128},
                           FEpiSwiGLUSlot{p.act, p.lslot, e * T, cnt, r0, pn * 128}, D);
            __syncthreads();
        }
    }
    xcd_barrier(bar);
    {
        const int* sp = (const int*)(smem + LDS_PREF_OFF);
        const int ni = sp[256];
        for (int it = blockIdx.x; it < ni * 4; it += gridDim.x) {
            const int item = it >> 2, pn = it & 3, e = find_expert(sp, item), r0 = (item - sp[e]) * 256, cnt = (int)p.counts[e];
            gemm_unit<256>(smem, FAMapSlot{p.act, FF, p.lslot, e * T, cnt, r0}, FBMapPlain{p.wde + (size_t)e * FF * D, D, pn * 256},
                           FEpiSlot{p.yslot, p.lslot, p.lw, e * T, cnt, r0, pn * 256}, FF);
            __syncthreads();
        }
    }
    xcd_barrier(bar);
    phase_final(p);
}

extern "C" void kernel_launch(void* const* d_in, const int* in_sizes, int n_in, void* d_out, int out_size, void* d_ws, size_t ws_size, hipStream_t stream) {
    Params p; memset(&p, 0, sizeof(p));
    p.x = (const float*)d_in[0]; p.c = (const float*)d_in[1]; p.w_ada = (const float*)d_in[2]; p.b_ada = (const float*)d_in[3];
    p.npm = (const float*)d_in[4]; p.npostm = (const float*)d_in[5]; p.w_in = (const float*)d_in[6]; p.conv_w = (const float*)d_in[7];
    p.w_conv_out = (const float*)d_in[8]; p.lbt = (const float*)d_in[9]; p.hnw = (const float*)d_in[10]; p.w_hgrn_out = (const float*)d_in[11];
    p.w_o = (const float*)d_in[12]; p.npf = (const float*)d_in[13]; p.npostf = (const float*)d_in[14]; p.w_router = (const float*)d_in[15];
    p.rbias = (const float*)d_in[16]; p.wge = (const float*)d_in[17]; p.wue = (const float*)d_in[18]; p.wde = (const float*)d_in[19];
    p.wgs = (const float*)d_in[20]; p.wus = (const float*)d_in[21]; p.wds = (const float*)d_in[22];
    p.out = (float*)d_out;
    char* base = (char*)d_ws; size_t off = 0;
    auto take = [&](size_t bytes) { char* r = base + off; off += (bytes + 255) & ~(size_t)255; return r; };
    char* ctrl = take(65536);
    p.bar = (unsigned*)ctrl; p.counts = (unsigned*)(ctrl + 16384);
    p.mod = (float*)take(6 * D * 4);
    p.h1 = (bf16_t*)take((size_t)T * D * 2);
    p.proj = (bf16_t*)take((size_t)T * NIN * 2);
    p.kcT = (float*)take((size_t)256 * 65536 * 4);
    p.dec = (float*)take((size_t)256 * 512 * 4);
    p.ST = (bf16_t*)take((size_t)256 * 65536 * 2);
    p.a1 = (bf16_t*)take((size_t)T * 512 * 2);
    p.ob = (bf16_t*)take((size_t)T * 512 * 2);
    p.m = (bf16_t*)take((size_t)T * D * 2);
    p.y = (bf16_t*)take((size_t)T * D * 2);
    p.h2 = (bf16_t*)take((size_t)T * D * 2);
    p.logits = (float*)take((size_t)T * E * 4);
    p.lslot = (int*)take((size_t)E * T * 4);
    p.lw = (float*)take((size_t)E * T * 4);
    p.act = (bf16_t*)take((size_t)T * TOPK * FF * 2);
    p.yslot = (bf16_t*)take((size_t)T * TOPK * D * 2);
    p.acts = (bf16_t*)take((size_t)T * FF * 2);
    p.shout = (bf16_t*)take((size_t)T * D * 2);

    static int grid = 0;
    if (!grid) {
        (void)hipFuncSetAttribute((const void*)k_mega, hipFuncAttributeMaxDynamicSharedMemorySize, LDS_TOTAL);
        int dev = 0, cus = 0, per_cu = 0;
        (void)hipGetDevice(&dev);
        (void)hipDeviceGetAttribute(&cus, hipDeviceAttributeMultiprocessorCount, dev);
        (void)hipOccupancyMaxActiveBlocksPerMultiprocessor(&per_cu, (const void*)k_mega, 512, LDS_TOTAL);
        if (cus <= 0) cus = 256;
        grid = cus * (per_cu < 1 ? per_cu : 1);
        if (grid <= 0) grid = cus;
    }
    (void)hipMemsetAsync(ctrl, 0, 65536, stream);
    k_mega<<<grid, 512, LDS_TOTAL, stream>>>(p);
}
```

```cpp
#include <hip/hip_runtime.h>
#include <stdint.h>
#include <string.h>
#include <stddef.h>

typedef unsigned short bf16_t;
#define DEV __device__ __forceinline__

constexpr int T = 16384, D = 1024, NIN = 5632, E = 256, FF = 256, TOPK = 8;
constexpr int OFF_CB = 0, OFF_CC = 512, OFF_CX = 1024, OFF_Q = 1536, OFF_F = 2048, OFF_I = 2560, OFF_G = 3072, OFF_GA = 3584, OFF_GB = 4608;
constexpr float EPS = 1e-6f;

DEV float bf2f(bf16_t v) { return __uint_as_float(((unsigned)v) << 16); }
DEV bf16_t f2bf(float f) { unsigned u = __float_as_uint(f); u += 0x7FFFu + ((u >> 16) & 1u); return (bf16_t)(u >> 16); }
DEV float sigmoidf_(float x) { return 1.f / (1.f + __expf(-x)); }
DEV float siluf_(float x) { return x / (1.f + __expf(-x)); }
DEV float wave_sum(float v) {
#pragma unroll
    for (int o = 32; o > 0; o >>= 1) v += __shfl_xor(v, o);
    return v;
}
DEV int opaque_tid() { int t = threadIdx.x; asm volatile("" : "+v"(t)); return t; }
DEV float lo_bf(unsigned u) { return __uint_as_float(u << 16); }
DEV float hi_bf(unsigned u) { return __uint_as_float(u & 0xffff0000u); }

#define XB_TMO      128
#define XB_XCNT(j)  (256  + 64 * (j))
#define XB_XSUB(j)  (1280 + 64 * (j))
#define XB_XGEN(j)  (2304 + 64 * (j))
#define XB_TOP      3328
#define XB_TOPGEN   3392
#define XCD_BAR_WORDS 3456
#define XB_SPIN_CAP (1u << 18)
#define LAS __attribute__((address_space(3)))
__device__ __forceinline__ unsigned xb_ld(unsigned* p)              { return __hip_atomic_load(p, __ATOMIC_RELAXED, __HIP_MEMORY_SCOPE_AGENT); }
__device__ __forceinline__ unsigned xb_add(unsigned* p, unsigned v) { return __hip_atomic_fetch_add(p, v, __ATOMIC_RELAXED, __HIP_MEMORY_SCOPE_AGENT); }
__device__ __forceinline__ unsigned xb_xcc_id() { return (unsigned)__builtin_amdgcn_s_getreg((3 << 11) | 20) & 0xFu; }
#define XB_SPIN(cond, bar) do { unsigned _sp = 0; while (cond) { __builtin_amdgcn_s_sleep(1); \
    if ((++_sp & 255u) == 0u) { if (xb_ld(&(bar)[XB_TMO])) break; if (_sp > XB_SPIN_CAP) { atomicAdd(&(bar)[XB_TMO], 1u); break; } } } } while (0)
struct XcdBarrier { unsigned* bar; unsigned x; volatile LAS unsigned* st; };
__device__ __forceinline__ XcdBarrier xcd_barrier_post(unsigned* bar, volatile LAS unsigned* st) {
    XcdBarrier b; b.bar = bar; b.x = xb_xcc_id(); b.st = st;
    if (threadIdx.x == 0) (void)xb_add(&bar[XB_XCNT(b.x)], 1u);
    return b;
}
__device__ __forceinline__ void xcd_barrier_complete(unsigned* bar, unsigned x, unsigned& nloc, unsigned& nx) {
    const unsigned G = gridDim.x * gridDim.y * gridDim.z;
    unsigned sum, cnt, mine, sp = 0u;
    for (;;) {
        sum = 0u; cnt = 0u; mine = 0u;
#pragma unroll
        for (unsigned j = 0; j < 16; ++j) { const unsigned c = xb_ld(&bar[XB_XCNT(j)]); sum += c; cnt += (c > 0u) ? 1u : 0u; mine = (j == x) ? c : mine; }
        if (sum == G) break;
        __builtin_amdgcn_s_sleep(1);
        if ((++sp & 255u) == 0u) { if (xb_ld(&bar[XB_TMO])) break; if (sp > XB_SPIN_CAP) { atomicAdd(&bar[XB_TMO], 1u); break; } }
    }
    nloc = mine > 0u ? mine : 1u; nx = cnt > 0u ? cnt : 1u;
}
__device__ __forceinline__ void xcd_barrier(const XcdBarrier& b) {
    asm volatile("s_waitcnt vmcnt(0)" ::: "memory");
    __syncthreads();
    if (threadIdx.x == 0) {
        unsigned* bar = b.bar;
        __builtin_amdgcn_s_waitcnt(0);
        unsigned nloc = b.st[0], nx = b.st[1];
        if (nloc == 0u) { xcd_barrier_complete(bar, b.x, nloc, nx); b.st[0] = nloc; b.st[1] = nx; }
        const unsigned old = xb_add(&bar[XB_XSUB(b.x)], 1u);
        const unsigned gen = old / nloc;
        if (old + 1u == (gen + 1u) * nloc) {
            __builtin_amdgcn_fence(__ATOMIC_RELEASE, "agent");
            asm volatile("s_waitcnt vmcnt(0)" ::: "memory");
            const unsigned og = xb_add(&bar[XB_TOP], 1u);
            const unsigned tg = og / nx;
            if (og + 1u == (tg + 1u) * nx) xb_add(&bar[XB_TOPGEN], 1u);
            else XB_SPIN(xb_ld(&bar[XB_TOPGEN]) == tg, bar);
            __builtin_amdgcn_fence(__ATOMIC_ACQUIRE, "agent");
            xb_add(&bar[XB_XGEN(b.x)], 1u);
            asm volatile("s_waitcnt vmcnt(0)" ::: "memory");
        } else {
            XB_SPIN(xb_ld(&bar[XB_XGEN(b.x)]) == gen, bar);
            __builtin_amdgcn_fence(__ATOMIC_ACQUIRE, "agent");
            asm volatile("s_waitcnt vmcnt(0)" ::: "memory");
        }
    }
    __syncthreads();
}

struct Params {
    const float *x, *c, *w_ada, *b_ada, *npm, *npostm, *w_in, *conv_w, *w_conv_out, *lbt, *hnw, *w_hgrn_out, *w_o, *npf, *npostf, *w_router, *rbias, *wge, *wue, *wde, *wgs, *wus, *wds;
    float* out;
    unsigned* bar;
    unsigned* counts;
    bf16_t *WinT, *WcoT, *WhoT, *WoT, *WrsT, *WdsT, *WgeuT, *WdeT;
    float* mod;
    bf16_t* h1;
    bf16_t* proj;
    float* kcT;
    float* dec;
    bf16_t* ST;
    bf16_t* a1;
    bf16_t* ob;
    bf16_t* m;
    bf16_t* y;
    bf16_t* h2;
    float* logits;
    int* lslot;
    float* lw;
    bf16_t* act;
    bf16_t* yslot;
    bf16_t* acts;
    bf16_t* shout;
};
typedef short bf16x8 __attribute__((ext_vector_type(8)));
typedef float f32x4 __attribute__((ext_vector_type(4)));
constexpr int GEMM_LDS_BYTES = 131072;
typedef __bf16 hwbf16x2 __attribute__((ext_vector_type(2)));
DEV unsigned pack_bf16x2(float lo, float hi) { hwbf16x2 v = {(__bf16)lo, (__bf16)hi}; return __builtin_bit_cast(unsigned, v); }

namespace g8 {
constexpr int BK = 64, HALF = 128, HTB = HALF * BK * 2;
DEV int lds_byte(int r, int c) { const int st = (r >> 4) * 2 + (c >> 5), rr = r & 15, cc = c & 31, ob = rr * 64 + cc * 2; return st * 1024 + (ob ^ (((ob >> 9) & 1) << 5)); }
DEV void stage_rc(int b, int& R, int& C) { const int st = b / 1024, sb = b % 1024, swz = sb ^ (((sb >> 9) & 1) << 5); R = (st >> 1) * 16 + swz / 64; C = (st & 1) * 32 + (swz % 64) / 2; }

struct Unit { const char* A; const char* B; int i0, i1, i2, i3; };

template <bool GATHER, class Sched, class EpiF>
DEV void gemm_stream(LAS unsigned char* lds, const int K, const Sched& S, const EpiF& EF) {
    const int tid = opaque_tid(), wid = __builtin_amdgcn_readfirstlane(tid >> 6), lane = tid & 63, wr = wid >> 2, wc = wid & 3, fr = lane & 15, fq = lane >> 4;
    const int nt = K / BK;
    int Rr[2], Cc[2];
    unsigned voffB[2];
#pragma unroll
    for (int i = 0; i < 2; ++i) { stage_rc(tid * 16 + i * 8192, Rr[i], Cc[i]); voffB[i] = (unsigned)(Rr[i] * K + Cc[i]) * 2u; }
    const size_t kstep = (size_t)(BK * 2);
    const size_t hstepB = (size_t)HALF * K * 2;
    const size_t hstepA = GATHER ? 0 : hstepB;
    const unsigned ldsw = (unsigned)wid * 1024u;
    const int aoff = lds_byte(wr * 64 + fr, fq * 8), boff = lds_byte(wc * 32 + fr, fq * 8);
#define G8_SA(b, h) (((b) * 2 + (h)) * HTB)
#define G8_SB(b, h) ((4 + (b) * 2 + (h)) * HTB)
#define G8_STAGE(bufoff, gbase, v0_, v1_) do { \
        __builtin_amdgcn_global_load_lds((const unsigned*)((const char*)(gbase) + (v0_)), (LAS unsigned*)(lds + (bufoff) + ldsw), 16, 0, 0); \
        __builtin_amdgcn_global_load_lds((const unsigned*)((const char*)(gbase) + (v1_)), (LAS unsigned*)(lds + (bufoff) + ldsw + 8192), 16, 0, 0); } while (0)
#define G8_STAGE_B(b, h, gbase) G8_STAGE(G8_SB(b, h), gbase, voffB[0], voffB[1])
#define G8_STAGE_A(b, h, gbase, VA) G8_STAGE(G8_SA(b, h), gbase, VA[h][0], VA[h][1])
#define G8_LDA(dst, b, h) do { _Pragma("unroll") for (int m = 0; m < 4; ++m) _Pragma("unroll") for (int k = 0; k < 2; ++k) dst[m][k] = *(const LAS bf16x8*)(lds + G8_SA(b, h) + aoff + m * 2048 + k * 1024); } while (0)
#define G8_LDB(dst, b, h) do { _Pragma("unroll") for (int n = 0; n < 2; ++n) _Pragma("unroll") for (int k = 0; k < 2; ++k) dst[n][k] = *(const LAS bf16x8*)(lds + G8_SB(b, h) + boff + n * 2048 + k * 1024); } while (0)
#define G8_MMA(ai, bj, At, Bt) do { __builtin_amdgcn_s_setprio(1); _Pragma("unroll") for (int m = 0; m < 4; ++m) _Pragma("unroll") for (int n = 0; n < 2; ++n) _Pragma("unroll") for (int k = 0; k < 2; ++k) \
        acc[ai][bj][m][n] = __builtin_amdgcn_mfma_f32_16x16x32_bf16(Bt[n][k], At[m][k], acc[ai][bj][m][n], 0, 0, 0); __builtin_amdgcn_s_setprio(0); } while (0)
#define G8_WAIT_V(n) asm volatile("s_waitcnt vmcnt(" #n ")" ::: "memory")
#define G8_WAIT_L(n) asm volatile("s_waitcnt lgkmcnt(" #n ")" ::: "memory")
#define G8_BAR __builtin_amdgcn_s_barrier()
#define G8_SCHED __builtin_amdgcn_sched_barrier(0)
#define G8_VOFF(VA, u) do { _Pragma("unroll") for (int h_ = 0; h_ < 2; ++h_) _Pragma("unroll") for (int i_ = 0; i_ < 2; ++i_) \
        VA[h_][i_] = GATHER ? (S.rowoff(u, Rr[i_] + 128 * h_) + (unsigned)Cc[i_] * 2u) : (unsigned)(Rr[i_] * K + Cc[i_]) * 2u; } while (0)
    Unit cur, nxt; int ui = 0;
    if (!S.next(0, cur)) return;
    f32x4 acc[2][2][4][2];
#pragma unroll
    for (int a_ = 0; a_ < 2; ++a_)
#pragma unroll
        for (int b_ = 0; b_ < 2; ++b_)
#pragma unroll
            for (int m = 0; m < 4; ++m)
#pragma unroll
                for (int n = 0; n < 2; ++n) acc[a_][b_][m][n] = (f32x4){0.f, 0.f, 0.f, 0.f};
    bf16x8 At[4][2], B0[2][2], B1[2][2];
    unsigned vAc[2][2], vAn[2][2];
    G8_VOFF(vAc, cur);
#pragma unroll
    for (int h_ = 0; h_ < 2; ++h_)
#pragma unroll
        for (int i_ = 0; i_ < 2; ++i_) vAn[h_][i_] = vAc[h_][i_];
    const char* cA = cur.A; const char* cB = cur.B;
    G8_STAGE_B(0, 0, cB); G8_STAGE_A(0, 0, cA, vAc); G8_STAGE_B(0, 1, cB + hstepB); G8_STAGE_A(0, 1, cA + hstepA, vAc);
    if (wr == 1) G8_BAR;
    G8_WAIT_V(4); G8_BAR;
    G8_STAGE_B(1, 0, cB + kstep); G8_STAGE_A(1, 0, cA + kstep, vAc); G8_STAGE_B(1, 1, cB + hstepB + kstep);
    G8_WAIT_V(6); G8_BAR;
    for (;;) {
        const bool has_next = S.next(ui + 1, nxt);
        const char* nA = has_next ? nxt.A : cA; const char* nB = has_next ? nxt.B : cB;
#pragma unroll 1
        for (int t = 0; t < nt; t += 2) {
            const bool last = (t == nt - 2);
            const char* a1 = cA + (size_t)(t + 1) * kstep;
            const char* a2 = last ? nA : cA + (size_t)(t + 2) * kstep; const char* b2 = last ? nB : cB + (size_t)(t + 2) * kstep;
            const char* a3 = a2 + kstep; const char* b3 = b2 + kstep;
            unsigned vA2[2][2];
#pragma unroll
            for (int h_ = 0; h_ < 2; ++h_)
#pragma unroll
                for (int i_ = 0; i_ < 2; ++i_) vA2[h_][i_] = vAc[h_][i_];
            if constexpr (GATHER) { if (last && has_next) { G8_VOFF(vAn, nxt);
#pragma unroll
                for (int h_ = 0; h_ < 2; ++h_)
#pragma unroll
                    for (int i_ = 0; i_ < 2; ++i_) vA2[h_][i_] = vAn[h_][i_]; } }
            G8_LDB(B0, 0, 0); G8_SCHED; G8_LDA(At, 0, 0); G8_STAGE_A(1, 1, a1 + hstepA, vAc);
            G8_WAIT_L(8); G8_BAR; G8_WAIT_L(0); G8_MMA(0, 0, At, B0); G8_BAR; G8_SCHED;
            G8_LDB(B1, 0, 1); G8_STAGE_B(0, 0, b2);
            G8_BAR; G8_WAIT_L(0); G8_MMA(0, 1, At, B1); G8_BAR;
            G8_LDA(At, 0, 1); G8_STAGE_A(0, 0, a2, vA2);
            G8_BAR; G8_WAIT_L(0); G8_MMA(1, 0, At, B0); G8_BAR; G8_SCHED;
            G8_STAGE_B(0, 1, b2 + hstepB);
            G8_WAIT_V(6); G8_BAR; G8_MMA(1, 1, At, B1); G8_BAR;
            G8_LDB(B0, 1, 0); G8_SCHED; G8_LDA(At, 1, 0); G8_STAGE_A(0, 1, a2 + hstepA, vA2);
            G8_WAIT_L(8); G8_BAR; G8_WAIT_L(0); G8_MMA(0, 0, At, B0); G8_BAR; G8_SCHED;
            G8_LDB(B1, 1, 1); G8_STAGE_B(1, 0, b3);
            G8_BAR; G8_WAIT_L(0); G8_MMA(0, 1, At, B1); G8_BAR;
            G8_LDA(At, 1, 1); G8_STAGE_A(1, 0, a3, vA2);
            G8_BAR; G8_WAIT_L(0); G8_MMA(1, 0, At, B0); G8_BAR; G8_SCHED;
            G8_STAGE_B(1, 1, b3 + hstepB);
            G8_WAIT_V(6); G8_BAR; G8_MMA(1, 1, At, B1); G8_BAR;
        }
        {
            const auto epi = EF(cur);
#pragma unroll
            for (int ai = 0; ai < 2; ++ai)
#pragma unroll
                for (int m = 0; m < 4; ++m)
#pragma unroll
                    for (int bj = 0; bj < 2; ++bj) epi(128 * ai + 64 * wr + 16 * m + fr, 128 * bj + 32 * wc + 4 * fq, acc[ai][bj][m][0], acc[ai][bj][m][1]);
        }
        if (!has_next) break;
#pragma unroll
        for (int a_ = 0; a_ < 2; ++a_)
#pragma unroll
            for (int b_ = 0; b_ < 2; ++b_)
#pragma unroll
                for (int m = 0; m < 4; ++m)
#pragma unroll
                    for (int n = 0; n < 2; ++n) acc[a_][b_][m][n] = (f32x4){0.f, 0.f, 0.f, 0.f};
        if constexpr (GATHER) {
#pragma unroll
            for (int h_ = 0; h_ < 2; ++h_)
#pragma unroll
                for (int i_ = 0; i_ < 2; ++i_) vAc[h_][i_] = vAn[h_][i_]; }
        cur = nxt; cA = nA; cB = nB; ++ui;
    }
    G8_WAIT_V(0);
    if (wr == 0) G8_BAR;
    G8_BAR;
#undef G8_SA
#undef G8_SB
#undef G8_STAGE
#undef G8_STAGE_A
#undef G8_STAGE_B
#undef G8_LDA
#undef G8_LDB
#undef G8_MMA
#undef G8_WAIT_V
#undef G8_WAIT_L
#undef G8_BAR
#undef G8_SCHED
#undef G8_VOFF
}
}

typedef short s16x4 __attribute__((ext_vector_type(4)));


struct FAMapPlain { const bf16_t* A; int lda; int row0; DEV const bf16_t* operator()(int r) const { return A + (size_t)(row0 + r) * lda; } };
struct FAMapGather { const bf16_t* A; int lda; const int* lslot; int base; int cnt; int r0;
    DEV const bf16_t* operator()(int r) const { int rr = r0 + r; rr = rr < cnt ? rr : cnt - 1; return A + (size_t)(lslot[base + rr] >> 3) * lda; } };
struct FAMapSlot { const bf16_t* A; int lda; const int* lslot; int base; int cnt; int r0;
    DEV const bf16_t* operator()(int r) const { int rr = r0 + r; rr = rr < cnt ? rr : cnt - 1; return A + (size_t)lslot[base + rr] * lda; } };
struct FBMapPlain { const float* W; int ldb; int col0; DEV const float* ptr(int vb) const { return W + col0 + vb * 16; } DEV int ld() const { return ldb; } };
struct FBMapPair { const float* Wg; const float* Wu; int ldb; int col0;
    DEV const float* ptr(int vb) const { return Wg + (ptrdiff_t)(vb & 1) * (Wu - Wg) + col0 + (vb >> 1) * 16; } DEV int ld() const { return ldb; } };

template <int BM, class AMap, class BMap, class Epi>
DEV void gemm_unit(char* smem, const AMap& amap, const BMap& bmap, const Epi& epi, int K) {
    constexpr int NA = BM / 64, MI = BM / 32, ABYTES = BM * 128, STG = ABYTES + 32768;
    const int tid = opaque_tid(), lane = tid & 63, wid = tid >> 6, wr = wid >> 2, wc = wid & 3, fr = lane & 15, fq = lane >> 4;
    const bf16_t* aptr[NA];
#pragma unroll
    for (int i = 0; i < NA; ++i) { const int c = tid + 512 * i, row = c >> 3, pch = c & 7; aptr[i] = amap(row) + ((pch ^ (row & 7)) << 3); }
    const int g = lane >> 4, j16 = lane & 15, krow = j16 >> 2, c4 = j16 & 3, vg = wid & 3, kh = wid >> 2;
    const int ldb = bmap.ld();
    const float* bptr = bmap.ptr(vg * 4 + g) + 4 * c4 + (size_t)(4 * kh + krow) * ldb;
    unsigned bwr[2];
#pragma unroll
    for (int o = 0; o < 2; ++o) bwr[o] = ABYTES + (vg * 4 + g) * 256 + (((4 * kh + krow) ^ (o << 2)) * 32) + c4 * 8;
    unsigned ard[2];
#pragma unroll
    for (int ks = 0; ks < 2; ++ks) { const int row = wr * (BM / 2) + fr; ard[ks] = row * 128 + (((ks * 4 + fq) ^ (row & 7)) << 4); }
    unsigned brd[2];
    { const int q = j16 >> 2, p = j16 & 3;
#pragma unroll
      for (int t = 0; t < 2; ++t) brd[t] = ABYTES + (fq * 16) * 256 + (((4 * t + q) ^ ((fq & 1) << 2)) * 32) + p * 8; }

    f32x4 acc[MI][4];
#pragma unroll
    for (int mi = 0; mi < MI; ++mi)
#pragma unroll
        for (int nf = 0; nf < 4; ++nf) acc[mi][nf] = (f32x4){0.f, 0.f, 0.f, 0.f};

    float4 breg[4];
    const int nk = K >> 6;
#define G_LOAD_A(kt, buf) do { _Pragma("unroll") for (int i = 0; i < NA; ++i) \
        __builtin_amdgcn_global_load_lds((const unsigned*)(aptr[i] + (kt) * 64), (LAS unsigned*)(smem + (buf) * STG + (tid + 512 * i) * 16), 16, 0, 0); } while (0)
#define G_LOAD_B(kt, h) do { _Pragma("unroll") for (int i = 0; i < 4; ++i) breg[i] = *(const float4*)(bptr + (size_t)((kt) * 64 + 8 * ((h) * 4 + i)) * ldb); } while (0)
#define G_WRITE_B(buf, h) do { char* sb_ = smem + (buf) * STG; \
        _Pragma("unroll") for (int i = 0; i < 4; ++i) { uint2 w; w.x = pack_bf16x2(breg[i].x, breg[i].y); w.y = pack_bf16x2(breg[i].z, breg[i].w); \
            *(uint2*)(sb_ + bwr[i & 1] + ((h) * 4 + i) * 16 * 256) = w; } } while (0)
#define G_COMPUTE(sb, ks) do { bf16x8 bf[4]; \
        _Pragma("unroll") for (int nf = 0; nf < 4; ++nf) { \
            const int nb = (nf >> 1) * 8 + wc * 2 + (nf & 1); const unsigned base = (ks) * 4 * 16 * 256 + nb * 256; \
            s16x4 t0 = __builtin_amdgcn_ds_read_tr16_b64_v4i16((LAS s16x4*)((sb) + brd[0] + base)); \
            s16x4 t1 = __builtin_amdgcn_ds_read_tr16_b64_v4i16((LAS s16x4*)((sb) + brd[1] + base)); \
            bf[nf] = (bf16x8){t0[0], t0[1], t0[2], t0[3], t1[0], t1[1], t1[2], t1[3]}; } \
        _Pragma("unroll") for (int mi = 0; mi < MI; ++mi) { \
            const bf16x8 af = *(const bf16x8*)((sb) + ard[ks] + mi * 16 * 128); \
            _Pragma("unroll") for (int nf = 0; nf < 4; ++nf) acc[mi][nf] = __builtin_amdgcn_mfma_f32_16x16x32_bf16(bf[nf], af, acc[mi][nf], 0, 0, 0); } } while (0)
    G_LOAD_A(0, 0); G_LOAD_B(0, 0); G_WRITE_B(0, 0); G_LOAD_B(0, 1); G_WRITE_B(0, 1);
    __syncthreads();
    for (int kt = 0; kt < nk; ++kt) {
        const bool more = kt + 1 < nk;
        const char* sb = smem + (kt & 1) * STG;
        if (more) { G_LOAD_A(kt + 1, (kt + 1) & 1); G_LOAD_B(kt + 1, 0); }
        G_COMPUTE(sb, 0);
        if (more) { G_WRITE_B((kt + 1) & 1, 0); G_LOAD_B(kt + 1, 1); }
        G_COMPUTE(sb, 1);
        if (more) { G_WRITE_B((kt + 1) & 1, 1); }
        __syncthreads();
    }
#undef G_LOAD_A
#undef G_LOAD_B
#undef G_WRITE_B
#undef G_COMPUTE
#pragma unroll
    for (int mi = 0; mi < MI; ++mi)
#pragma unroll
        for (int bj = 0; bj < 2; ++bj) epi(wr * (BM / 2) + mi * 16 + fr, bj * 128 + wc * 32 + 4 * fq, acc[mi][bj * 2], acc[mi][bj * 2 + 1]);
}

struct FEpiStoreBf16 { bf16_t* C; int ldc; int row0; int col0;
    DEV void operator()(int r, int c, f32x4 v0, f32x4 v1) const { bf16_t* p = C + (size_t)(row0 + r) * ldc + col0 + c;
        uint2 a, b; a.x = pack_bf16x2(v0[0], v0[1]); a.y = pack_bf16x2(v0[2], v0[3]); b.x = pack_bf16x2(v1[0], v1[1]); b.y = pack_bf16x2(v1[2], v1[3]);
        *(uint2*)p = a; *(uint2*)(p + 16) = b; } };
struct FEpiStoreF32 { float* C; int ldc; int row0; int col0;
    DEV void operator()(int r, int c, f32x4 v0, f32x4 v1) const { float* p = C + (size_t)(row0 + r) * ldc + col0 + c; *(f32x4*)p = v0; *(f32x4*)(p + 16) = v1; } };
struct FEpiGateA { bf16_t* M; const bf16_t* proj; int row0; int col0;
    DEV void one(int r, int c, f32x4 v) const { const size_t row = row0 + r; const uint2 gr = *(const uint2*)(proj + row * NIN + OFF_GA + col0 + c);
        float g0 = sigmoidf_(__uint_as_float(gr.x << 16)), g1 = sigmoidf_(__uint_as_float(gr.x & 0xffff0000u)), g2 = sigmoidf_(__uint_as_float(gr.y << 16)), g3 = sigmoidf_(__uint_as_float(gr.y & 0xffff0000u));
        uint2 o; o.x = pack_bf16x2(g0 * v[0], g1 * v[1]); o.y = pack_bf16x2(g2 * v[2], g3 * v[3]); *(uint2*)(M + row * D + col0 + c) = o; }
    DEV void operator()(int r, int c, f32x4 v0, f32x4 v1) const { one(r, c, v0); one(r, c + 16, v1); } };
struct FEpiGateB { bf16_t* M; const bf16_t* proj; int row0; int col0;
    DEV void one(int r, int c, f32x4 v) const { const size_t row = row0 + r; const uint2 gr = *(const uint2*)(proj + row * NIN + OFF_GB + col0 + c);
        const uint2 mo = *(const uint2*)(M + row * D + col0 + c);
        float g0 = sigmoidf_(__uint_as_float(gr.x << 16)), g1 = sigmoidf_(__uint_as_float(gr.x & 0xffff0000u)), g2 = sigmoidf_(__uint_as_float(gr.y << 16)), g3 = sigmoidf_(__uint_as_float(gr.y & 0xffff0000u));
        float m0 = __uint_as_float(mo.x << 16), m1 = __uint_as_float(mo.x & 0xffff0000u), m2 = __uint_as_float(mo.y << 16), m3 = __uint_as_float(mo.y & 0xffff0000u);
        uint2 o; o.x = pack_bf16x2(m0 + g0 * v[0], m1 + g1 * v[1]); o.y = pack_bf16x2(m2 + g2 * v[2], m3 + g3 * v[3]); *(uint2*)(M + row * D + col0 + c) = o; }
    DEV void operator()(int r, int c, f32x4 v0, f32x4 v1) const { one(r, c, v0); one(r, c + 16, v1); } };
struct FEpiSwiGLU { bf16_t* act; int row0; int col0;
    DEV void operator()(int r, int c, f32x4 g, f32x4 u) const {
        uint2 o; o.x = pack_bf16x2(siluf_(g[0]) * u[0], siluf_(g[1]) * u[1]); o.y = pack_bf16x2(siluf_(g[2]) * u[2], siluf_(g[3]) * u[3]);
        *(uint2*)(act + (size_t)(row0 + r) * FF + col0 + (c >> 5) * 16 + (c & 15)) = o; } };
struct FEpiSwiGLUSlot { bf16_t* act; const int* lslot; int base; int cnt; int r0; int col0;
    DEV void operator()(int r, int c, f32x4 g, f32x4 u) const { const int rr = r0 + r; if (rr < cnt) {
        uint2 o; o.x = pack_bf16x2(siluf_(g[0]) * u[0], siluf_(g[1]) * u[1]); o.y = pack_bf16x2(siluf_(g[2]) * u[2], siluf_(g[3]) * u[3]);
        *(uint2*)(act + (size_t)lslot[base + rr] * FF + col0 + (c >> 5) * 16 + (c & 15)) = o; } } };
struct FEpiSlot { bf16_t* yslot; const int* lslot; const float* lw; int base; int cnt; int r0; int col0;
    DEV void operator()(int r, int c, f32x4 v0, f32x4 v1) const { const int rr = r0 + r; if (rr < cnt) { const int s = lslot[base + rr]; const float w = lw[base + rr];
        bf16_t* p = yslot + (size_t)s * D + col0 + c; uint2 a, b; a.x = pack_bf16x2(w * v0[0], w * v0[1]); a.y = pack_bf16x2(w * v0[2], w * v0[3]); b.x = pack_bf16x2(w * v1[0], w * v1[1]); b.y = pack_bf16x2(w * v1[2], w * v1[3]);
        *(uint2*)p = a; *(uint2*)(p + 16) = b; } } };

DEV unsigned sw128(int row, int chunk) { return (unsigned)(row * 128 + ((chunk ^ (row & 7)) << 4)); }
DEV unsigned sw256(int row, int chunk) { return (unsigned)(row * 256 + ((chunk ^ (row & 15)) << 4)); }
constexpr int HG_LDS_BYTES = 96 * 1024;

DEV void hgrn_gates(const bf16_t* proj, const float* lbt, int t0, int h, int d, int seg, float* red, float (&fgv)[16], float (&b)[16], float& blast) {
    const float a0 = lbt[h * 128 + d], a1 = lbt[512 + h * 128 + d];
    const float lb = 1.f / (1.f + __expf(a1 - a0));
    float run = 0.f;
#pragma unroll
    for (int i = 0; i < 16; ++i) {
        const float f = bf2f(proj[(size_t)(t0 + 16 * seg + i) * NIN + OFF_F + h * 128 + d]);
        const float fg = lb + (1.f - lb) * sigmoidf_(f);
        fgv[i] = fg; run += __logf(fg); b[i] = run;
    }
    red[seg * 128 + d] = run;
    __syncthreads();
    const float r0 = red[d], r1 = red[128 + d], r2 = red[256 + d], r3 = red[384 + d];
    const float pre = (seg > 0 ? r0 : 0.f) + (seg > 1 ? r1 : 0.f) + (seg > 2 ? r2 : 0.f);
    blast = r0 + r1 + r2 + r3;
#pragma unroll
    for (int i = 0; i < 16; ++i) b[i] += pre;
}
DEV void pack16_store(char* smem, unsigned a0, unsigned a1, const float (&v)[16]) {
    uint4 lo, hi;
    lo.x = pack_bf16x2(v[0], v[1]); lo.y = pack_bf16x2(v[2], v[3]); lo.z = pack_bf16x2(v[4], v[5]); lo.w = pack_bf16x2(v[6], v[7]);
    hi.x = pack_bf16x2(v[8], v[9]); hi.y = pack_bf16x2(v[10], v[11]); hi.z = pack_bf16x2(v[12], v[13]); hi.w = pack_bf16x2(v[14], v[15]);
    *(uint4*)(smem + a0) = lo; *(uint4*)(smem + a1) = hi;
}

DEV void hgrn_phase1(char* smem, const bf16_t* proj, const float* lbt, float* kcT, float* dec, int c, int h) {
    const int tid = opaque_tid(), d = tid & 127, seg = tid >> 7, t0 = c * 64;
    const int lane = tid & 63, w = tid >> 6, fr = lane & 15, fq = lane >> 4;
    float* red = (float*)(smem + 32768);
    float fgv[16], b[16], blast;
    hgrn_gates(proj, lbt, t0, h, d, seg, red, fgv, b, blast);
    float kd[16], vv[16];
#pragma unroll
    for (int i = 0; i < 16; ++i) {
        kd[i] = (1.f - fgv[i]) * __expf(blast - b[i]);
        vv[i] = bf2f(proj[(size_t)(t0 + 16 * seg + i) * NIN + OFF_I + h * 128 + d]);
    }
    pack16_store(smem, sw128(d, 2 * seg), sw128(d, 2 * seg + 1), kd);
    pack16_store(smem + 16384, sw128(d, 2 * seg), sw128(d, 2 * seg + 1), vv);
    if (seg == 3) dec[(size_t)(c * 4 + h) * 128 + d] = __expf(blast);
    __syncthreads();
    f32x4 acc[8];
#pragma unroll
    for (int nv = 0; nv < 8; ++nv) acc[nv] = (f32x4){0.f, 0.f, 0.f, 0.f};
#pragma unroll
    for (int ks = 0; ks < 2; ++ks) {
        const bf16x8 xf = *(const bf16x8*)(smem + sw128(16 * w + fr, ks * 4 + fq));
#pragma unroll
        for (int nv = 0; nv < 8; ++nv) {
            const bf16x8 yf = *(const bf16x8*)(smem + 16384 + sw128(16 * nv + fr, ks * 4 + fq));
            acc[nv] = __builtin_amdgcn_mfma_f32_16x16x32_bf16(xf, yf, acc[nv], 0, 0, 0);
        }
    }
    float* out = kcT + (size_t)(c * 4 + h) * 16384;
#pragma unroll
    for (int nv = 0; nv < 8; ++nv) *(f32x4*)(out + (16 * nv + fr) * 128 + 16 * w + 4 * fq) = acc[nv];
    __syncthreads();
}

DEV void hgrn_phase2(const float* kcT, const float* dec, bf16_t* ST, int e) {
    const int h = e >> 14, d = e & 127;
    float S = 0.f;
    for (int c0 = 0; c0 < 256; c0 += 16) {
        float kc[16], dc[16];
#pragma unroll
        for (int i = 0; i < 16; ++i) { kc[i] = kcT[(size_t)(c0 + i) * 65536 + e]; dc[i] = dec[(size_t)((c0 + i) * 4 + h) * 128 + d]; }
#pragma unroll
        for (int i = 0; i < 16; ++i) { ST[(size_t)(c0 + i) * 65536 + e] = f2bf(S); S = dc[i] * S + kc[i]; }
    }
}

DEV void hgrn_phase3(char* smem, const bf16_t* proj, const float* lbt, const bf16_t* ST, const float* hw, bf16_t* ob, int c, int h) {
    constexpr int O_QT = 0, O_KT = 16384, O_VT = 32768, O_ST = 49152, O_AT = 81920, O_RED = 90112, O_SSQ = 92160;
    const int tid = opaque_tid(), d = tid & 127, seg = tid >> 7, t0 = c * 64;
    const int lane = tid & 63, w = tid >> 6, fr = lane & 15, fq = lane >> 4;
    {
        float fgv[16], b[16], blast;
        hgrn_gates(proj, lbt, t0, h, d, seg, (float*)(smem + O_RED), fgv, b, blast);
        float vv[16];
#pragma unroll
        for (int i = 0; i < 16; ++i) {
            const int t = 16 * seg + i;
            const float qv = bf2f(proj[(size_t)(t0 + t) * NIN + OFF_Q + h * 128 + d]);
            const float eb = __expf(b[i]);
            const float qt = siluf_(qv) * eb, kt = (1.f - fgv[i]) / eb;
            const unsigned off = sw256(t, d >> 3) + (d & 7) * 2;
            *(bf16_t*)(smem + O_QT + off) = f2bf(qt);
            *(bf16_t*)(smem + O_KT + off) = f2bf(kt);
            vv[i] = bf2f(proj[(size_t)(t0 + t) * NIN + OFF_I + h * 128 + d]);
        }
        pack16_store(smem + O_VT, sw128(d, 2 * seg), sw128(d, 2 * seg + 1), vv);
        const bf16_t* sp = ST + (size_t)(c * 4 + h) * 16384;
#pragma unroll
        for (int i = 0; i < 4; ++i) { const int idx = tid + 512 * i, row = idx >> 4, ch = idx & 15; *(uint4*)(smem + O_ST + sw256(row, ch)) = *(const uint4*)(sp + row * 128 + ch * 8); }
    }
    __syncthreads();
    {
        const int tb = w & 3;
#pragma unroll
        for (int u = 0; u < 2; ++u) {
            const int sb = (w >> 2) * 2 + u;
            f32x4 acc = (f32x4){0.f, 0.f, 0.f, 0.f};
            if (sb <= tb) {
#pragma unroll
                for (int ks = 0; ks < 4; ++ks) {
                    const bf16x8 xf = *(const bf16x8*)(smem + O_KT + sw256(16 * sb + fr, ks * 4 + fq));
                    const bf16x8 yf = *(const bf16x8*)(smem + O_QT + sw256(16 * tb + fr, ks * 4 + fq));
                    acc = __builtin_amdgcn_mfma_f32_16x16x32_bf16(xf, yf, acc, 0, 0, 0);
                }
                const int t = 16 * tb + fr, s0 = 16 * sb + 4 * fq;
#pragma unroll
                for (int jj = 0; jj < 4; ++jj) if (s0 + jj > t) acc[jj] = 0.f;
            }
            uint2 o; o.x = pack_bf16x2(acc[0], acc[1]); o.y = pack_bf16x2(acc[2], acc[3]);
            *(uint2*)(smem + O_AT + sw128(16 * tb + fr, 2 * sb + (fq >> 1)) + 8 * (fq & 1)) = o;
        }
    }
    __syncthreads();
    const int tb = w & 3, vh = w >> 2;
    f32x4 acc[4];
#pragma unroll
    for (int n = 0; n < 4; ++n) acc[n] = (f32x4){0.f, 0.f, 0.f, 0.f};
#pragma unroll
    for (int ks = 0; ks < 2; ++ks) {
        const bf16x8 yf = *(const bf16x8*)(smem + O_AT + sw128(16 * tb + fr, ks * 4 + fq));
#pragma unroll
        for (int n = 0; n < 4; ++n) {
            const bf16x8 xf = *(const bf16x8*)(smem + O_VT + sw128(16 * (4 * vh + n) + fr, ks * 4 + fq));
            acc[n] = __builtin_amdgcn_mfma_f32_16x16x32_bf16(xf, yf, acc[n], 0, 0, 0);
        }
    }
#pragma unroll
    for (int ks = 0; ks < 4; ++ks) {
        const bf16x8 yf = *(const bf16x8*)(smem + O_QT + sw256(16 * tb + fr, ks * 4 + fq));
#pragma unroll
        for (int n = 0; n < 4; ++n) {
            const bf16x8 xf = *(const bf16x8*)(smem + O_ST + sw256(16 * (4 * vh + n) + fr, ks * 4 + fq));
            acc[n] = __builtin_amdgcn_mfma_f32_16x16x32_bf16(xf, yf, acc[n], 0, 0, 0);
        }
    }
    float ss = 0.f;
#pragma unroll
    for (int n = 0; n < 4; ++n)
#pragma unroll
        for (int jj = 0; jj < 4; ++jj) ss += acc[n][jj] * acc[n][jj];
    ss += __shfl_xor(ss, 16); ss += __shfl_xor(ss, 32);
    float* ssq = (float*)(smem + O_SSQ);
    if (fq == 0) ssq[vh * 64 + 16 * tb + fr] = ss;
    __syncthreads();
    const float tot = ssq[16 * tb + fr] + ssq[64 + 16 * tb + fr];
    const float rs = rsqrtf(tot * (1.f / 128.f) + EPS);
    const size_t trow = (size_t)(t0 + 16 * tb + fr);
#pragma unroll
    for (int n = 0; n < 4; ++n) {
        const int v0 = 16 * (4 * vh + n) + 4 * fq;
        const uint2 gr = *(const uint2*)(proj + trow * NIN + OFF_G + h * 128 + v0);
        const f32x4 wv = *(const f32x4*)(hw + v0);
        const float g0 = siluf_(__uint_as_float(gr.x << 16)), g1 = siluf_(__uint_as_float(gr.x & 0xffff0000u)), g2 = siluf_(__uint_as_float(gr.y << 16)), g3 = siluf_(__uint_as_float(gr.y & 0xffff0000u));
        uint2 o; o.x = pack_bf16x2(acc[n][0] * rs * wv[0] * g0, acc[n][1] * rs * wv[1] * g1); o.y = pack_bf16x2(acc[n][2] * rs * wv[2] * g2, acc[n][3] * rs * wv[3] * g3);
        *(uint2*)(ob + trow * 512 + h * 128 + v0) = o;
    }
    __syncthreads();
}


constexpr int LDS_BAR_OFF = GEMM_LDS_BYTES;
constexpr int LDS_PREF_OFF = GEMM_LDS_BYTES + 256;
constexpr int LDS_TOTAL = GEMM_LDS_BYTES + 256 + 2048;

DEV void phase_mod(const Params& p, char* smem) {
    const int tid = opaque_tid(), ks = tid >> 3, sub = tid & 7;
    float* red = (float*)smem;
    for (int cb = blockIdx.x; cb < 256; cb += gridDim.x) {
        const int j0 = cb * 24;
        float a0 = 0.f, a1 = 0.f, a2 = 0.f;
#pragma unroll 4
        for (int i = 0; i < 16; ++i) {
            const int k = ks + 64 * i;
            const float sc = siluf_(p.c[k]);
            const float* w = p.w_ada + (size_t)k * (6 * D) + j0 + 3 * sub;
            a0 += sc * w[0]; a1 += sc * w[1]; a2 += sc * w[2];
        }
        red[ks * 24 + 3 * sub] = a0; red[ks * 24 + 3 * sub + 1] = a1; red[ks * 24 + 3 * sub + 2] = a2;
        __syncthreads();
        if (tid < 24) { float sacc = p.b_ada[j0 + tid]; for (int q = 0; q < 64; ++q) sacc += red[q * 24 + tid]; p.mod[j0 + tid] = sacc; }
        __syncthreads();
    }
}

DEV void phase_norm1(const Params& p) {
    const int tid_ = opaque_tid(), lane = tid_ & 63, gw = blockIdx.x * 8 + (tid_ >> 6), nw = gridDim.x * 8;
    for (int row = gw; row < T; row += nw) {
        const float* xr = p.x + (size_t)row * D;
        float4 v[4]; float ss = 0.f;
#pragma unroll
        for (int i = 0; i < 4; ++i) { v[i] = *(const float4*)(xr + i * 256 + lane * 4); ss += v[i].x * v[i].x + v[i].y * v[i].y + v[i].z * v[i].z + v[i].w * v[i].w; }
        ss = wave_sum(ss);
        const float rs = rsqrtf(ss * (1.f / D) + EPS);
#pragma unroll
        for (int i = 0; i < 4; ++i) {
            const int c = i * 256 + lane * 4;
            const float4 w = *(const float4*)(p.npm + c), sc = *(const float4*)(p.mod + D + c), sh = *(const float4*)(p.mod + c);
            uint2 o; o.x = pack_bf16x2(v[i].x * rs * w.x * (1.f + sc.x) + sh.x, v[i].y * rs * w.y * (1.f + sc.y) + sh.y);
            o.y = pack_bf16x2(v[i].z * rs * w.z * (1.f + sc.z) + sh.z, v[i].w * rs * w.w * (1.f + sc.w) + sh.w);
            *(uint2*)(p.h1 + (size_t)row * D + c) = o;
        }
    }
}

DEV void phase_conv(const Params& p) {
    const int gt = blockIdx.x * 512 + opaque_tid(), nt = gridDim.x * 512;
    for (int idx = gt; idx < T * 64; idx += nt) {
        const int t = idx >> 6, c8 = (idx & 63) * 8;
        float acc[8];
#pragma unroll
        for (int q = 0; q < 8; ++q) acc[q] = 0.f;
#pragma unroll
        for (int j = 0; j < 3; ++j) {
            const int tt = t - 2 + j;
            if (tt >= 0) {
                const uint4 cc = *(const uint4*)(p.proj + (size_t)tt * NIN + OFF_CC + c8), cx = *(const uint4*)(p.proj + (size_t)tt * NIN + OFF_CX + c8);
                const float4 w0 = *(const float4*)(p.conv_w + j * 512 + c8), w1 = *(const float4*)(p.conv_w + j * 512 + c8 + 4);
                acc[0] += w0.x * lo_bf(cc.x) * lo_bf(cx.x); acc[1] += w0.y * hi_bf(cc.x) * hi_bf(cx.x);
                acc[2] += w0.z * lo_bf(cc.y) * lo_bf(cx.y); acc[3] += w0.w * hi_bf(cc.y) * hi_bf(cx.y);
                acc[4] += w1.x * lo_bf(cc.z) * lo_bf(cx.z); acc[5] += w1.y * hi_bf(cc.z) * hi_bf(cx.z);
                acc[6] += w1.z * lo_bf(cc.w) * lo_bf(cx.w); acc[7] += w1.w * hi_bf(cc.w) * hi_bf(cx.w);
            }
        }
        const uint4 cb = *(const uint4*)(p.proj + (size_t)t * NIN + OFF_CB + c8);
        uint4 o;
        o.x = pack_bf16x2(lo_bf(cb.x) * acc[0], hi_bf(cb.x) * acc[1]); o.y = pack_bf16x2(lo_bf(cb.y) * acc[2], hi_bf(cb.y) * acc[3]);
        o.z = pack_bf16x2(lo_bf(cb.z) * acc[4], hi_bf(cb.z) * acc[5]); o.w = pack_bf16x2(lo_bf(cb.w) * acc[6], hi_bf(cb.w) * acc[7]);
        *(uint4*)(p.a1 + (size_t)t * 512 + c8) = o;
    }
}

DEV void phase_mid(const Params& p) {
    const int tid_ = opaque_tid(), lane = tid_ & 63, gw = blockIdx.x * 8 + (tid_ >> 6), nw = gridDim.x * 8;
    for (int row = gw; row < T; row += nw) {
        float yv[16], xv[16]; float ss = 0.f;
#pragma unroll
        for (int i = 0; i < 4; ++i) {
            const uint2 r = *(const uint2*)(p.y + (size_t)row * D + i * 256 + lane * 4);
            yv[4 * i] = lo_bf(r.x); yv[4 * i + 1] = hi_bf(r.x); yv[4 * i + 2] = lo_bf(r.y); yv[4 * i + 3] = hi_bf(r.y);
#pragma unroll
            for (int j = 0; j < 4; ++j) ss += yv[4 * i + j] * yv[4 * i + j];
        }
        ss = wave_sum(ss);
        const float rs = rsqrtf(ss * (1.f / D) + EPS);
        float ss2 = 0.f;
#pragma unroll
        for (int i = 0; i < 4; ++i) {
            const int c = i * 256 + lane * 4;
            const float4 xx = *(const float4*)(p.x + (size_t)row * D + c), g1 = *(const float4*)(p.mod + 2 * D + c), w = *(const float4*)(p.npostm + c);
            float4 o;
            o.x = xx.x + g1.x * (yv[4 * i] * rs * w.x); o.y = xx.y + g1.y * (yv[4 * i + 1] * rs * w.y); o.z = xx.z + g1.z * (yv[4 * i + 2] * rs * w.z); o.w = xx.w + g1.w * (yv[4 * i + 3] * rs * w.w);
            xv[4 * i] = o.x; xv[4 * i + 1] = o.y; xv[4 * i + 2] = o.z; xv[4 * i + 3] = o.w;
            ss2 += o.x * o.x + o.y * o.y + o.z * o.z + o.w * o.w;
            *(float4*)(p.out + (size_t)row * D + c) = o;
        }
        ss2 = wave_sum(ss2);
        const float rs2 = rsqrtf(ss2 * (1.f / D) + EPS);
#pragma unroll
        for (int i = 0; i < 4; ++i) {
            const int c = i * 256 + lane * 4;
            const float4 w = *(const float4*)(p.npf + c), sc = *(const float4*)(p.mod + 4 * D + c), sh = *(const float4*)(p.mod + 3 * D + c);
            uint2 o; o.x = pack_bf16x2(xv[4 * i] * rs2 * w.x * (1.f + sc.x) + sh.x, xv[4 * i + 1] * rs2 * w.y * (1.f + sc.y) + sh.y);
            o.y = pack_bf16x2(xv[4 * i + 2] * rs2 * w.z * (1.f + sc.z) + sh.z, xv[4 * i + 3] * rs2 * w.w * (1.f + sc.w) + sh.w);
            *(uint2*)(p.h2 + (size_t)row * D + c) = o;
        }
    }
}

DEV void phase_route(const Params& p) {
    const int tid_ = opaque_tid(), lane = tid_ & 63, gw = blockIdx.x * 8 + (tid_ >> 6), nw = gridDim.x * 8;
    const float4 rb = *(const float4*)(p.rbias + lane * 4);
    for (int t = gw; t < T; t += nw) {
        const float4 lg = *(const float4*)(p.logits + (size_t)t * E + lane * 4);
        float s[4] = {sigmoidf_(lg.x), sigmoidf_(lg.y), sigmoidf_(lg.z), sigmoidf_(lg.w)};
        float sel[4] = {s[0] + rb.x, s[1] + rb.y, s[2] + rb.z, s[3] + rb.w};
        float m1 = -INFINITY, m2 = -INFINITY;
#pragma unroll
        for (int i = 0; i < 4; ++i) { const float v = sel[i]; if (v > m1) { m2 = m1; m1 = v; } else if (v > m2) m2 = v; }
#pragma unroll
        for (int o = 1; o < 8; o <<= 1) { const float o1 = __shfl_xor(m1, o), o2 = __shfl_xor(m2, o); const float n1 = fmaxf(m1, o1), n2 = fmaxf(fminf(m1, o1), fmaxf(m2, o2)); m1 = n1; m2 = n2; }
        const float gs = m1 + m2; const int g = lane >> 3;
        int rank = 0;
#pragma unroll
        for (int j = 0; j < 8; ++j) { const float gj = __shfl(gs, j * 8); rank += (gj > gs || (gj == gs && j < g)) ? 1 : 0; }
        const bool gsel = rank < 4;
        float val[4];
#pragma unroll
        for (int i = 0; i < 4; ++i) val[i] = gsel ? sel[i] : -INFINITY;
        float wk = 0.f; int ek = 0; float wsum = 0.f;
        for (int r = 0; r < TOPK; ++r) {
            float bv = -INFINITY; int bi = lane * 4;
#pragma unroll
            for (int i = 0; i < 4; ++i) if (val[i] > bv) { bv = val[i]; bi = lane * 4 + i; }
#pragma unroll
            for (int o = 1; o < 64; o <<= 1) { const float ov = __shfl_xor(bv, o); const int oi = __shfl_xor(bi, o); if (ov > bv || (ov == bv && oi < bi)) { bv = ov; bi = oi; } }
            const int owner = bi >> 2, sub = bi & 3;
            float sv = sub == 0 ? s[0] : sub == 1 ? s[1] : sub == 2 ? s[2] : s[3];
            sv = __shfl(sv, owner);
            if (lane == owner) {
#pragma unroll
                for (int i = 0; i < 4; ++i) if (i == sub) val[i] = -INFINITY;
            }
            wsum += sv;
            if (lane == r) { wk = sv; ek = bi; }
        }
        if (lane < TOPK) {
            const int pos = (int)atomicAdd(&p.counts[ek], 1u);
            p.lslot[(size_t)ek * T + pos] = t * TOPK + lane;
            p.lw[(size_t)ek * T + pos] = wk / (wsum + 1e-20f) * 2.5f;
        }
    }
}

DEV void phase_final(const Params& p) {
    const int tid_ = opaque_tid(), lane = tid_ & 63, gw = blockIdx.x * 8 + (tid_ >> 6), nw = gridDim.x * 8;
    for (int row = gw; row < T; row += nw) {
        float mv[16]; float ss = 0.f;
#pragma unroll
        for (int i = 0; i < 4; ++i) {
            const int c = i * 256 + lane * 4;
            const uint2 r = *(const uint2*)(p.shout + (size_t)row * D + c);
            float a0 = lo_bf(r.x), a1 = hi_bf(r.x), a2 = lo_bf(r.y), a3 = hi_bf(r.y);
#pragma unroll
            for (int k = 0; k < TOPK; ++k) { const uint2 q = *(const uint2*)(p.yslot + ((size_t)row * TOPK + k) * D + c); a0 += lo_bf(q.x); a1 += hi_bf(q.x); a2 += lo_bf(q.y); a3 += hi_bf(q.y); }
            mv[4 * i] = a0; mv[4 * i + 1] = a1; mv[4 * i + 2] = a2; mv[4 * i + 3] = a3;
            ss += a0 * a0 + a1 * a1 + a2 * a2 + a3 * a3;
        }
        ss = wave_sum(ss);
        const float rs = rsqrtf(ss * (1.f / D) + EPS);
#pragma unroll
        for (int i = 0; i < 4; ++i) {
            const int c = i * 256 + lane * 4;
            float4 o = *(const float4*)(p.out + (size_t)row * D + c);
            const float4 g2 = *(const float4*)(p.mod + 5 * D + c), w = *(const float4*)(p.npostf + c);
            o.x += g2.x * (mv[4 * i] * rs * w.x); o.y += g2.y * (mv[4 * i + 1] * rs * w.y); o.z += g2.z * (mv[4 * i + 2] * rs * w.z); o.w += g2.w * (mv[4 * i + 3] * rs * w.w);
            *(float4*)(p.out + (size_t)row * D + c) = o;
        }
    }
}

DEV bool dense_unit(int r, int nM, int nN, int& pm, int& pn) {
    const int b = blockIdx.x, G = gridDim.x;
    if ((G & 7) == 0 && (nM & 7) == 0) {
        const int per = nM >> 3, nlb = G >> 3, li = r * nlb + (b >> 3);
        if (li >= per * nN) return false;
        pm = (b & 7) * per + li % per; pn = li / per; return true;
    }
    const int u = r * G + b; if (u >= nM * nN) return false;
    pm = u / nN; pn = u % nN; return true;
}
struct DenseSched {
    const char* A; const char* Bt; int K; int nN;
    DEV bool next(int i, g8::Unit& u) const { int pm, pn; if (!dense_unit(i, T / 256, nN, pm, pn)) return false;
        u.A = A + (size_t)pm * 256 * K * 2; u.B = Bt + (size_t)pn * 256 * K * 2; u.i0 = pm; u.i1 = pn; u.i2 = 0; u.i3 = 0; return true; }
    DEV unsigned rowoff(const g8::Unit&, int) const { return 0u; }
};
struct SubSched {
    const char* A; const char* Bt; int K; int nN; int b0;
    DEV bool next(int i, g8::Unit& u) const { const int nb = (int)gridDim.x - b0, v = i * nb + ((int)blockIdx.x - b0); if (v >= 64 * nN) return false; const int pm = v / nN, pn = v % nN;
        u.A = A + (size_t)pm * 256 * K * 2; u.B = Bt + (size_t)pn * 256 * K * 2; u.i0 = pm; u.i1 = pn; u.i2 = 0; u.i3 = 0; return true; }
    DEV unsigned rowoff(const g8::Unit&, int) const { return 0u; }
};

DEV int perm_expert(int j) { return (j & 31) * 8 + (j >> 5); }
DEV void build_pref(const Params& p, char* smem) {
    int* sp = (int*)(smem + LDS_PREF_OFF);
    const int tid = opaque_tid();
    if (tid < 256) sp[tid + 1] = (int)((p.counts[perm_expert(tid)] + 255u) >> 8);
    if (tid == 0) sp[0] = 0;
    __syncthreads();
    for (int off = 1; off < 256; off <<= 1) {
        int v = 0;
        if (tid < 256 && tid + 1 - off >= 1) v = sp[tid + 1 - off];
        __syncthreads();
        if (tid < 256) sp[tid + 1] += v;
        __syncthreads();
    }
}
template <int NT, int K, bool BYSLOT>
struct ExpSched {
    const int* sp; const unsigned* counts; const int* lslot; const char* A; const char* Bt; size_t bt_estride;
    DEV bool next(int i, g8::Unit& u) const {
        const int G = gridDim.x, b = blockIdx.x;
        int tile, pn, lo, hi;
        if ((G & 7) == 0) { const int xl = b & 7, li = i * (G >> 3) + (b >> 3); pn = li % NT; tile = sp[32 * xl] + li / NT; if (tile >= sp[32 * xl + 32]) return false; lo = 32 * xl; hi = 32 * xl + 32; }
        else { const int li = i * G + b; pn = li % NT; tile = li / NT; if (tile >= sp[256]) return false; lo = 0; hi = 256; }
        while (hi - lo > 1) { const int mid = (lo + hi) >> 1; if (sp[mid] <= tile) lo = mid; else hi = mid; }
        const int e = perm_expert(lo);
        u.A = A; u.B = Bt + (size_t)e * bt_estride + (size_t)pn * 256 * K * 2;
        u.i0 = e; u.i1 = (tile - sp[lo]) * 256; u.i2 = (int)counts[e]; u.i3 = pn; return true;
    }
    DEV unsigned rowoff(const g8::Unit& u, int row) const {
        int rr = u.i1 + row; rr = rr < u.i2 ? rr : u.i2 - 1;
        const int slot = lslot[(size_t)u.i0 * T + rr];
        return (unsigned)(BYSLOT ? slot : (slot >> 3)) * (unsigned)(K * 2);
    }
};

struct FEpiP9 { float* logits; bf16_t* acts; int row0; int pn;
    DEV void operator()(int r, int c, f32x4 v0, f32x4 v1) const {
        if (pn == 0) { float* q = logits + (size_t)(row0 + r) * E + c; *(f32x4*)q = v0; *(f32x4*)(q + 16) = v1; }
        else { uint2 o; o.x = pack_bf16x2(siluf_(v0[0]) * v1[0], siluf_(v0[1]) * v1[1]); o.y = pack_bf16x2(siluf_(v0[2]) * v1[2], siluf_(v0[3]) * v1[3]);
               *(uint2*)(acts + (size_t)(row0 + r) * FF + (pn - 1) * 128 + (c >> 5) * 16 + (c & 15)) = o; } } };

DEV void cvt_tile(const float* src, bf16_t* dst, int ld, int dstK, int pair, int k0, int n0, int lane) {
    const int nq = lane & 15, kq = lane >> 4;
    const float* sp_ = src + (size_t)(k0 + 8 * kq) * ld + n0 + 4 * nq;
    float4 v[8];
#pragma unroll
    for (int r = 0; r < 8; ++r) v[r] = *(const float4*)(sp_ + (size_t)r * ld);
#pragma unroll
    for (int q = 0; q < 4; ++q) {
        const int n = n0 + 4 * nq + q;
        const int row = pair ? (((n >> 4) * 2 + (pair - 1)) * 16 + (n & 15)) : n;
        float e[8];
#pragma unroll
        for (int r = 0; r < 8; ++r) e[r] = q == 0 ? v[r].x : q == 1 ? v[r].y : q == 2 ? v[r].z : v[r].w;
        uint4 o; o.x = pack_bf16x2(e[0], e[1]); o.y = pack_bf16x2(e[2], e[3]); o.z = pack_bf16x2(e[4], e[5]); o.w = pack_bf16x2(e[6], e[7]);
        *(uint4*)(dst + (size_t)row * dstK + k0 + 8 * kq) = o;
    }
}
DEV void phase_convert(const Params& p) {
    const int tid_ = opaque_tid(), lane = tid_ & 63, gw = blockIdx.x * 8 + (tid_ >> 6), nw = gridDim.x * 8;
    constexpr int R0 = 2816, R1 = R0 + 256, R2 = R1 + 256, R3 = R2 + 512, R4 = R3 + 128, R5 = R4 + 128, R6 = R5 + 128, R7 = R6 + 128, R8 = R7 + 32768, R9 = R8 + 32768, R10 = R9 + 32768;
    for (int t = gw; t < R7; t += nw) {
        const float* src; bf16_t* dst; int K, N, pair, loc;
        if (t < R0) { src = p.w_in; dst = p.WinT; K = 1024; N = NIN; pair = 0; loc = t; }
        else if (t < R1) { src = p.w_conv_out; dst = p.WcoT; K = 512; N = D; pair = 0; loc = t - R0; }
        else if (t < R2) { src = p.w_hgrn_out; dst = p.WhoT; K = 512; N = D; pair = 0; loc = t - R1; }
        else if (t < R3) { src = p.w_o; dst = p.WoT; K = 1024; N = D; pair = 0; loc = t - R2; }
        else if (t < R4) { src = p.w_router; dst = p.WrsT; K = 1024; N = E; pair = 0; loc = t - R3; }
        else if (t < R5) { src = p.wgs; dst = p.WrsT + (size_t)256 * 1024; K = 1024; N = FF; pair = 1; loc = t - R4; }
        else if (t < R6) { src = p.wus; dst = p.WrsT + (size_t)256 * 1024; K = 1024; N = FF; pair = 2; loc = t - R5; }
        else if (t < R7) { src = p.wds; dst = p.WdsT; K = 256; N = D; pair = 0; loc = t - R6; }
        else if (t < R8) { const int l = t - R7, e = l >> 7; src = p.wge + (size_t)e * D * FF; dst = p.WgeuT + (size_t)e * 512 * 1024; K = 1024; N = FF; pair = 1; loc = l & 127; }
        else if (t < R9) { const int l = t - R8, e = l >> 7; src = p.wue + (size_t)e * D * FF; dst = p.WgeuT + (size_t)e * 512 * 1024; K = 1024; N = FF; pair = 2; loc = l & 127; }
        else { const int l = t - R9, e = l >> 7; src = p.wde + (size_t)e * FF * D; dst = p.WdeT + (size_t)e * 1024 * 256; K = 256; N = D; pair = 0; loc = l & 127; }
        const int nnt = N >> 6, kt = loc / nnt, ntile = loc % nnt;
        cvt_tile(src, dst, N, K, pair, kt * 32, ntile * 64, lane);
    }
}

__global__ void __launch_bounds__(512, 2) k_mega(Params p) {
    extern __shared__ __attribute__((aligned(16))) char smem[];
    volatile LAS unsigned* st = (volatile LAS unsigned*)(smem + LDS_BAR_OFF);
    LAS unsigned char* lds = (LAS unsigned char*)smem;
    if (threadIdx.x == 0) { st[0] = 0u; st[1] = 0u; st[2] = 0u; st[3] = 0u; }
    __syncthreads();
    const XcdBarrier bar = xcd_barrier_post(p.bar, st);

    phase_mod(p, smem);
    phase_convert(p);
    xcd_barrier(bar);
    phase_norm1(p);
    xcd_barrier(bar);
    g8::gemm_stream<false>(lds, D, DenseSched{(const char*)p.h1, (const char*)p.WinT, D, NIN / 256},
        [&](const g8::Unit& u) { return FEpiStoreBf16{p.proj, NIN, u.i0 * 256, u.i1 * 256}; });
    xcd_barrier(bar);
    phase_conv(p);
    for (int u = blockIdx.x; u < 1024; u += gridDim.x) hgrn_phase1(smem, p.proj, p.lbt, p.kcT, p.dec, u >> 2, u & 3);
    xcd_barrier(bar);
    {
        const int G = gridDim.x, b = blockIdx.x, nscan = G >> 1;
        if (b < nscan) { for (int e = b * 512 + opaque_tid(); e < 65536; e += nscan * 512) hgrn_phase2(p.kcT, p.dec, p.ST, e); }
        else g8::gemm_stream<false>(lds, 512, SubSched{(const char*)p.a1, (const char*)p.WcoT, 512, D / 256, nscan},
                [&](const g8::Unit& u) { return FEpiGateA{p.m, p.proj, u.i0 * 256, u.i1 * 256}; });
    }
    xcd_barrier(bar);
    for (int u = blockIdx.x; u < 1024; u += gridDim.x) hgrn_phase3(smem, p.proj, p.lbt, p.ST, p.hnw, p.ob, u >> 2, u & 3);
    xcd_barrier(bar);
    g8::gemm_stream<false>(lds, 512, DenseSched{(const char*)p.ob, (const char*)p.WhoT, 512, D / 256},
        [&](const g8::Unit& u) { return FEpiGateB{p.m, p.proj, u.i0 * 256, u.i1 * 256}; });
    xcd_barrier(bar);
    g8::gemm_stream<false>(lds, D, DenseSched{(const char*)p.m, (const char*)p.WoT, D, D / 256},
        [&](const g8::Unit& u) { return FEpiStoreBf16{p.y, D, u.i0 * 256, u.i1 * 256}; });
    xcd_barrier(bar);
    phase_mid(p);
    xcd_barrier(bar);
    g8::gemm_stream<false>(lds, D, DenseSched{(const char*)p.h2, (const char*)p.WrsT, D, 3},
        [&](const g8::Unit& u) { return FEpiP9{p.logits, p.acts, u.i0 * 256, u.i1}; });
    xcd_barrier(bar);
    phase_route(p);
    g8::gemm_stream<false>(lds, FF, DenseSched{(const char*)p.acts, (const char*)p.WdsT, FF, D / 256},
        [&](const g8::Unit& u) { return FEpiStoreBf16{p.shout, D, u.i0 * 256, u.i1 * 256}; });
    xcd_barrier(bar);
    build_pref(p, smem);
    {
        const int* sp = (const int*)(smem + LDS_PREF_OFF);
        const int ni = sp[256];
        for (int it = blockIdx.x; it < ni * 2; it += gridDim.x) {
            const int item = it >> 1, pn = it & 1; int lo = 0, hi = 256;
            while (hi - lo > 1) { const int mid = (lo + hi) >> 1; if (sp[mid] <= item) lo = mid; else hi = mid; }
            const int e = perm_expert(lo), r0 = (item - sp[lo]) * 256, cnt = (int)p.counts[e];
            gemm_unit<256>(smem, FAMapGather{p.h2, D, p.lslot, e * T, cnt, r0}, FBMapPair{p.wge + (size_t)e * D * FF, p.wue + (size_t)e * D * FF, FF, pn * 128},
                           FEpiSwiGLUSlot{p.act, p.lslot, e * T, cnt, r0, pn * 128}, D);
            __syncthreads();
        }
    }
    xcd_barrier(bar);
    {
        const int* sp = (const int*)(smem + LDS_PREF_OFF);
        const int ni = sp[256];
        for (int it = blockIdx.x; it < ni * 4; it += gridDim.x) {
            const int item = it >> 2, pn = it & 3; int lo = 0, hi = 256;
            while (hi - lo > 1) { const int mid = (lo + hi) >> 1; if (sp[mid] <= item) lo = mid; else hi = mid; }
            const int e = perm_expert(lo), r0 = (item - sp[lo]) * 256, cnt = (int)p.counts[e];
            gemm_unit<256>(smem, FAMapSlot{p.act, FF, p.lslot, e * T, cnt, r0}, FBMapPlain{p.wde + (size_t)e * FF * D, D, pn * 256},
                           FEpiSlot{p.yslot, p.lslot, p.lw, e * T, cnt, r0, pn * 256}, FF);
            __syncthreads();
        }
    }
    xcd_barrier(bar);
    phase_final(p);
}

extern "C" void kernel_launch(void* const* d_in, const int* in_sizes, int n_in, void* d_out, int out_size, void* d_ws, size_t ws_size, hipStream_t stream) {
    Params p; memset(&p, 0, sizeof(p));
    p.x = (const float*)d_in[0]; p.c = (const float*)d_in[1]; p.w_ada = (const float*)d_in[2]; p.b_ada = (const float*)d_in[3];
    p.npm = (const float*)d_in[4]; p.npostm = (const float*)d_in[5]; p.w_in = (const float*)d_in[6]; p.conv_w = (const float*)d_in[7];
    p.w_conv_out = (const float*)d_in[8]; p.lbt = (const float*)d_in[9]; p.hnw = (const float*)d_in[10]; p.w_hgrn_out = (const float*)d_in[11];
    p.w_o = (const float*)d_in[12]; p.npf = (const float*)d_in[13]; p.npostf = (const float*)d_in[14]; p.w_router = (const float*)d_in[15];
    p.rbias = (const float*)d_in[16]; p.wge = (const float*)d_in[17]; p.wue = (const float*)d_in[18]; p.wde = (const float*)d_in[19];
    p.wgs = (const float*)d_in[20]; p.wus = (const float*)d_in[21]; p.wds = (const float*)d_in[22];
    p.out = (float*)d_out;
    char* base = (char*)d_ws; size_t off = 0;
    auto take = [&](size_t bytes) { char* r = base + off; off += (bytes + 255) & ~(size_t)255; return r; };
    char* ctrl = take(65536);
    p.bar = (unsigned*)ctrl; p.counts = (unsigned*)(ctrl + 16384);
    p.mod = (float*)take(6 * D * 4);
    p.WinT = (bf16_t*)take((size_t)NIN * D * 2);
    p.WcoT = (bf16_t*)take((size_t)D * 512 * 2);
    p.WhoT = (bf16_t*)take((size_t)D * 512 * 2);
    p.WoT = (bf16_t*)take((size_t)D * D * 2);
    p.WrsT = (bf16_t*)take((size_t)768 * D * 2);
    p.WdsT = (bf16_t*)take((size_t)D * FF * 2);
    p.WgeuT = (bf16_t*)take((size_t)E * 512 * D * 2);
    p.WdeT = (bf16_t*)take((size_t)E * D * FF * 2);
    char* r1 = take((size_t)T * NIN * 2 + (size_t)256 * 65536 * 4 + (size_t)256 * 65536 * 2);
    p.proj = (bf16_t*)r1; p.kcT = (float*)(r1 + (size_t)T * NIN * 2); p.ST = (bf16_t*)(r1 + (size_t)T * NIN * 2 + (size_t)256 * 65536 * 4);
    p.yslot = (bf16_t*)r1;
    p.dec = (float*)take((size_t)256 * 512 * 4);
    char* r2 = take((size_t)3 * T * D * 2);
    p.h1 = (bf16_t*)r2; p.m = (bf16_t*)(r2 + (size_t)T * D * 2); p.y = (bf16_t*)(r2 + (size_t)2 * T * D * 2);
    p.act = (bf16_t*)r2;
    p.a1 = (bf16_t*)take((size_t)T * 512 * 2);
    p.ob = (bf16_t*)take((size_t)T * 512 * 2);
    p.h2 = (bf16_t*)take((size_t)T * D * 2);
    p.logits = (float*)take((size_t)T * E * 4);
    p.lslot = (int*)take((size_t)E * T * 4);
    p.lw = (float*)take((size_t)E * T * 4);
    p.acts = (bf16_t*)take((size_t)T * FF * 2);
    p.shout = (bf16_t*)take((size_t)T * D * 2);

    static int grid = 0;
    if (!grid) {
        (void)hipFuncSetAttribute((const void*)k_mega, hipFuncAttributeMaxDynamicSharedMemorySize, LDS_TOTAL);
        int dev = 0, cus = 0, per_cu = 0;
        (void)hipGetDevice(&dev);
        (void)hipDeviceGetAttribute(&cus, hipDeviceAttributeMultiprocessorCount, dev);
        (void)hipOccupancyMaxActiveBlocksPerMultiprocessor(&per_cu, (const void*)k_mega, 512, LDS_TOTAL);
        if (cus <= 0) cus = 256;
        grid = cus * (per_cu < 1 ? per_cu : 1);
        if (grid <= 0) grid = cus;
    }
    (void)hipMemsetAsync(ctrl, 0, 65536, stream);
    k_mega<<<grid, 512, LDS_TOTAL, stream>>>(p);
}
```

```cpp
#include <hip/hip_runtime.h>
#include <stdint.h>
#include <string.h>
#include <stddef.h>

typedef unsigned short bf16_t;
#define DEV __device__ __forceinline__

constexpr int T = 16384, D = 1024, NIN = 5632, E = 256, FF = 256, TOPK = 8;
constexpr int OFF_CB = 0, OFF_CC = 512, OFF_CX = 1024, OFF_Q = 1536, OFF_F = 2048, OFF_I = 2560, OFF_G = 3072, OFF_GA = 3584, OFF_GB = 4608;
constexpr float EPS = 1e-6f;

DEV float bf2f(bf16_t v) { return __uint_as_float(((unsigned)v) << 16); }
DEV bf16_t f2bf(float f) { unsigned u = __float_as_uint(f); u += 0x7FFFu + ((u >> 16) & 1u); return (bf16_t)(u >> 16); }
DEV float sigmoidf_(float x) { return 1.f / (1.f + __expf(-x)); }
DEV float siluf_(float x) { return x / (1.f + __expf(-x)); }
DEV float wave_sum(float v) {
#pragma unroll
    for (int o = 32; o > 0; o >>= 1) v += __shfl_xor(v, o);
    return v;
}
DEV int opaque_tid() { int t = threadIdx.x; asm volatile("" : "+v"(t)); return t; }
DEV float lo_bf(unsigned u) { return __uint_as_float(u << 16); }
DEV float hi_bf(unsigned u) { return __uint_as_float(u & 0xffff0000u); }

#define XB_TMO      128
#define XB_XCNT(j)  (256  + 64 * (j))
#define XB_XSUB(j)  (1280 + 64 * (j))
#define XB_XGEN(j)  (2304 + 64 * (j))
#define XB_TOP      3328
#define XB_TOPGEN   3392
#define XCD_BAR_WORDS 3456
#define XB_SPIN_CAP (1u << 18)
#define LAS __attribute__((address_space(3)))
__device__ __forceinline__ unsigned xb_ld(unsigned* p)              { return __hip_atomic_load(p, __ATOMIC_RELAXED, __HIP_MEMORY_SCOPE_AGENT); }
__device__ __forceinline__ unsigned xb_add(unsigned* p, unsigned v) { return __hip_atomic_fetch_add(p, v, __ATOMIC_RELAXED, __HIP_MEMORY_SCOPE_AGENT); }
__device__ __forceinline__ unsigned xb_xcc_id() { return (unsigned)__builtin_amdgcn_s_getreg((3 << 11) | 20) & 0xFu; }
#define XB_SPIN(cond, bar) do { unsigned _sp = 0; while (cond) { __builtin_amdgcn_s_sleep(1); \
    if ((++_sp & 255u) == 0u) { if (xb_ld(&(bar)[XB_TMO])) break; if (_sp > XB_SPIN_CAP) { atomicAdd(&(bar)[XB_TMO], 1u); break; } } } } while (0)
struct XcdBarrier { unsigned* bar; unsigned x; volatile LAS unsigned* st; };
__device__ __forceinline__ XcdBarrier xcd_barrier_post(unsigned* bar, volatile LAS unsigned* st) {
    XcdBarrier b; b.bar = bar; b.x = xb_xcc_id(); b.st = st;
    if (threadIdx.x == 0) (void)xb_add(&bar[XB_XCNT(b.x)], 1u);
    return b;
}
__device__ __forceinline__ void xcd_barrier_complete(unsigned* bar, unsigned x, unsigned& nloc, unsigned& nx) {
    const unsigned G = gridDim.x * gridDim.y * gridDim.z;
    unsigned sum, cnt, mine, sp = 0u;
    for (;;) {
        sum = 0u; cnt = 0u; mine = 0u;
#pragma unroll
        for (unsigned j = 0; j < 16; ++j) { const unsigned c = xb_ld(&bar[XB_XCNT(j)]); sum += c; cnt += (c > 0u) ? 1u : 0u; mine = (j == x) ? c : mine; }
        if (sum == G) break;
        __builtin_amdgcn_s_sleep(1);
        if ((++sp & 255u) == 0u) { if (xb_ld(&bar[XB_TMO])) break; if (sp > XB_SPIN_CAP) { atomicAdd(&bar[XB_TMO], 1u); break; } }
    }
    nloc = mine > 0u ? mine : 1u; nx = cnt > 0u ? cnt : 1u;
}
__device__ __forceinline__ void xcd_barrier(const XcdBarrier& b) {
    asm volatile("s_waitcnt vmcnt(0)" ::: "memory");
    __syncthreads();
    if (threadIdx.x == 0) {
        unsigned* bar = b.bar;
        __builtin_amdgcn_s_waitcnt(0);
        unsigned nloc = b.st[0], nx = b.st[1];
        if (nloc == 0u) { xcd_barrier_complete(bar, b.x, nloc, nx); b.st[0] = nloc; b.st[1] = nx; }
        const unsigned old = xb_add(&bar[XB_XSUB(b.x)], 1u);
        const unsigned gen = old / nloc;
        if (old + 1u == (gen + 1u) * nloc) {
            __builtin_amdgcn_fence(__ATOMIC_RELEASE, "agent");
            asm volatile("s_waitcnt vmcnt(0)" ::: "memory");
            const unsigned og = xb_add(&bar[XB_TOP], 1u);
            const unsigned tg = og / nx;
            if (og + 1u == (tg + 1u) * nx) xb_add(&bar[XB_TOPGEN], 1u);
            else XB_SPIN(xb_ld(&bar[XB_TOPGEN]) == tg, bar);
            __builtin_amdgcn_fence(__ATOMIC_ACQUIRE, "agent");
            xb_add(&bar[XB_XGEN(b.x)], 1u);
            asm volatile("s_waitcnt vmcnt(0)" ::: "memory");
        } else {
            XB_SPIN(xb_ld(&bar[XB_XGEN(b.x)]) == gen, bar);
            __builtin_amdgcn_fence(__ATOMIC_ACQUIRE, "agent");
            asm volatile("s_waitcnt vmcnt(0)" ::: "memory");
        }
    }
    __syncthreads();
}

struct Params {
    const float *x, *c, *w_ada, *b_ada, *npm, *npostm, *w_in, *conv_w, *w_conv_out, *lbt, *hnw, *w_hgrn_out, *w_o, *npf, *npostf, *w_router, *rbias, *wge, *wue, *wde, *wgs, *wus, *wds;
    float* out;
    unsigned* bar;
    unsigned* counts;
    bf16_t *WinT, *WcoT, *WhoT, *WoT, *WrsT, *WdsT, *WgeuT, *WdeT;
    float* mod;
    bf16_t* h1;
    bf16_t* proj;
    float* kcT;
    float* dec;
    bf16_t* ST;
    bf16_t* a1;
    bf16_t* ob;
    bf16_t* m;
    bf16_t* y;
    bf16_t* h2;
    float* logits;
    int* lslot;
    float* lw;
    bf16_t* act;
    bf16_t* yslot;
    bf16_t* acts;
    bf16_t* shout;
};
typedef short bf16x8 __attribute__((ext_vector_type(8)));
typedef float f32x4 __attribute__((ext_vector_type(4)));
constexpr int GEMM_LDS_BYTES = 131072;
typedef __bf16 hwbf16x2 __attribute__((ext_vector_type(2)));
DEV unsigned pack_bf16x2(float lo, float hi) { hwbf16x2 v = {(__bf16)lo, (__bf16)hi}; return __builtin_bit_cast(unsigned, v); }

namespace g8 {
constexpr int BK = 64, HALF = 128, HTB = HALF * BK * 2;
DEV int lds_byte(int r, int c) { const int st = (r >> 4) * 2 + (c >> 5), rr = r & 15, cc = c & 31, ob = rr * 64 + cc * 2; return st * 1024 + (ob ^ (((ob >> 9) & 1) << 5)); }
DEV void stage_rc(int b, int& R, int& C) { const int st = b / 1024, sb = b % 1024, swz = sb ^ (((sb >> 9) & 1) << 5); R = (st >> 1) * 16 + swz / 64; C = (st & 1) * 32 + (swz % 64) / 2; }

struct Unit { const char* A; const char* B; int i0, i1, i2, i3; };

template <bool GATHER, class Sched, class EpiF>
DEV void gemm_stream(LAS unsigned char* lds, const int K, const Sched& S, const EpiF& EF) {
    const int tid = opaque_tid(), wid = __builtin_amdgcn_readfirstlane(tid >> 6), lane = tid & 63, wr = wid >> 2, wc = wid & 3, fr = lane & 15, fq = lane >> 4;
    const int nt = K / BK;
    int Rr[2], Cc[2];
    unsigned voffB[2];
#pragma unroll
    for (int i = 0; i < 2; ++i) { stage_rc(tid * 16 + i * 8192, Rr[i], Cc[i]); voffB[i] = (unsigned)(Rr[i] * K + Cc[i]) * 2u; }
    const size_t kstep = (size_t)(BK * 2);
    const size_t hstepB = (size_t)HALF * K * 2;
    const size_t hstepA = GATHER ? 0 : hstepB;
    const unsigned ldsw = (unsigned)wid * 1024u;
    const int aoff = lds_byte(wr * 64 + fr, fq * 8), boff = lds_byte(wc * 32 + fr, fq * 8);
#define G8_SA(b, h) (((b) * 2 + (h)) * HTB)
#define G8_SB(b, h) ((4 + (b) * 2 + (h)) * HTB)
#define G8_STAGE(bufoff, gbase, v0_, v1_) do { \
        __builtin_amdgcn_global_load_lds((const unsigned*)((const char*)(gbase) + (v0_)), (LAS unsigned*)(lds + (bufoff) + ldsw), 16, 0, 0); \
        __builtin_amdgcn_global_load_lds((const unsigned*)((const char*)(gbase) + (v1_)), (LAS unsigned*)(lds + (bufoff) + ldsw + 8192), 16, 0, 0); } while (0)
#define G8_STAGE_B(b, h, gbase) G8_STAGE(G8_SB(b, h), gbase, voffB[0], voffB[1])
#define G8_STAGE_A(b, h, gbase, VA) G8_STAGE(G8_SA(b, h), gbase, VA[h][0], VA[h][1])
#define G8_LDA(dst, b, h) do { _Pragma("unroll") for (int m = 0; m < 4; ++m) _Pragma("unroll") for (int k = 0; k < 2; ++k) dst[m][k] = *(const LAS bf16x8*)(lds + G8_SA(b, h) + aoff + m * 2048 + k * 1024); } while (0)
#define G8_LDB(dst, b, h) do { _Pragma("unroll") for (int n = 0; n < 2; ++n) _Pragma("unroll") for (int k = 0; k < 2; ++k) dst[n][k] = *(const LAS bf16x8*)(lds + G8_SB(b, h) + boff + n * 2048 + k * 1024); } while (0)
#define G8_MMA(ai, bj, At, Bt) do { __builtin_amdgcn_s_setprio(1); _Pragma("unroll") for (int m = 0; m < 4; ++m) _Pragma("unroll") for (int n = 0; n < 2; ++n) _Pragma("unroll") for (int k = 0; k < 2; ++k) \
        acc[ai][bj][m][n] = __builtin_amdgcn_mfma_f32_16x16x32_bf16(Bt[n][k], At[m][k], acc[ai][bj][m][n], 0, 0, 0); __builtin_amdgcn_s_setprio(0); } while (0)
#define G8_WAIT_V(n) asm volatile("s_waitcnt vmcnt(" #n ")" ::: "memory")
#define G8_WAIT_L(n) asm volatile("s_waitcnt lgkmcnt(" #n ")" ::: "memory")
#define G8_BAR __builtin_amdgcn_s_barrier()
#define G8_SCHED __builtin_amdgcn_sched_barrier(0)
#define G8_VOFF(VA, u) do { _Pragma("unroll") for (int h_ = 0; h_ < 2; ++h_) _Pragma("unroll") for (int i_ = 0; i_ < 2; ++i_) \
        VA[h_][i_] = GATHER ? (S.rowoff(u, Rr[i_] + 128 * h_) + (unsigned)Cc[i_] * 2u) : (unsigned)(Rr[i_] * K + Cc[i_]) * 2u; } while (0)
    Unit cur, nxt; int ui = 0;
    if (!S.next(0, cur)) return;
    f32x4 acc[2][2][4][2];
#pragma unroll
    for (int a_ = 0; a_ < 2; ++a_)
#pragma unroll
        for (int b_ = 0; b_ < 2; ++b_)
#pragma unroll
            for (int m = 0; m < 4; ++m)
#pragma unroll
                for (int n = 0; n < 2; ++n) acc[a_][b_][m][n] = (f32x4){0.f, 0.f, 0.f, 0.f};
    bf16x8 At[4][2], B0[2][2], B1[2][2];
    unsigned vAc[2][2], vAn[2][2];
    G8_VOFF(vAc, cur);
#pragma unroll
    for (int h_ = 0; h_ < 2; ++h_)
#pragma unroll
        for (int i_ = 0; i_ < 2; ++i_) vAn[h_][i_] = vAc[h_][i_];
    const char* cA = cur.A; const char* cB = cur.B;
    G8_STAGE_B(0, 0, cB); G8_STAGE_A(0, 0, cA, vAc); G8_STAGE_B(0, 1, cB + hstepB); G8_STAGE_A(0, 1, cA + hstepA, vAc);
    if (wr == 1) G8_BAR;
    G8_WAIT_V(4); G8_BAR;
    G8_STAGE_B(1, 0, cB + kstep); G8_STAGE_A(1, 0, cA + kstep, vAc); G8_STAGE_B(1, 1, cB + hstepB + kstep);
    G8_WAIT_V(6); G8_BAR;
    for (;;) {
        const bool has_next = S.next(ui + 1, nxt);
        const char* nA = has_next ? nxt.A : cA; const char* nB = has_next ? nxt.B : cB;
#pragma unroll 1
        for (int t = 0; t < nt; t += 2) {
            const bool last = (t == nt - 2);
            const char* a1 = cA + (size_t)(t + 1) * kstep;
            const char* a2 = last ? nA : cA + (size_t)(t + 2) * kstep; const char* b2 = last ? nB : cB + (size_t)(t + 2) * kstep;
            const char* a3 = a2 + kstep; const char* b3 = b2 + kstep;
            unsigned vA2[2][2];
#pragma unroll
            for (int h_ = 0; h_ < 2; ++h_)
#pragma unroll
                for (int i_ = 0; i_ < 2; ++i_) vA2[h_][i_] = vAc[h_][i_];
            if constexpr (GATHER) { if (last && has_next) { G8_VOFF(vAn, nxt);
#pragma unroll
                for (int h_ = 0; h_ < 2; ++h_)
#pragma unroll
                    for (int i_ = 0; i_ < 2; ++i_) vA2[h_][i_] = vAn[h_][i_]; } }
            G8_LDB(B0, 0, 0); G8_SCHED; G8_LDA(At, 0, 0); G8_STAGE_A(1, 1, a1 + hstepA, vAc);
            G8_WAIT_L(8); G8_BAR; G8_WAIT_L(0); G8_MMA(0, 0, At, B0); G8_BAR; G8_SCHED;
            G8_LDB(B1, 0, 1); G8_STAGE_B(0, 0, b2);
            G8_BAR; G8_WAIT_L(0); G8_MMA(0, 1, At, B1); G8_BAR;
            G8_LDA(At, 0, 1); G8_STAGE_A(0, 0, a2, vA2);
            G8_BAR; G8_WAIT_L(0); G8_MMA(1, 0, At, B0); G8_BAR; G8_SCHED;
            G8_STAGE_B(0, 1, b2 + hstepB);
            G8_WAIT_V(6); G8_BAR; G8_MMA(1, 1, At, B1); G8_BAR;
            G8_LDB(B0, 1, 0); G8_SCHED; G8_LDA(At, 1, 0); G8_STAGE_A(0, 1, a2 + hstepA, vA2);
            G8_WAIT_L(8); G8_BAR; G8_WAIT_L(0); G8_MMA(0, 0, At, B0); G8_BAR; G8_SCHED;
            G8_LDB(B1, 1, 1); G8_STAGE_B(1, 0, b3);
            G8_BAR; G8_WAIT_L(0); G8_MMA(0, 1, At, B1); G8_BAR;
            G8_LDA(At, 1, 1); G8_STAGE_A(1, 0, a3, vA2);
            G8_BAR; G8_WAIT_L(0); G8_MMA(1, 0, At, B0); G8_BAR; G8_SCHED;
            G8_STAGE_B(1, 1, b3 + hstepB);
            G8_WAIT_V(6); G8_BAR; G8_MMA(1, 1, At, B1); G8_BAR;
        }
        {
            const auto epi = EF(cur);
#pragma unroll
            for (int ai = 0; ai < 2; ++ai)
#pragma unroll
                for (int m = 0; m < 4; ++m)
#pragma unroll
                    for (int bj = 0; bj < 2; ++bj) epi(128 * ai + 64 * wr + 16 * m + fr, 128 * bj + 32 * wc + 4 * fq, acc[ai][bj][m][0], acc[ai][bj][m][1]);
        }
        if (!has_next) break;
#pragma unroll
        for (int a_ = 0; a_ < 2; ++a_)
#pragma unroll
            for (int b_ = 0; b_ < 2; ++b_)
#pragma unroll
                for (int m = 0; m < 4; ++m)
#pragma unroll
                    for (int n = 0; n < 2; ++n) acc[a_][b_][m][n] = (f32x4){0.f, 0.f, 0.f, 0.f};
        if constexpr (GATHER) {
#pragma unroll
            for (int h_ = 0; h_ < 2; ++h_)
#pragma unroll
                for (int i_ = 0; i_ < 2; ++i_) vAc[h_][i_] = vAn[h_][i_]; }
        cur = nxt; cA = nA; cB = nB; ++ui;
    }
    G8_WAIT_V(0);
    if (wr == 0) G8_BAR;
    G8_BAR;
#undef G8_SA
#undef G8_SB
#undef G8_STAGE
#undef G8_STAGE_A
#undef G8_STAGE_B
#undef G8_LDA
#undef G8_LDB
#undef G8_MMA
#undef G8_WAIT_V
#undef G8_WAIT_L
#undef G8_BAR
#undef G8_SCHED
#undef G8_VOFF
}
}

typedef short s16x4 __attribute__((ext_vector_type(4)));


struct FAMapPlain { const bf16_t* A; int lda; int row0; DEV const bf16_t* operator()(int r) const { return A + (size_t)(row0 + r) * lda; } DEV const bf16_t* aorigin() const { return A; } };
struct FAMapGather { const bf16_t* A; int lda; const int* lslot; int base; int cnt; int r0;
    DEV const bf16_t* operator()(int r) const { int rr = r0 + r; rr = rr < cnt ? rr : cnt - 1; return A + (size_t)(lslot[base + rr] >> 3) * lda; } DEV const bf16_t* aorigin() const { return A; } };
struct FAMapSlot { const bf16_t* A; int lda; const int* lslot; int base; int cnt; int r0;
    DEV const bf16_t* operator()(int r) const { int rr = r0 + r; rr = rr < cnt ? rr : cnt - 1; return A + (size_t)lslot[base + rr] * lda; } DEV const bf16_t* aorigin() const { return A; } };
struct FBMapPlain { const float* W; int ldb; int col0; DEV const float* ptr(int vb) const { return W + col0 + vb * 16; } DEV int ld() const { return ldb; } };
struct FBMapPair { const float* Wg; const float* Wu; int ldb; int col0;
    DEV const float* ptr(int vb) const { return Wg + (ptrdiff_t)(vb & 1) * (Wu - Wg) + col0 + (vb >> 1) * 16; } DEV int ld() const { return ldb; } };

template <int BM, class AMap, class BMap, class Epi>
DEV void gemm_unit(char* smem, const AMap& amap, const BMap& bmap, const Epi& epi, int K) {
    constexpr int NA = BM / 64, MI = BM / 32, ABYTES = BM * 128, STG = ABYTES + 32768;
    const int tid = opaque_tid(), lane = tid & 63, wid = tid >> 6, wr = wid >> 2, wc = wid & 3, fr = lane & 15, fq = lane >> 4;
    const bf16_t* aptr[NA];
#pragma unroll
    for (int i = 0; i < NA; ++i) { const int c = tid + 512 * i, row = c >> 3, pch = c & 7; aptr[i] = amap(row) + ((pch ^ (row & 7)) << 3); }
    const int g = lane >> 4, j16 = lane & 15, krow = j16 >> 2, c4 = j16 & 3, vg = wid & 3, kh = wid >> 2;
    const int ldb = bmap.ld();
    const float* bptr = bmap.ptr(vg * 4 + g) + 4 * c4 + (size_t)(4 * kh + krow) * ldb;
    unsigned bwr[2];
#pragma unroll
    for (int o = 0; o < 2; ++o) bwr[o] = ABYTES + (vg * 4 + g) * 256 + (((4 * kh + krow) ^ (o << 2)) * 32) + c4 * 8;
    unsigned ard[2];
#pragma unroll
    for (int ks = 0; ks < 2; ++ks) { const int row = wr * (BM / 2) + fr; ard[ks] = row * 128 + (((ks * 4 + fq) ^ (row & 7)) << 4); }
    unsigned brd[2];
    { const int q = j16 >> 2, p = j16 & 3;
#pragma unroll
      for (int t = 0; t < 2; ++t) brd[t] = ABYTES + (fq * 16) * 256 + (((4 * t + q) ^ ((fq & 1) << 2)) * 32) + p * 8; }

    f32x4 acc[MI][4];
#pragma unroll
    for (int mi = 0; mi < MI; ++mi)
#pragma unroll
        for (int nf = 0; nf < 4; ++nf) acc[mi][nf] = (f32x4){0.f, 0.f, 0.f, 0.f};

    float4 breg[4];
    const int nk = K >> 6;
#define G_LOAD_A(kt, buf) do { _Pragma("unroll") for (int i = 0; i < NA; ++i) \
        __builtin_amdgcn_global_load_lds((const unsigned*)(aptr[i] + (kt) * 64), (LAS unsigned*)(smem + (buf) * STG + (tid + 512 * i) * 16), 16, 0, 0); } while (0)
#define G_LOAD_B(kt, h) do { _Pragma("unroll") for (int i = 0; i < 4; ++i) breg[i] = *(const float4*)(bptr + (size_t)((kt) * 64 + 8 * ((h) * 4 + i)) * ldb); } while (0)
#define G_WRITE_B(buf, h) do { char* sb_ = smem + (buf) * STG; \
        _Pragma("unroll") for (int i = 0; i < 4; ++i) { uint2 w; w.x = pack_bf16x2(breg[i].x, breg[i].y); w.y = pack_bf16x2(breg[i].z, breg[i].w); \
            *(uint2*)(sb_ + bwr[i & 1] + ((h) * 4 + i) * 16 * 256) = w; } } while (0)
#define G_COMPUTE(sb, ks) do { bf16x8 bf[4]; \
        _Pragma("unroll") for (int nf = 0; nf < 4; ++nf) { \
            const int nb = (nf >> 1) * 8 + wc * 2 + (nf & 1); const unsigned base = (ks) * 4 * 16 * 256 + nb * 256; \
            s16x4 t0 = __builtin_amdgcn_ds_read_tr16_b64_v4i16((LAS s16x4*)((sb) + brd[0] + base)); \
            s16x4 t1 = __builtin_amdgcn_ds_read_tr16_b64_v4i16((LAS s16x4*)((sb) + brd[1] + base)); \
            bf[nf] = (bf16x8){t0[0], t0[1], t0[2], t0[3], t1[0], t1[1], t1[2], t1[3]}; } \
        _Pragma("unroll") for (int mi = 0; mi < MI; ++mi) { \
            const bf16x8 af = *(const bf16x8*)((sb) + ard[ks] + mi * 16 * 128); \
            _Pragma("unroll") for (int nf = 0; nf < 4; ++nf) acc[mi][nf] = __builtin_amdgcn_mfma_f32_16x16x32_bf16(bf[nf], af, acc[mi][nf], 0, 0, 0); } } while (0)
    G_LOAD_A(0, 0); G_LOAD_B(0, 0); G_WRITE_B(0, 0); G_LOAD_B(0, 1); G_WRITE_B(0, 1);
    __syncthreads();
    for (int kt = 0; kt < nk; ++kt) {
        const bool more = kt + 1 < nk;
        const char* sb = smem + (kt & 1) * STG;
        if (more) { G_LOAD_A(kt + 1, (kt + 1) & 1); G_LOAD_B(kt + 1, 0); }
        G_COMPUTE(sb, 0);
        if (more) { G_WRITE_B((kt + 1) & 1, 0); G_LOAD_B(kt + 1, 1); }
        G_COMPUTE(sb, 1);
        if (more) { G_WRITE_B((kt + 1) & 1, 1); }
        __syncthreads();
    }
#undef G_LOAD_A
#undef G_LOAD_B
#undef G_WRITE_B
#undef G_COMPUTE
#pragma unroll
    for (int mi = 0; mi < MI; ++mi)
#pragma unroll
        for (int bj = 0; bj < 2; ++bj) epi(wr * (BM / 2) + mi * 16 + fr, bj * 128 + wc * 32 + 4 * fq, acc[mi][bj * 2], acc[mi][bj * 2 + 1]);
}


template <int BM, class AMap, class BMap, class Epi>
DEV void gemm_unit2(char* smem, const AMap& amap, const BMap& bmap, const Epi& epi, int K) {
    constexpr int NA = BM / 64, MI = BM / 32, ABYTES = BM * 128, STG = ABYTES + 32768;
    const int tid = opaque_tid(), lane = tid & 63, wid = tid >> 6, wr = wid >> 2, wc = wid & 3, fr = lane & 15, fq = lane >> 4;
    const char* abase = (const char*)amap.aorigin();
    unsigned aoffs[NA];
#pragma unroll
    for (int i = 0; i < NA; ++i) { const int c = tid + 512 * i, row = c >> 3, pch = c & 7; aoffs[i] = (unsigned)((const char*)(amap(row) + ((pch ^ (row & 7)) << 3)) - abase); }
    const int g = lane >> 4, j16 = lane & 15, krow = j16 >> 2, c4 = j16 & 3, vg = wid & 3, kh = wid >> 2;
    const int ldb = bmap.ld();
    const float* bptr = bmap.ptr(vg * 4 + g) + 4 * c4 + (size_t)(4 * kh + krow) * ldb;
    unsigned bwr[2];
#pragma unroll
    for (int o = 0; o < 2; ++o) bwr[o] = ABYTES + (vg * 4 + g) * 256 + (((4 * kh + krow) ^ (o << 2)) * 32) + c4 * 8;
    unsigned ard[2];
#pragma unroll
    for (int ks = 0; ks < 2; ++ks) { const int row = wr * (BM / 2) + fr; ard[ks] = row * 128 + (((ks * 4 + fq) ^ (row & 7)) << 4); }
    unsigned brd[2];
    { const int q = j16 >> 2, p = j16 & 3;
#pragma unroll
      for (int t = 0; t < 2; ++t) brd[t] = ABYTES + (fq * 16) * 256 + (((4 * t + q) ^ ((fq & 1) << 2)) * 32) + p * 8; }

    f32x4 acc[MI][4];
#pragma unroll
    for (int mi = 0; mi < MI; ++mi)
#pragma unroll
        for (int nf = 0; nf < 4; ++nf) acc[mi][nf] = (f32x4){0.f, 0.f, 0.f, 0.f};

    float4 breg[4];
    const int nk = K >> 6;
#define G_LOAD_A(kt, buf) do { _Pragma("unroll") for (int i = 0; i < NA; ++i) \
        __builtin_amdgcn_global_load_lds((const unsigned*)(abase + (size_t)(kt) * 128 + aoffs[i]), (LAS unsigned*)(smem + (buf) * STG + (tid + 512 * i) * 16), 16, 0, 0); } while (0)
#define G_LOAD_B(kt, h) do { _Pragma("unroll") for (int i = 0; i < 4; ++i) breg[i] = *(const float4*)(bptr + (size_t)((kt) * 64 + 8 * ((h) * 4 + i)) * ldb); } while (0)
#define G_WRITE_B(buf, h) do { char* sb_ = smem + (buf) * STG; \
        _Pragma("unroll") for (int i = 0; i < 4; ++i) { uint2 w; w.x = pack_bf16x2(breg[i].x, breg[i].y); w.y = pack_bf16x2(breg[i].z, breg[i].w); \
            *(uint2*)(sb_ + bwr[i & 1] + ((h) * 4 + i) * 16 * 256) = w; } } while (0)
#define G_AF(sb, ks, mi) (*(const bf16x8*)((sb) + ard[ks] + (mi) * 16 * 128))
#define G_MM(mi, afv) do { _Pragma("unroll") for (int nf = 0; nf < 4; ++nf) acc[mi][nf] = __builtin_amdgcn_mfma_f32_16x16x32_bf16(bf[nf], afv, acc[mi][nf], 0, 0, 0); } while (0)
#define G_COMPUTE(sb, ks) do { bf16x8 bf[4]; \
        _Pragma("unroll") for (int nf = 0; nf < 4; ++nf) { \
            const int nb = (nf >> 1) * 8 + wc * 2 + (nf & 1); const unsigned base = (ks) * 4 * 16 * 256 + nb * 256; \
            s16x4 t0 = __builtin_amdgcn_ds_read_tr16_b64_v4i16((LAS s16x4*)((sb) + brd[0] + base)); \
            s16x4 t1 = __builtin_amdgcn_ds_read_tr16_b64_v4i16((LAS s16x4*)((sb) + brd[1] + base)); \
            bf[nf] = (bf16x8){t0[0], t0[1], t0[2], t0[3], t1[0], t1[1], t1[2], t1[3]}; } \
        bf16x8 a0 = G_AF(sb, ks, 0), a1 = G_AF(sb, ks, 1), a2 = G_AF(sb, ks, 2), a3 = G_AF(sb, ks, 3); \
        G_MM(0, a0); a0 = G_AF(sb, ks, 4); G_MM(1, a1); a1 = G_AF(sb, ks, 5); G_MM(2, a2); a2 = G_AF(sb, ks, 6); G_MM(3, a3); a3 = G_AF(sb, ks, 7); \
        G_MM(4, a0); G_MM(5, a1); G_MM(6, a2); G_MM(7, a3); \
        if ((ks) == 0) { \
        __builtin_amdgcn_sched_group_barrier(0x100, 12, 0); \
        __builtin_amdgcn_sched_group_barrier(0x008, 4, 0); __builtin_amdgcn_sched_group_barrier(0x100, 1, 0); __builtin_amdgcn_sched_group_barrier(0x020, 2, 0); \
        __builtin_amdgcn_sched_group_barrier(0x008, 4, 0); __builtin_amdgcn_sched_group_barrier(0x100, 1, 0); __builtin_amdgcn_sched_group_barrier(0x020, 2, 0); \
        __builtin_amdgcn_sched_group_barrier(0x008, 4, 0); __builtin_amdgcn_sched_group_barrier(0x100, 1, 0); __builtin_amdgcn_sched_group_barrier(0x020, 2, 0); \
        __builtin_amdgcn_sched_group_barrier(0x008, 4, 0); __builtin_amdgcn_sched_group_barrier(0x100, 1, 0); __builtin_amdgcn_sched_group_barrier(0x020, 2, 0); \
        __builtin_amdgcn_sched_group_barrier(0x008, 4, 0); __builtin_amdgcn_sched_group_barrier(0x020, 1, 0); \
        __builtin_amdgcn_sched_group_barrier(0x008, 4, 0); __builtin_amdgcn_sched_group_barrier(0x020, 1, 0); \
        __builtin_amdgcn_sched_group_barrier(0x008, 4, 0); __builtin_amdgcn_sched_group_barrier(0x020, 1, 0); \
        __builtin_amdgcn_sched_group_barrier(0x008, 4, 0); __builtin_amdgcn_sched_group_barrier(0x020, 1, 0); \
        } else { \
        __builtin_amdgcn_sched_group_barrier(0x100, 12, 0); \
        __builtin_amdgcn_sched_group_barrier(0x008, 4, 0); __builtin_amdgcn_sched_group_barrier(0x100, 1, 0); \
        __builtin_amdgcn_sched_group_barrier(0x008, 4, 0); __builtin_amdgcn_sched_group_barrier(0x100, 1, 0); \
        __builtin_amdgcn_sched_group_barrier(0x008, 4, 0); __builtin_amdgcn_sched_group_barrier(0x100, 1, 0); \
        __builtin_amdgcn_sched_group_barrier(0x008, 4, 0); __builtin_amdgcn_sched_group_barrier(0x100, 1, 0); \
        __builtin_amdgcn_sched_group_barrier(0x008, 16, 0); } } while (0)
    float4 breg2[4];
#define G_LOAD_B2(kt) do { _Pragma("unroll") for (int i = 0; i < 4; ++i) breg2[i] = *(const float4*)(bptr + (size_t)((kt) * 64 + 8 * (4 + i)) * ldb); } while (0)
#define G_WRITE_B2(buf) do { char* sb_ = smem + (buf) * STG; \
        _Pragma("unroll") for (int i = 0; i < 4; ++i) { uint2 w; w.x = pack_bf16x2(breg2[i].x, breg2[i].y); w.y = pack_bf16x2(breg2[i].z, breg2[i].w); \
            *(uint2*)(sb_ + bwr[i & 1] + (4 + i) * 16 * 256) = w; } } while (0)
    G_LOAD_A(0, 0); G_LOAD_B(0, 0); G_LOAD_B2(0); G_WRITE_B(0, 0); G_WRITE_B2(0);
    __syncthreads();
    for (int kt = 0; kt < nk; ++kt) {
        const bool more = kt + 1 < nk;
        const char* sb = smem + (kt & 1) * STG;
        { const int kn = more ? kt + 1 : kt; G_LOAD_A(kn, (kt + 1) & 1); G_LOAD_B(kn, 0); G_LOAD_B2(kn); }
        G_COMPUTE(sb, 0);
        __builtin_amdgcn_sched_barrier(0);
        G_COMPUTE(sb, 1);
        if (more) { G_WRITE_B((kt + 1) & 1, 0); G_WRITE_B2((kt + 1) & 1); }
        __syncthreads();
    }
#undef G_LOAD_B2
#undef G_WRITE_B2
#undef G_LOAD_A
#undef G_LOAD_B
#undef G_WRITE_B
#undef G_COMPUTE
#undef G_AF
#undef G_MM
#pragma unroll
    for (int mi = 0; mi < MI; ++mi)
#pragma unroll
        for (int bj = 0; bj < 2; ++bj) epi(wr * (BM / 2) + mi * 16 + fr, bj * 128 + wc * 32 + 4 * fq, acc[mi][bj * 2], acc[mi][bj * 2 + 1]);
}


template <class AMap, class BMap, class Epi>
DEV void gemm_unit_bd(char* smem, const AMap& amap, const BMap& bmap, const Epi& epi, int K) {
    const int tid = opaque_tid(), lane = tid & 63, wid = tid >> 6, fr = lane & 15, fq = lane >> 4;
    const bf16_t* aptr[4];
#pragma unroll
    for (int i = 0; i < 4; ++i) { const int c = tid + 512 * i, row = c >> 3, pch = c & 7; aptr[i] = amap(row) + ((pch ^ (row & 7)) << 3); }
    const int ldb = bmap.ld();
    const float* bp0 = bmap.ptr(2 * wid) + fr + (size_t)(8 * fq) * ldb;
    const float* bp1 = bmap.ptr(2 * wid + 1) + fr + (size_t)(8 * fq) * ldb;
    unsigned ard[2];
#pragma unroll
    for (int ks = 0; ks < 2; ++ks) ard[ks] = fr * 128 + (((ks * 4 + fq) ^ (fr & 7)) << 4);
    f32x4 acc[16][2];
#pragma unroll
    for (int mi = 0; mi < 16; ++mi) { acc[mi][0] = (f32x4){0.f, 0.f, 0.f, 0.f}; acc[mi][1] = (f32x4){0.f, 0.f, 0.f, 0.f}; }
    float bq[2][2][8];
    const int nk = K >> 6;
#define BD_LOAD_A(kt) do { _Pragma("unroll") for (int i = 0; i < 4; ++i) \
        __builtin_amdgcn_global_load_lds((const unsigned*)(aptr[i] + (kt) * 64), (LAS unsigned*)(smem + ((kt) & 3) * 32768 + (tid + 512 * i) * 16), 16, 0, 0); } while (0)
#define BD_LOAD_B(kt) do { _Pragma("unroll") for (int ks = 0; ks < 2; ++ks) _Pragma("unroll") for (int j = 0; j < 8; ++j) { \
        const size_t ro = (size_t)((kt) * 64 + ks * 32 + j) * ldb; bq[0][ks][j] = bp0[ro]; bq[1][ks][j] = bp1[ro]; } } while (0)
    BD_LOAD_A(0); if (nk > 1) BD_LOAD_A(1); if (nk > 2) BD_LOAD_A(2);
    BD_LOAD_B(0);
    for (int kt = 0; kt < nk; ++kt) {
        bf16x8 bfr[2][2];
#pragma unroll
        for (int nf = 0; nf < 2; ++nf)
#pragma unroll
            for (int ks = 0; ks < 2; ++ks) {
                const unsigned p0 = pack_bf16x2(bq[nf][ks][0], bq[nf][ks][1]), p1 = pack_bf16x2(bq[nf][ks][2], bq[nf][ks][3]), p2 = pack_bf16x2(bq[nf][ks][4], bq[nf][ks][5]), p3 = pack_bf16x2(bq[nf][ks][6], bq[nf][ks][7]);
                const uint4 u = make_uint4(p0, p1, p2, p3);
                bfr[nf][ks] = __builtin_bit_cast(bf16x8, u);
            }
        asm volatile("s_waitcnt vmcnt(0)" ::: "memory");
        __builtin_amdgcn_s_barrier();
        if (kt + 3 < nk) BD_LOAD_A(kt + 3);
        if (kt + 1 < nk) BD_LOAD_B(kt + 1);
        asm volatile("" ::: "memory");
        const char* sb = smem + (kt & 3) * 32768;
#pragma unroll
        for (int ks = 0; ks < 2; ++ks)
#pragma unroll
            for (int mi = 0; mi < 16; ++mi) {
                const bf16x8 af = *(const bf16x8*)(sb + ard[ks] + mi * 2048);
                acc[mi][0] = __builtin_amdgcn_mfma_f32_16x16x32_bf16(bfr[0][ks], af, acc[mi][0], 0, 0, 0);
                acc[mi][1] = __builtin_amdgcn_mfma_f32_16x16x32_bf16(bfr[1][ks], af, acc[mi][1], 0, 0, 0);
            }
    }
#undef BD_LOAD_A
#undef BD_LOAD_B
#pragma unroll
    for (int mi = 0; mi < 16; ++mi) epi(mi * 16 + fr, 32 * wid + 4 * fq, acc[mi][0], acc[mi][1]);
}

struct FEpiStoreBf16 { bf16_t* C; int ldc; int row0; int col0;
    DEV void operator()(int r, int c, f32x4 v0, f32x4 v1) const { bf16_t* p = C + (size_t)(row0 + r) * ldc + col0 + c;
        uint2 a, b; a.x = pack_bf16x2(v0[0], v0[1]); a.y = pack_bf16x2(v0[2], v0[3]); b.x = pack_bf16x2(v1[0], v1[1]); b.y = pack_bf16x2(v1[2], v1[3]);
        *(uint2*)p = a; *(uint2*)(p + 16) = b; } };
struct FEpiStoreF32 { float* C; int ldc; int row0; int col0;
    DEV void operator()(int r, int c, f32x4 v0, f32x4 v1) const { float* p = C + (size_t)(row0 + r) * ldc + col0 + c; *(f32x4*)p = v0; *(f32x4*)(p + 16) = v1; } };
struct FEpiGateA { bf16_t* M; const bf16_t* proj; int row0; int col0;
    DEV void one(int r, int c, f32x4 v) const { const size_t row = row0 + r; const uint2 gr = *(const uint2*)(proj + row * NIN + OFF_GA + col0 + c);
        float g0 = sigmoidf_(__uint_as_float(gr.x << 16)), g1 = sigmoidf_(__uint_as_float(gr.x & 0xffff0000u)), g2 = sigmoidf_(__uint_as_float(gr.y << 16)), g3 = sigmoidf_(__uint_as_float(gr.y & 0xffff0000u));
        uint2 o; o.x = pack_bf16x2(g0 * v[0], g1 * v[1]); o.y = pack_bf16x2(g2 * v[2], g3 * v[3]); *(uint2*)(M + row * D + col0 + c) = o; }
    DEV void operator()(int r, int c, f32x4 v0, f32x4 v1) const { one(r, c, v0); one(r, c + 16, v1); } };
struct FEpiGateB { bf16_t* M; const bf16_t* proj; int row0; int col0;
    DEV void one(int r, int c, f32x4 v) const { const size_t row = row0 + r; const uint2 gr = *(const uint2*)(proj + row * NIN + OFF_GB + col0 + c);
        const uint2 mo = *(const uint2*)(M + row * D + col0 + c);
        float g0 = sigmoidf_(__uint_as_float(gr.x << 16)), g1 = sigmoidf_(__uint_as_float(gr.x & 0xffff0000u)), g2 = sigmoidf_(__uint_as_float(gr.y << 16)), g3 = sigmoidf_(__uint_as_float(gr.y & 0xffff0000u));
        float m0 = __uint_as_float(mo.x << 16), m1 = __uint_as_float(mo.x & 0xffff0000u), m2 = __uint_as_float(mo.y << 16), m3 = __uint_as_float(mo.y & 0xffff0000u);
        uint2 o; o.x = pack_bf16x2(m0 + g0 * v[0], m1 + g1 * v[1]); o.y = pack_bf16x2(m2 + g2 * v[2], m3 + g3 * v[3]); *(uint2*)(M + row * D + col0 + c) = o; }
    DEV void operator()(int r, int c, f32x4 v0, f32x4 v1) const { one(r, c, v0); one(r, c + 16, v1); } };
struct FEpiSwiGLU { bf16_t* act; int row0; int col0;
    DEV void operator()(int r, int c, f32x4 g, f32x4 u) const {
        uint2 o; o.x = pack_bf16x2(siluf_(g[0]) * u[0], siluf_(g[1]) * u[1]); o.y = pack_bf16x2(siluf_(g[2]) * u[2], siluf_(g[3]) * u[3]);
        *(uint2*)(act + (size_t)(row0 + r) * FF + col0 + (c >> 5) * 16 + (c & 15)) = o; } };
struct FEpiSwiGLUSlot { bf16_t* act; const int* lslot; int base; int cnt; int r0; int col0;
    DEV void operator()(int r, int c, f32x4 g, f32x4 u) const { const int rr = r0 + r; if (rr < cnt) {
        uint2 o; o.x = pack_bf16x2(siluf_(g[0]) * u[0], siluf_(g[1]) * u[1]); o.y = pack_bf16x2(siluf_(g[2]) * u[2], siluf_(g[3]) * u[3]);
        *(uint2*)(act + (size_t)lslot[base + rr] * FF + col0 + (c >> 5) * 16 + (c & 15)) = o; } } };
struct FEpiSlot { bf16_t* yslot; const int* lslot; const float* lw; int base; int cnt; int r0; int col0;
    DEV void operator()(int r, int c, f32x4 v0, f32x4 v1) const { const int rr = r0 + r; if (rr < cnt) { const int s = lslot[base + rr]; const float w = lw[base + rr];
        bf16_t* p = yslot + (size_t)s * D + col0 + c; uint2 a, b; a.x = pack_bf16x2(w * v0[0], w * v0[1]); a.y = pack_bf16x2(w * v0[2], w * v0[3]); b.x = pack_bf16x2(w * v1[0], w * v1[1]); b.y = pack_bf16x2(w * v1[2], w * v1[3]);
        *(uint2*)p = a; *(uint2*)(p + 16) = b; } } };

DEV unsigned sw128(int row, int chunk) { return (unsigned)(row * 128 + ((chunk ^ (row & 7)) << 4)); }
DEV unsigned sw256(int row, int chunk) { return (unsigned)(row * 256 + ((chunk ^ (row & 15)) << 4)); }
constexpr int HG_LDS_BYTES = 96 * 1024;

DEV void hgrn_gates(const bf16_t* proj, const float* lbt, int t0, int h, int d, int seg, float* red, float (&fgv)[16], float (&b)[16], float& blast) {
    const float a0 = lbt[h * 128 + d], a1 = lbt[512 + h * 128 + d];
    const float lb = 1.f / (1.f + __expf(a1 - a0));
    float run = 0.f;
#pragma unroll
    for (int i = 0; i < 16; ++i) {
        const float f = bf2f(proj[(size_t)(t0 + 16 * seg + i) * NIN + OFF_F + h * 128 + d]);
        const float fg = lb + (1.f - lb) * sigmoidf_(f);
        fgv[i] = fg; run += __logf(fg); b[i] = run;
    }
    red[seg * 128 + d] = run;
    __syncthreads();
    const float r0 = red[d], r1 = red[128 + d], r2 = red[256 + d], r3 = red[384 + d];
    const float pre = (seg > 0 ? r0 : 0.f) + (seg > 1 ? r1 : 0.f) + (seg > 2 ? r2 : 0.f);
    blast = r0 + r1 + r2 + r3;
#pragma unroll
    for (int i = 0; i < 16; ++i) b[i] += pre;
}
DEV void pack16_store(char* smem, unsigned a0, unsigned a1, const float (&v)[16]) {
    uint4 lo, hi;
    lo.x = pack_bf16x2(v[0], v[1]); lo.y = pack_bf16x2(v[2], v[3]); lo.z = pack_bf16x2(v[4], v[5]); lo.w = pack_bf16x2(v[6], v[7]);
    hi.x = pack_bf16x2(v[8], v[9]); hi.y = pack_bf16x2(v[10], v[11]); hi.z = pack_bf16x2(v[12], v[13]); hi.w = pack_bf16x2(v[14], v[15]);
    *(uint4*)(smem + a0) = lo; *(uint4*)(smem + a1) = hi;
}

DEV void hgrn_phase1(char* smem, const bf16_t* proj, const float* lbt, float* kcT, float* dec, int c, int h) {
    const int tid = opaque_tid(), d = tid & 127, seg = tid >> 7, t0 = c * 64;
    const int lane = tid & 63, w = tid >> 6, fr = lane & 15, fq = lane >> 4;
    float* red = (float*)(smem + 32768);
    float fgv[16], b[16], blast;
    hgrn_gates(proj, lbt, t0, h, d, seg, red, fgv, b, blast);
    float kd[16], vv[16];
#pragma unroll
    for (int i = 0; i < 16; ++i) {
        kd[i] = (1.f - fgv[i]) * __expf(blast - b[i]);
        vv[i] = bf2f(proj[(size_t)(t0 + 16 * seg + i) * NIN + OFF_I + h * 128 + d]);
    }
    pack16_store(smem, sw128(d, 2 * seg), sw128(d, 2 * seg + 1), kd);
    pack16_store(smem + 16384, sw128(d, 2 * seg), sw128(d, 2 * seg + 1), vv);
    if (seg == 3) dec[(size_t)(c * 4 + h) * 128 + d] = __expf(blast);
    __syncthreads();
    f32x4 acc[8];
#pragma unroll
    for (int nv = 0; nv < 8; ++nv) acc[nv] = (f32x4){0.f, 0.f, 0.f, 0.f};
#pragma unroll
    for (int ks = 0; ks < 2; ++ks) {
        const bf16x8 xf = *(const bf16x8*)(smem + sw128(16 * w + fr, ks * 4 + fq));
#pragma unroll
        for (int nv = 0; nv < 8; ++nv) {
            const bf16x8 yf = *(const bf16x8*)(smem + 16384 + sw128(16 * nv + fr, ks * 4 + fq));
            acc[nv] = __builtin_amdgcn_mfma_f32_16x16x32_bf16(xf, yf, acc[nv], 0, 0, 0);
        }
    }
    float* out = kcT + (size_t)(c * 4 + h) * 16384;
#pragma unroll
    for (int nv = 0; nv < 8; ++nv) *(f32x4*)(out + (16 * nv + fr) * 128 + 16 * w + 4 * fq) = acc[nv];
    __syncthreads();
}

DEV void hgrn_phase2(const float* kcT, const float* dec, bf16_t* ST, int e) {
    const int h = e >> 14, d = e & 127;
    float S = 0.f;
    for (int c0 = 0; c0 < 256; c0 += 16) {
        float kc[16], dc[16];
#pragma unroll
        for (int i = 0; i < 16; ++i) { kc[i] = kcT[(size_t)(c0 + i) * 65536 + e]; dc[i] = dec[(size_t)((c0 + i) * 4 + h) * 128 + d]; }
#pragma unroll
        for (int i = 0; i < 16; ++i) { ST[(size_t)(c0 + i) * 65536 + e] = f2bf(S); S = dc[i] * S + kc[i]; }
    }
}

DEV void hgrn_phase3(char* smem, const bf16_t* proj, const float* lbt, const bf16_t* ST, const float* hw, bf16_t* ob, int c, int h) {
    constexpr int O_QT = 0, O_KT = 16384, O_VT = 32768, O_ST = 49152, O_AT = 81920, O_RED = 90112, O_SSQ = 92160;
    const int tid = opaque_tid(), d = tid & 127, seg = tid >> 7, t0 = c * 64;
    const int lane = tid & 63, w = tid >> 6, fr = lane & 15, fq = lane >> 4;
    {
        float fgv[16], b[16], blast;
        hgrn_gates(proj, lbt, t0, h, d, seg, (float*)(smem + O_RED), fgv, b, blast);
        float vv[16];
#pragma unroll
        for (int i = 0; i < 16; ++i) {
            const int t = 16 * seg + i;
            const float qv = bf2f(proj[(size_t)(t0 + t) * NIN + OFF_Q + h * 128 + d]);
            const float eb = __expf(b[i]);
            const float qt = siluf_(qv) * eb, kt = (1.f - fgv[i]) / eb;
            const unsigned off = sw256(t, d >> 3) + (d & 7) * 2;
            *(bf16_t*)(smem + O_QT + off) = f2bf(qt);
            *(bf16_t*)(smem + O_KT + off) = f2bf(kt);
            vv[i] = bf2f(proj[(size_t)(t0 + t) * NIN + OFF_I + h * 128 + d]);
        }
        pack16_store(smem + O_VT, sw128(d, 2 * seg), sw128(d, 2 * seg + 1), vv);
        const bf16_t* sp = ST + (size_t)(c * 4 + h) * 16384;
#pragma unroll
        for (int i = 0; i < 4; ++i) { const int idx = tid + 512 * i, row = idx >> 4, ch = idx & 15; *(uint4*)(smem + O_ST + sw256(row, ch)) = *(const uint4*)(sp + row * 128 + ch * 8); }
    }
    __syncthreads();
    {
        const int tb = w & 3;
#pragma unroll
        for (int u = 0; u < 2; ++u) {
            const int sb = (w >> 2) * 2 + u;
            f32x4 acc = (f32x4){0.f, 0.f, 0.f, 0.f};
            if (sb <= tb) {
#pragma unroll
                for (int ks = 0; ks < 4; ++ks) {
                    const bf16x8 xf = *(const bf16x8*)(smem + O_KT + sw256(16 * sb + fr, ks * 4 + fq));
                    const bf16x8 yf = *(const bf16x8*)(smem + O_QT + sw256(16 * tb + fr, ks * 4 + fq));
                    acc = __builtin_amdgcn_mfma_f32_16x16x32_bf16(xf, yf, acc, 0, 0, 0);
                }
                const int t = 16 * tb + fr, s0 = 16 * sb + 4 * fq;
#pragma unroll
                for (int jj = 0; jj < 4; ++jj) if (s0 + jj > t) acc[jj] = 0.f;
            }
            uint2 o; o.x = pack_bf16x2(acc[0], acc[1]); o.y = pack_bf16x2(acc[2], acc[3]);
            *(uint2*)(smem + O_AT + sw128(16 * tb + fr, 2 * sb + (fq >> 1)) + 8 * (fq & 1)) = o;
        }
    }
    __syncthreads();
    const int tb = w & 3, vh = w >> 2;
    f32x4 acc[4];
#pragma unroll
    for (int n = 0; n < 4; ++n) acc[n] = (f32x4){0.f, 0.f, 0.f, 0.f};
#pragma unroll
    for (int ks = 0; ks < 2; ++ks) {
        const bf16x8 yf = *(const bf16x8*)(smem + O_AT + sw128(16 * tb + fr, ks * 4 + fq));
#pragma unroll
        for (int n = 0; n < 4; ++n) {
            const bf16x8 xf = *(const bf16x8*)(smem + O_VT + sw128(16 * (4 * vh + n) + fr, ks * 4 + fq));
            acc[n] = __builtin_amdgcn_mfma_f32_16x16x32_bf16(xf, yf, acc[n], 0, 0, 0);
        }
    }
#pragma unroll
    for (int ks = 0; ks < 4; ++ks) {
        const bf16x8 yf = *(const bf16x8*)(smem + O_QT + sw256(16 * tb + fr, ks * 4 + fq));
#pragma unroll
        for (int n = 0; n < 4; ++n) {
            const bf16x8 xf = *(const bf16x8*)(smem + O_ST + sw256(16 * (4 * vh + n) + fr, ks * 4 + fq));
            acc[n] = __builtin_amdgcn_mfma_f32_16x16x32_bf16(xf, yf, acc[n], 0, 0, 0);
        }
    }
    float ss = 0.f;
#pragma unroll
    for (int n = 0; n < 4; ++n)
#pragma unroll
        for (int jj = 0; jj < 4; ++jj) ss += acc[n][jj] * acc[n][jj];
    ss += __shfl_xor(ss, 16); ss += __shfl_xor(ss, 32);
    float* ssq = (float*)(smem + O_SSQ);
    if (fq == 0) ssq[vh * 64 + 16 * tb + fr] = ss;
    __syncthreads();
    const float tot = ssq[16 * tb + fr] + ssq[64 + 16 * tb + fr];
    const float rs = rsqrtf(tot * (1.f / 128.f) + EPS);
    const size_t trow = (size_t)(t0 + 16 * tb + fr);
#pragma unroll
    for (int n = 0; n < 4; ++n) {
        const int v0 = 16 * (4 * vh + n) + 4 * fq;
        const uint2 gr = *(const uint2*)(proj + trow * NIN + OFF_G + h * 128 + v0);
        const f32x4 wv = *(const f32x4*)(hw + v0);
        const float g0 = siluf_(__uint_as_float(gr.x << 16)), g1 = siluf_(__uint_as_float(gr.x & 0xffff0000u)), g2 = siluf_(__uint_as_float(gr.y << 16)), g3 = siluf_(__uint_as_float(gr.y & 0xffff0000u));
        uint2 o; o.x = pack_bf16x2(acc[n][0] * rs * wv[0] * g0, acc[n][1] * rs * wv[1] * g1); o.y = pack_bf16x2(acc[n][2] * rs * wv[2] * g2, acc[n][3] * rs * wv[3] * g3);
        *(uint2*)(ob + trow * 512 + h * 128 + v0) = o;
    }
    __syncthreads();
}


constexpr int LDS_BAR_OFF = GEMM_LDS_BYTES;
constexpr int LDS_PREF_OFF = GEMM_LDS_BYTES + 256;
constexpr int LDS_TOTAL = GEMM_LDS_BYTES + 256 + 2048;

DEV void phase_mod(const Params& p, char* smem) {
    const int tid = opaque_tid(), ks = tid >> 3, sub = tid & 7;
    float* red = (float*)smem;
    for (int cb = blockIdx.x; cb < 256; cb += gridDim.x) {
        const int j0 = cb * 24;
        float a0 = 0.f, a1 = 0.f, a2 = 0.f;
#pragma unroll 4
        for (int i = 0; i < 16; ++i) {
            const int k = ks + 64 * i;
            const float sc = siluf_(p.c[k]);
            const float* w = p.w_ada + (size_t)k * (6 * D) + j0 + 3 * sub;
            a0 += sc * w[0]; a1 += sc * w[1]; a2 += sc * w[2];
        }
        red[ks * 24 + 3 * sub] = a0; red[ks * 24 + 3 * sub + 1] = a1; red[ks * 24 + 3 * sub + 2] = a2;
        __syncthreads();
        if (tid < 24) { float sacc = p.b_ada[j0 + tid]; for (int q = 0; q < 64; ++q) sacc += red[q * 24 + tid]; p.mod[j0 + tid] = sacc; }
        __syncthreads();
    }
}

DEV void phase_norm1(const Params& p) {
    const int tid_ = opaque_tid(), lane = tid_ & 63, gw = blockIdx.x * 8 + (tid_ >> 6), nw = gridDim.x * 8;
    for (int row = gw; row < T; row += nw) {
        const float* xr = p.x + (size_t)row * D;
        float4 v[4]; float ss = 0.f;
#pragma unroll
        for (int i = 0; i < 4; ++i) { v[i] = *(const float4*)(xr + i * 256 + lane * 4); ss += v[i].x * v[i].x + v[i].y * v[i].y + v[i].z * v[i].z + v[i].w * v[i].w; }
        ss = wave_sum(ss);
        const float rs = rsqrtf(ss * (1.f / D) + EPS);
#pragma unroll
        for (int i = 0; i < 4; ++i) {
            const int c = i * 256 + lane * 4;
            const float4 w = *(const float4*)(p.npm + c), sc = *(const float4*)(p.mod + D + c), sh = *(const float4*)(p.mod + c);
            uint2 o; o.x = pack_bf16x2(v[i].x * rs * w.x * (1.f + sc.x) + sh.x, v[i].y * rs * w.y * (1.f + sc.y) + sh.y);
            o.y = pack_bf16x2(v[i].z * rs * w.z * (1.f + sc.z) + sh.z, v[i].w * rs * w.w * (1.f + sc.w) + sh.w);
            *(uint2*)(p.h1 + (size_t)row * D + c) = o;
        }
    }
}

DEV void phase_conv(const Params& p) {
    const int gt = blockIdx.x * 512 + opaque_tid(), nt = gridDim.x * 512;
    for (int idx = gt; idx < T * 64; idx += nt) {
        const int t = idx >> 6, c8 = (idx & 63) * 8;
        float acc[8];
#pragma unroll
        for (int q = 0; q < 8; ++q) acc[q] = 0.f;
#pragma unroll
        for (int j = 0; j < 3; ++j) {
            const int tt = t - 2 + j;
            if (tt >= 0) {
                const uint4 cc = *(const uint4*)(p.proj + (size_t)tt * NIN + OFF_CC + c8), cx = *(const uint4*)(p.proj + (size_t)tt * NIN + OFF_CX + c8);
                const float4 w0 = *(const float4*)(p.conv_w + j * 512 + c8), w1 = *(const float4*)(p.conv_w + j * 512 + c8 + 4);
                acc[0] += w0.x * lo_bf(cc.x) * lo_bf(cx.x); acc[1] += w0.y * hi_bf(cc.x) * hi_bf(cx.x);
                acc[2] += w0.z * lo_bf(cc.y) * lo_bf(cx.y); acc[3] += w0.w * hi_bf(cc.y) * hi_bf(cx.y);
                acc[4] += w1.x * lo_bf(cc.z) * lo_bf(cx.z); acc[5] += w1.y * hi_bf(cc.z) * hi_bf(cx.z);
                acc[6] += w1.z * lo_bf(cc.w) * lo_bf(cx.w); acc[7] += w1.w * hi_bf(cc.w) * hi_bf(cx.w);
            }
        }
        const uint4 cb = *(const uint4*)(p.proj + (size_t)t * NIN + OFF_CB + c8);
        uint4 o;
        o.x = pack_bf16x2(lo_bf(cb.x) * acc[0], hi_bf(cb.x) * acc[1]); o.y = pack_bf16x2(lo_bf(cb.y) * acc[2], hi_bf(cb.y) * acc[3]);
        o.z = pack_bf16x2(lo_bf(cb.z) * acc[4], hi_bf(cb.z) * acc[5]); o.w = pack_bf16x2(lo_bf(cb.w) * acc[6], hi_bf(cb.w) * acc[7]);
        *(uint4*)(p.a1 + (size_t)t * 512 + c8) = o;
    }
}

DEV void phase_mid(const Params& p) {
    const int tid_ = opaque_tid(), lane = tid_ & 63, gw = blockIdx.x * 8 + (tid_ >> 6), nw = gridDim.x * 8;
    for (int row = gw; row < T; row += nw) {
        float yv[16], xv[16]; float ss = 0.f;
#pragma unroll
        for (int i = 0; i < 4; ++i) {
            const uint2 r = *(const uint2*)(p.y + (size_t)row * D + i * 256 + lane * 4);
            yv[4 * i] = lo_bf(r.x); yv[4 * i + 1] = hi_bf(r.x); yv[4 * i + 2] = lo_bf(r.y); yv[4 * i + 3] = hi_bf(r.y);
#pragma unroll
            for (int j = 0; j < 4; ++j) ss += yv[4 * i + j] * yv[4 * i + j];
        }
        ss = wave_sum(ss);
        const float rs = rsqrtf(ss * (1.f / D) + EPS);
        float ss2 = 0.f;
#pragma unroll
        for (int i = 0; i < 4; ++i) {
            const int c = i * 256 + lane * 4;
            const float4 xx = *(const float4*)(p.x + (size_t)row * D + c), g1 = *(const float4*)(p.mod + 2 * D + c), w = *(const float4*)(p.npostm + c);
            float4 o;
            o.x = xx.x + g1.x * (yv[4 * i] * rs * w.x); o.y = xx.y + g1.y * (yv[4 * i + 1] * rs * w.y); o.z = xx.z + g1.z * (yv[4 * i + 2] * rs * w.z); o.w = xx.w + g1.w * (yv[4 * i + 3] * rs * w.w);
            xv[4 * i] = o.x; xv[4 * i + 1] = o.y; xv[4 * i + 2] = o.z; xv[4 * i + 3] = o.w;
            ss2 += o.x * o.x + o.y * o.y + o.z * o.z + o.w * o.w;
            *(float4*)(p.out + (size_t)row * D + c) = o;
        }
        ss2 = wave_sum(ss2);
        const float rs2 = rsqrtf(ss2 * (1.f / D) + EPS);
#pragma unroll
        for (int i = 0; i < 4; ++i) {
            const int c = i * 256 + lane * 4;
            const float4 w = *(const float4*)(p.npf + c), sc = *(const float4*)(p.mod + 4 * D + c), sh = *(const float4*)(p.mod + 3 * D + c);
            uint2 o; o.x = pack_bf16x2(xv[4 * i] * rs2 * w.x * (1.f + sc.x) + sh.x, xv[4 * i + 1] * rs2 * w.y * (1.f + sc.y) + sh.y);
            o.y = pack_bf16x2(xv[4 * i + 2] * rs2 * w.z * (1.f + sc.z) + sh.z, xv[4 * i + 3] * rs2 * w.w * (1.f + sc.w) + sh.w);
            *(uint2*)(p.h2 + (size_t)row * D + c) = o;
        }
    }
}

template <int CTRL> DEV float dpp_f(float v) { return __builtin_bit_cast(float, __builtin_amdgcn_update_dpp(0, __builtin_bit_cast(int, v), CTRL, 0xf, 0xf, true)); }
DEV float row16_max(float v) {
    v = fmaxf(v, dpp_f<0xB1>(v)); v = fmaxf(v, dpp_f<0x4E>(v)); v = fmaxf(v, dpp_f<0x141>(v)); v = fmaxf(v, dpp_f<0x140>(v)); return v;
}
DEV float wave_max_uniform(float v) {
    v = row16_max(v);
    const float r0 = __builtin_bit_cast(float, __builtin_amdgcn_readlane(__builtin_bit_cast(int, v), 0)), r1 = __builtin_bit_cast(float, __builtin_amdgcn_readlane(__builtin_bit_cast(int, v), 16));
    const float r2 = __builtin_bit_cast(float, __builtin_amdgcn_readlane(__builtin_bit_cast(int, v), 32)), r3 = __builtin_bit_cast(float, __builtin_amdgcn_readlane(__builtin_bit_cast(int, v), 48));
    return fmaxf(fmaxf(r0, r1), fmaxf(r2, r3));
}
DEV void phase_route(const Params& p) {
    const int tid_ = opaque_tid(), lane = tid_ & 63, gw = blockIdx.x * 8 + (tid_ >> 6), nw = gridDim.x * 8;
    const float4 rb = *(const float4*)(p.rbias + lane * 4);
    float4 lgn = gw < T ? *(const float4*)(p.logits + (size_t)gw * E + lane * 4) : make_float4(0.f, 0.f, 0.f, 0.f);
    int ppos = 0, pek = 0, pslot = -1; float pw = 0.f;
    for (int t = gw; t < T; t += nw) {
        const float4 lg = lgn;
        if (t + nw < T) lgn = *(const float4*)(p.logits + (size_t)(t + nw) * E + lane * 4);
        const float s0 = sigmoidf_(lg.x), s1 = sigmoidf_(lg.y), s2 = sigmoidf_(lg.z), s3 = sigmoidf_(lg.w);
        const float e0 = s0 + rb.x, e1 = s1 + rb.y, e2 = s2 + rb.z, e3 = s3 + rb.w;
        float m1 = fmaxf(fmaxf(e0, e1), fmaxf(e2, e3));
        float m2;
        { const float a = fmaxf(e0, e1), b = fminf(e0, e1), c = fmaxf(e2, e3), d = fminf(e2, e3); m2 = fmaxf(fminf(a, c), fmaxf(b, d)); }
#define RT_MERGE(CTRL) do { const float o1 = dpp_f<CTRL>(m1), o2 = dpp_f<CTRL>(m2); const float n1 = fmaxf(m1, o1), n2 = fmaxf(fminf(m1, o1), fmaxf(m2, o2)); m1 = n1; m2 = n2; } while (0)
        RT_MERGE(0xB1); RT_MERGE(0x4E); RT_MERGE(0x141);
#undef RT_MERGE
        const float gs = m1 + m2; const int g = lane >> 3;
        int rank = 0;
#pragma unroll
        for (int j = 0; j < 8; ++j) { const float gj = __builtin_bit_cast(float, __builtin_amdgcn_readlane(__builtin_bit_cast(int, gs), j * 8)); rank += (gj > gs || (gj == gs && j < g)) ? 1 : 0; }
        const bool gsel = rank < 4;
        float v0 = gsel ? e0 : -INFINITY, v1 = gsel ? e1 : -INFINITY, v2 = gsel ? e2 : -INFINITY, v3 = gsel ? e3 : -INFINITY;
        float wk = 0.f; int ek = 0; float wsum = 0.f;
#pragma unroll 1
        for (int r = 0; r < TOPK; ++r) {
            const float lm = fmaxf(fmaxf(v0, v1), fmaxf(v2, v3));
            const float mx = wave_max_uniform(lm);
            const unsigned long long bal = __ballot(lm == mx);
            const int owner = __builtin_ctzll(bal);
            const int sub = (v0 == mx) ? 0 : (v1 == mx) ? 1 : (v2 == mx) ? 2 : 3;
            const float sv_l = sub == 0 ? s0 : sub == 1 ? s1 : sub == 2 ? s2 : s3;
            const int osub = __builtin_amdgcn_readlane(sub, owner);
            const float sv = __builtin_bit_cast(float, __builtin_amdgcn_readlane(__builtin_bit_cast(int, sv_l), owner));
            if (lane == owner) { if (osub == 0) v0 = -INFINITY; else if (osub == 1) v1 = -INFINITY; else if (osub == 2) v2 = -INFINITY; else v3 = -INFINITY; }
            wsum += sv;
            if (lane == r) { wk = sv; ek = owner * 4 + osub; }
        }
        int pos = 0;
        if (lane < TOPK) pos = (int)atomicAdd(&p.counts[ek << 5], 1u);
        if (lane < TOPK && pslot >= 0) { p.lslot[(size_t)pek * T + ppos] = pslot; p.lw[(size_t)pek * T + ppos] = pw; }
        ppos = pos; pek = ek; pslot = t * TOPK + lane; pw = wk / (wsum + 1e-20f) * 2.5f;
    }
    if (lane < TOPK && pslot >= 0) { p.lslot[(size_t)pek * T + ppos] = pslot; p.lw[(size_t)pek * T + ppos] = pw; }
}

DEV void phase_final(const Params& p) {
    const int tid_ = opaque_tid(), lane = tid_ & 63, gw = blockIdx.x * 8 + (tid_ >> 6), nw = gridDim.x * 8;
    for (int row = gw; row < T; row += nw) {
        float mv[16]; float ss = 0.f;
#pragma unroll
        for (int i = 0; i < 4; ++i) {
            const int c = i * 256 + lane * 4;
            const uint2 r = *(const uint2*)(p.shout + (size_t)row * D + c);
            float a0 = lo_bf(r.x), a1 = hi_bf(r.x), a2 = lo_bf(r.y), a3 = hi_bf(r.y);
#pragma unroll
            for (int k = 0; k < TOPK; ++k) { const uint2 q = *(const uint2*)(p.yslot + ((size_t)row * TOPK + k) * D + c); a0 += lo_bf(q.x); a1 += hi_bf(q.x); a2 += lo_bf(q.y); a3 += hi_bf(q.y); }
            mv[4 * i] = a0; mv[4 * i + 1] = a1; mv[4 * i + 2] = a2; mv[4 * i + 3] = a3;
            ss += a0 * a0 + a1 * a1 + a2 * a2 + a3 * a3;
        }
        ss = wave_sum(ss);
        const float rs = rsqrtf(ss * (1.f / D) + EPS);
#pragma unroll
        for (int i = 0; i < 4; ++i) {
            const int c = i * 256 + lane * 4;
            float4 o = *(const float4*)(p.out + (size_t)row * D + c);
            const float4 g2 = *(const float4*)(p.mod + 5 * D + c), w = *(const float4*)(p.npostf + c);
            o.x += g2.x * (mv[4 * i] * rs * w.x); o.y += g2.y * (mv[4 * i + 1] * rs * w.y); o.z += g2.z * (mv[4 * i + 2] * rs * w.z); o.w += g2.w * (mv[4 * i + 3] * rs * w.w);
            *(float4*)(p.out + (size_t)row * D + c) = o;
        }
    }
}

DEV bool dense_unit(int r, int nM, int nN, int& pm, int& pn) {
    const int b = blockIdx.x, G = gridDim.x;
    if ((G & 7) == 0 && (nM & 7) == 0) {
        const int per = nM >> 3, nlb = G >> 3, li = r * nlb + (b >> 3);
        if (li >= per * nN) return false;
        pm = (b & 7) * per + li % per; pn = li / per; return true;
    }
    const int u = r * G + b; if (u >= nM * nN) return false;
    pm = u / nN; pn = u % nN; return true;
}
struct DenseSched {
    const char* A; const char* Bt; int K; int nN;
    DEV bool next(int i, g8::Unit& u) const { int pm, pn; if (!dense_unit(i, T / 256, nN, pm, pn)) return false;
        u.A = A + (size_t)pm * 256 * K * 2; u.B = Bt + (size_t)pn * 256 * K * 2; u.i0 = pm; u.i1 = pn; u.i2 = 0; u.i3 = 0; return true; }
    DEV unsigned rowoff(const g8::Unit&, int) const { return 0u; }
};
struct SubSched {
    const char* A; const char* Bt; int K; int nN; int b0;
    DEV bool next(int i, g8::Unit& u) const { const int nb = (int)gridDim.x - b0, v = i * nb + ((int)blockIdx.x - b0); if (v >= 64 * nN) return false; const int pm = v / nN, pn = v % nN;
        u.A = A + (size_t)pm * 256 * K * 2; u.B = Bt + (size_t)pn * 256 * K * 2; u.i0 = pm; u.i1 = pn; u.i2 = 0; u.i3 = 0; return true; }
    DEV unsigned rowoff(const g8::Unit&, int) const { return 0u; }
};

DEV int perm_expert(int j) { return (j & 31) * 8 + (j >> 5); }
DEV void build_pref(const Params& p, char* smem) {
    int* sp = (int*)(smem + LDS_PREF_OFF);
    const int tid = opaque_tid();
    if (tid < 256) sp[tid + 1] = (int)((p.counts[perm_expert(tid) << 5] + 255u) >> 8);
    if (tid == 0) sp[0] = 0;
    __syncthreads();
    for (int off = 1; off < 256; off <<= 1) {
        int v = 0;
        if (tid < 256 && tid + 1 - off >= 1) v = sp[tid + 1 - off];
        __syncthreads();
        if (tid < 256) sp[tid + 1] += v;
        __syncthreads();
    }
}
template <int NT, int K, bool BYSLOT>
struct ExpSched {
    const int* sp; const unsigned* counts; const int* lslot; const char* A; const char* Bt; size_t bt_estride;
    DEV bool next(int i, g8::Unit& u) const {
        const int G = gridDim.x, b = blockIdx.x;
        int tile, pn, lo, hi;
        if ((G & 7) == 0) { const int xl = b & 7, li = i * (G >> 3) + (b >> 3); pn = li % NT; tile = sp[32 * xl] + li / NT; if (tile >= sp[32 * xl + 32]) return false; lo = 32 * xl; hi = 32 * xl + 32; }
        else { const int li = i * G + b; pn = li % NT; tile = li / NT; if (tile >= sp[256]) return false; lo = 0; hi = 256; }
        while (hi - lo > 1) { const int mid = (lo + hi) >> 1; if (sp[mid] <= tile) lo = mid; else hi = mid; }
        const int e = perm_expert(lo);
        u.A = A; u.B = Bt + (size_t)e * bt_estride + (size_t)pn * 256 * K * 2;
        u.i0 = e; u.i1 = (tile - sp[lo]) * 256; u.i2 = (int)counts[e << 5]; u.i3 = pn; return true;
    }
    DEV unsigned rowoff(const g8::Unit& u, int row) const {
        int rr = u.i1 + row; rr = rr < u.i2 ? rr : u.i2 - 1;
        const int slot = lslot[(size_t)u.i0 * T + rr];
        return (unsigned)(BYSLOT ? slot : (slot >> 3)) * (unsigned)(K * 2);
    }
};

struct FEpiP9 { float* logits; bf16_t* acts; int row0; int pn;
    DEV void operator()(int r, int c, f32x4 v0, f32x4 v1) const {
        if (pn == 0) { float* q = logits + (size_t)(row0 + r) * E + c; *(f32x4*)q = v0; *(f32x4*)(q + 16) = v1; }
        else { uint2 o; o.x = pack_bf16x2(siluf_(v0[0]) * v1[0], siluf_(v0[1]) * v1[1]); o.y = pack_bf16x2(siluf_(v0[2]) * v1[2], siluf_(v0[3]) * v1[3]);
               *(uint2*)(acts + (size_t)(row0 + r) * FF + (pn - 1) * 128 + (c >> 5) * 16 + (c & 15)) = o; } } };

DEV void cvt_tile(const float* src, bf16_t* dst, int ld, int dstK, int pair, int k0, int n0, int lane) {
    const int nq = lane & 15, kq = lane >> 4;
    const float* sp_ = src + (size_t)(k0 + 8 * kq) * ld + n0 + 4 * nq;
    float4 v[8];
#pragma unroll
    for (int r = 0; r < 8; ++r) v[r] = *(const float4*)(sp_ + (size_t)r * ld);
#pragma unroll
    for (int q = 0; q < 4; ++q) {
        const int n = n0 + 4 * nq + q;
        const int row = pair ? (((n >> 4) * 2 + (pair - 1)) * 16 + (n & 15)) : n;
        float e[8];
#pragma unroll
        for (int r = 0; r < 8; ++r) e[r] = q == 0 ? v[r].x : q == 1 ? v[r].y : q == 2 ? v[r].z : v[r].w;
        uint4 o; o.x = pack_bf16x2(e[0], e[1]); o.y = pack_bf16x2(e[2], e[3]); o.z = pack_bf16x2(e[4], e[5]); o.w = pack_bf16x2(e[6], e[7]);
        *(uint4*)(dst + (size_t)row * dstK + k0 + 8 * kq) = o;
    }
}
DEV void phase_convert(const Params& p) {
    const int tid_ = opaque_tid(), lane = tid_ & 63, gw = blockIdx.x * 8 + (tid_ >> 6), nw = gridDim.x * 8;
    constexpr int R0 = 2816, R1 = R0 + 256, R2 = R1 + 256, R3 = R2 + 512, R4 = R3 + 128, R5 = R4 + 128, R6 = R5 + 128, R7 = R6 + 128, R8 = R7 + 32768, R9 = R8 + 32768, R10 = R9 + 32768;
    for (int t = gw; t < R7; t += nw) {
        const float* src; bf16_t* dst; int K, N, pair, loc;
        if (t < R0) { src = p.w_in; dst = p.WinT; K = 1024; N = NIN; pair = 0; loc = t; }
        else if (t < R1) { src = p.w_conv_out; dst = p.WcoT; K = 512; N = D; pair = 0; loc = t - R0; }
        else if (t < R2) { src = p.w_hgrn_out; dst = p.WhoT; K = 512; N = D; pair = 0; loc = t - R1; }
        else if (t < R3) { src = p.w_o; dst = p.WoT; K = 1024; N = D; pair = 0; loc = t - R2; }
        else if (t < R4) { src = p.w_router; dst = p.WrsT; K = 1024; N = E; pair = 0; loc = t - R3; }
        else if (t < R5) { src = p.wgs; dst = p.WrsT + (size_t)256 * 1024; K = 1024; N = FF; pair = 1; loc = t - R4; }
        else if (t < R6) { src = p.wus; dst = p.WrsT + (size_t)256 * 1024; K = 1024; N = FF; pair = 2; loc = t - R5; }
        else if (t < R7) { src = p.wds; dst = p.WdsT; K = 256; N = D; pair = 0; loc = t - R6; }
        else if (t < R8) { const int l = t - R7, e = l >> 7; src = p.wge + (size_t)e * D * FF; dst = p.WgeuT + (size_t)e * 512 * 1024; K = 1024; N = FF; pair = 1; loc = l & 127; }
        else if (t < R9) { const int l = t - R8, e = l >> 7; src = p.wue + (size_t)e * D * FF; dst = p.WgeuT + (size_t)e * 512 * 1024; K = 1024; N = FF; pair = 2; loc = l & 127; }
        else { const int l = t - R9, e = l >> 7; src = p.wde + (size_t)e * FF * D; dst = p.WdeT + (size_t)e * 1024 * 256; K = 256; N = D; pair = 0; loc = l & 127; }
        const int nnt = N >> 6, kt = loc / nnt, ntile = loc % nnt;
        cvt_tile(src, dst, N, K, pair, kt * 32, ntile * 64, lane);
    }
}

__global__ void __launch_bounds__(512, 2) k_mega(Params p) {
    extern __shared__ __attribute__((aligned(16))) char smem[];
    volatile LAS unsigned* st = (volatile LAS unsigned*)(smem + LDS_BAR_OFF);
    LAS unsigned char* lds = (LAS unsigned char*)smem;
    if (threadIdx.x == 0) { st[0] = 0u; st[1] = 0u; st[2] = 0u; st[3] = 0u; }
    __syncthreads();
    const XcdBarrier bar = xcd_barrier_post(p.bar, st);

    phase_mod(p, smem);
    phase_convert(p);
    xcd_barrier(bar);
    phase_norm1(p);
    xcd_barrier(bar);
    g8::gemm_stream<false>(lds, D, DenseSched{(const char*)p.h1, (const char*)p.WinT, D, NIN / 256},
        [&](const g8::Unit& u) { return FEpiStoreBf16{p.proj, NIN, u.i0 * 256, u.i1 * 256}; });
    xcd_barrier(bar);
    phase_conv(p);
    for (int u = blockIdx.x; u < 1024; u += gridDim.x) hgrn_phase1(smem, p.proj, p.lbt, p.kcT, p.dec, u >> 2, u & 3);
    xcd_barrier(bar);
    {
        const int G = gridDim.x, b = blockIdx.x, nscan = G >> 1;
        if (b < nscan) { for (int e = b * 512 + opaque_tid(); e < 65536; e += nscan * 512) hgrn_phase2(p.kcT, p.dec, p.ST, e); }
        else g8::gemm_stream<false>(lds, 512, SubSched{(const char*)p.a1, (const char*)p.WcoT, 512, D / 256, nscan},
                [&](const g8::Unit& u) { return FEpiGateA{p.m, p.proj, u.i0 * 256, u.i1 * 256}; });
    }
    xcd_barrier(bar);
    for (int u = blockIdx.x; u < 1024; u += gridDim.x) hgrn_phase3(smem, p.proj, p.lbt, p.ST, p.hnw, p.ob, u >> 2, u & 3);
    xcd_barrier(bar);
    g8::gemm_stream<false>(lds, 512, DenseSched{(const char*)p.ob, (const char*)p.WhoT, 512, D / 256},
        [&](const g8::Unit& u) { return FEpiGateB{p.m, p.proj, u.i0 * 256, u.i1 * 256}; });
    xcd_barrier(bar);
    g8::gemm_stream<false>(lds, D, DenseSched{(const char*)p.m, (const char*)p.WoT, D, D / 256},
        [&](const g8::Unit& u) { return FEpiStoreBf16{p.y, D, u.i0 * 256, u.i1 * 256}; });
    xcd_barrier(bar);
    phase_mid(p);
    xcd_barrier(bar);
    g8::gemm_stream<false>(lds, D, DenseSched{(const char*)p.h2, (const char*)p.WrsT, D, 3},
        [&](const g8::Unit& u) { return FEpiP9{p.logits, p.acts, u.i0 * 256, u.i1}; });
    xcd_barrier(bar);
    phase_route(p);
    g8::gemm_stream<false>(lds, FF, DenseSched{(const char*)p.acts, (const char*)p.WdsT, FF, D / 256},
        [&](const g8::Unit& u) { return FEpiStoreBf16{p.shout, D, u.i0 * 256, u.i1 * 256}; });
    xcd_barrier(bar);
    build_pref(p, smem);
    {
        const int* sp = (const int*)(smem + LDS_PREF_OFF);
        const int ni = sp[256];
        for (int it = blockIdx.x; it < ni * 2; it += gridDim.x) {
            const int item = it >> 1, pn = it & 1; int lo = 0, hi = 256;
            while (hi - lo > 1) { const int mid = (lo + hi) >> 1; if (sp[mid] <= item) lo = mid; else hi = mid; }
            const int e = perm_expert(lo), r0 = (item - sp[lo]) * 256, cnt = (int)p.counts[e << 5];
            gemm_unit2<256>(smem, FAMapGather{p.h2, D, p.lslot, e * T, cnt, r0}, FBMapPair{p.wge + (size_t)e * D * FF, p.wue + (size_t)e * D * FF, FF, pn * 128},
                           FEpiSwiGLUSlot{p.act, p.lslot, e * T, cnt, r0, pn * 128}, D);
            __syncthreads();
        }
    }
    xcd_barrier(bar);
    {
        const int* sp = (const int*)(smem + LDS_PREF_OFF);
        const int ni = sp[256];
        for (int it = blockIdx.x; it < ni * 4; it += gridDim.x) {
            const int item = it >> 2, pn = it & 3; int lo = 0, hi = 256;
            while (hi - lo > 1) { const int mid = (lo + hi) >> 1; if (sp[mid] <= item) lo = mid; else hi = mid; }
            const int e = perm_expert(lo), r0 = (item - sp[lo]) * 256, cnt = (int)p.counts[e << 5];
            gemm_unit2<256>(smem, FAMapSlot{p.act, FF, p.lslot, e * T, cnt, r0}, FBMapPlain{p.wde + (size_t)e * FF * D, D, pn * 256},
                           FEpiSlot{p.yslot, p.lslot, p.lw, e * T, cnt, r0, pn * 256}, FF);
            __syncthreads();
        }
    }
    xcd_barrier(bar);
    phase_final(p);
}

extern "C" void kernel_launch(void* const* d_in, const int* in_sizes, int n_in, void* d_out, int out_size, void* d_ws, size_t ws_size, hipStream_t stream) {
    Params p; memset(&p, 0, sizeof(p));
    p.x = (const float*)d_in[0]; p.c = (const float*)d_in[1]; p.w_ada = (const float*)d_in[2]; p.b_ada = (const float*)d_in[3];
    p.npm = (const float*)d_in[4]; p.npostm = (const float*)d_in[5]; p.w_in = (const float*)d_in[6]; p.conv_w = (const float*)d_in[7];
    p.w_conv_out = (const float*)d_in[8]; p.lbt = (const float*)d_in[9]; p.hnw = (const float*)d_in[10]; p.w_hgrn_out = (const float*)d_in[11];
    p.w_o = (const float*)d_in[12]; p.npf = (const float*)d_in[13]; p.npostf = (const float*)d_in[14]; p.w_router = (const float*)d_in[15];
    p.rbias = (const float*)d_in[16]; p.wge = (const float*)d_in[17]; p.wue = (const float*)d_in[18]; p.wde = (const float*)d_in[19];
    p.wgs = (const float*)d_in[20]; p.wus = (const float*)d_in[21]; p.wds = (const float*)d_in[22];
    p.out = (float*)d_out;
    char* base = (char*)d_ws; size_t off = 0;
    auto take = [&](size_t bytes) { char* r = base + off; off += (bytes + 255) & ~(size_t)255; return r; };
    char* ctrl = take(65536);
    p.bar = (unsigned*)ctrl; p.counts = (unsigned*)(ctrl + 16384);
    p.mod = (float*)take(6 * D * 4);
    p.WinT = (bf16_t*)take((size_t)NIN * D * 2);
    p.WcoT = (bf16_t*)take((size_t)D * 512 * 2);
    p.WhoT = (bf16_t*)take((size_t)D * 512 * 2);
    p.WoT = (bf16_t*)take((size_t)D * D * 2);
    p.WrsT = (bf16_t*)take((size_t)768 * D * 2);
    p.WdsT = (bf16_t*)take((size_t)D * FF * 2);
    p.WgeuT = (bf16_t*)take((size_t)E * 512 * D * 2);
    p.WdeT = (bf16_t*)take((size_t)E * D * FF * 2);
    char* r1 = take((size_t)T * NIN * 2 + (size_t)256 * 65536 * 4 + (size_t)256 * 65536 * 2);
    p.proj = (bf16_t*)r1; p.kcT = (float*)(r1 + (size_t)T * NIN * 2); p.ST = (bf16_t*)(r1 + (size_t)T * NIN * 2 + (size_t)256 * 65536 * 4);
    p.yslot = (bf16_t*)r1;
    p.dec = (float*)take((size_t)256 * 512 * 4);
    char* r2 = take((size_t)3 * T * D * 2);
    p.h1 = (bf16_t*)r2; p.m = (bf16_t*)(r2 + (size_t)T * D * 2); p.y = (bf16_t*)(r2 + (size_t)2 * T * D * 2);
    p.act = (bf16_t*)r2;
    p.a1 = (bf16_t*)take((size_t)T * 512 * 2);
    p.ob = (bf16_t*)take((size_t)T * 512 * 2);
    p.h2 = (bf16_t*)take((size_t)T * D * 2);
    p.logits = (float*)take((size_t)T * E * 4);
    p.lslot = (int*)take((size_t)E * T * 4);
    p.lw = (float*)take((size_t)E * T * 4);
    p.acts = (bf16_t*)take((size_t)T * FF * 2);
    p.shout = (bf16_t*)take((size_t)T * D * 2);

    static int grid = 0;
    if (!grid) {
        (void)hipFuncSetAttribute((const void*)k_mega, hipFuncAttributeMaxDynamicSharedMemorySize, LDS_TOTAL);
        int dev = 0, cus = 0, per_cu = 0;
        (void)hipGetDevice(&dev);
        (void)hipDeviceGetAttribute(&cus, hipDeviceAttributeMultiprocessorCount, dev);
        (void)hipOccupancyMaxActiveBlocksPerMultiprocessor(&per_cu, (const void*)k_mega, 512, LDS_TOTAL);
        if (cus <= 0) cus = 256;
        grid = cus * (per_cu < 1 ? per_cu : 1);
        if (grid <= 0) grid = cus;
    }
    (void)hipMemsetAsync(ctrl, 0, 65536, stream);
    k_mega<<<grid, 512, LDS_TOTAL, stream>>>(p);
}
```

```cpp
#include <hip/hip_runtime.h>
#include <stdint.h>
#include <string.h>
#include <stddef.h>

typedef unsigned short bf16_t;
#define DEV __device__ __forceinline__

constexpr int T = 16384, D = 1024, NIN = 5632, E = 256, FF = 256, TOPK = 8;
constexpr int NP = 3584, OFF_CB = 0, OFF_CC = 512, OFF_CX = 1024, OFF_GA = 1536, OFF_GB = 2560, HX_Q = 0, HX_F = 1, HX_I = 2, HX_G = 3;
constexpr float EPS = 1e-6f;

DEV float bf2f(bf16_t v) { return __uint_as_float(((unsigned)v) << 16); }
DEV bf16_t f2bf(float f) { unsigned u = __float_as_uint(f); u += 0x7FFFu + ((u >> 16) & 1u); return (bf16_t)(u >> 16); }
DEV float sigmoidf_(float x) { return 1.f / (1.f + __expf(-x)); }
DEV float siluf_(float x) { return x / (1.f + __expf(-x)); }
DEV float wave_sum(float v) {
#pragma unroll
    for (int o = 32; o > 0; o >>= 1) v += __shfl_xor(v, o);
    return v;
}
DEV int opaque_tid() { int t = threadIdx.x; asm volatile("" : "+v"(t)); return t; }
DEV float lo_bf(unsigned u) { return __uint_as_float(u << 16); }
DEV float hi_bf(unsigned u) { return __uint_as_float(u & 0xffff0000u); }

#define XB_TMO      128
#define XB_XCNT(j)  (256  + 64 * (j))
#define XB_XSUB(j)  (1280 + 64 * (j))
#define XB_XGEN(j)  (2304 + 64 * (j))
#define XB_TOP      3328
#define XB_TOPGEN   3392
#define XCD_BAR_WORDS 3456
#define XB_SPIN_CAP (1u << 18)
#define LAS __attribute__((address_space(3)))
__device__ __forceinline__ unsigned xb_ld(unsigned* p)              { return __hip_atomic_load(p, __ATOMIC_RELAXED, __HIP_MEMORY_SCOPE_AGENT); }
__device__ __forceinline__ unsigned xb_add(unsigned* p, unsigned v) { return __hip_atomic_fetch_add(p, v, __ATOMIC_RELAXED, __HIP_MEMORY_SCOPE_AGENT); }
__device__ __forceinline__ unsigned xb_xcc_id() { return (unsigned)__builtin_amdgcn_s_getreg((3 << 11) | 20) & 0xFu; }
#define XB_SPIN(cond, bar) do { unsigned _sp = 0; while (cond) { __builtin_amdgcn_s_sleep(1); \
    if ((++_sp & 255u) == 0u) { if (xb_ld(&(bar)[XB_TMO])) break; if (_sp > XB_SPIN_CAP) { atomicAdd(&(bar)[XB_TMO], 1u); break; } } } } while (0)
struct XcdBarrier { unsigned* bar; unsigned x; volatile LAS unsigned* st; };
__device__ __forceinline__ XcdBarrier xcd_barrier_post(unsigned* bar, volatile LAS unsigned* st) {
    XcdBarrier b; b.bar = bar; b.x = xb_xcc_id(); b.st = st;
    if (threadIdx.x == 0) (void)xb_add(&bar[XB_XCNT(b.x)], 1u);
    return b;
}
__device__ __forceinline__ void xcd_barrier_complete(unsigned* bar, unsigned x, unsigned& nloc, unsigned& nx) {
    const unsigned G = gridDim.x * gridDim.y * gridDim.z;
    unsigned sum, cnt, mine, sp = 0u;
    for (;;) {
        sum = 0u; cnt = 0u; mine = 0u;
#pragma unroll
        for (unsigned j = 0; j < 16; ++j) { const unsigned c = xb_ld(&bar[XB_XCNT(j)]); sum += c; cnt += (c > 0u) ? 1u : 0u; mine = (j == x) ? c : mine; }
        if (sum == G) break;
        __builtin_amdgcn_s_sleep(1);
        if ((++sp & 255u) == 0u) { if (xb_ld(&bar[XB_TMO])) break; if (sp > XB_SPIN_CAP) { atomicAdd(&bar[XB_TMO], 1u); break; } }
    }
    nloc = mine > 0u ? mine : 1u; nx = cnt > 0u ? cnt : 1u;
}
__device__ __forceinline__ void xcd_barrier(const XcdBarrier& b) {
    asm volatile("s_waitcnt vmcnt(0)" ::: "memory");
    __syncthreads();
    if (threadIdx.x == 0) {
        unsigned* bar = b.bar;
        __builtin_amdgcn_s_waitcnt(0);
        unsigned nloc = b.st[0], nx = b.st[1];
        if (nloc == 0u) { xcd_barrier_complete(bar, b.x, nloc, nx); b.st[0] = nloc; b.st[1] = nx; }
        const unsigned old = xb_add(&bar[XB_XSUB(b.x)], 1u);
        const unsigned gen = old / nloc;
        if (old + 1u == (gen + 1u) * nloc) {
            __builtin_amdgcn_fence(__ATOMIC_RELEASE, "agent");
            asm volatile("s_waitcnt vmcnt(0)" ::: "memory");
            const unsigned og = xb_add(&bar[XB_TOP], 1u);
            const unsigned tg = og / nx;
            if (og + 1u == (tg + 1u) * nx) xb_add(&bar[XB_TOPGEN], 1u);
            else XB_SPIN(xb_ld(&bar[XB_TOPGEN]) == tg, bar);
            __builtin_amdgcn_fence(__ATOMIC_ACQUIRE, "agent");
            xb_add(&bar[XB_XGEN(b.x)], 1u);
            asm volatile("s_waitcnt vmcnt(0)" ::: "memory");
        } else {
            XB_SPIN(xb_ld(&bar[XB_XGEN(b.x)]) == gen, bar);
            __builtin_amdgcn_fence(__ATOMIC_ACQUIRE, "agent");
            asm volatile("s_waitcnt vmcnt(0)" ::: "memory");
        }
    }
    __syncthreads();
}

struct Params {
    const float *x, *c, *w_ada, *b_ada, *npm, *npostm, *w_in, *conv_w, *w_conv_out, *lbt, *hnw, *w_hgrn_out, *w_o, *npf, *npostf, *w_router, *rbias, *wge, *wue, *wde, *wgs, *wus, *wds;
    float* out;
    unsigned* bar;
    unsigned* counts;
    bf16_t *WinT, *WcoT, *WhoT, *WoT, *WrsT, *WdsT, *WgeuT, *WdeT;
    float* mod;
    bf16_t* h1;
    bf16_t* proj;
    float* kcT;
    float* dec;
    bf16_t* ST;
    bf16_t* a1;
    bf16_t* ob;
    bf16_t* m;
    bf16_t* y;
    bf16_t* h2;
    float* logits;
    int* lslot;
    float* lw;
    bf16_t* act;
    bf16_t* yslot;
    bf16_t* acts;
    bf16_t* shout;
};
typedef short bf16x8 __attribute__((ext_vector_type(8)));
typedef float f32x4 __attribute__((ext_vector_type(4)));
typedef short s16x4 __attribute__((ext_vector_type(4)));
typedef unsigned u32x2_t __attribute__((ext_vector_type(2)));
constexpr int GEMM_LDS_BYTES = 131072;
typedef __bf16 hwbf16x2 __attribute__((ext_vector_type(2)));
DEV unsigned pack_bf16x2(float lo, float hi) { hwbf16x2 v = {(__bf16)lo, (__bf16)hi}; return __builtin_bit_cast(unsigned, v); }

DEV const float* rfl_ptr(const float* p) { const unsigned long long v = (unsigned long long)p; const unsigned lo = (unsigned)__builtin_amdgcn_readfirstlane((int)(unsigned)v), hi = (unsigned)__builtin_amdgcn_readfirstlane((int)(unsigned)(v >> 32)); return (const float*)(((unsigned long long)hi << 32) | lo); }
namespace g8 {
constexpr int BK = 64, HALF = 128, HTB = HALF * BK * 2;
DEV int lds_byte(int r, int c) { const int st = (r >> 4) * 2 + (c >> 5), rr = r & 15, cc = c & 31, ob = rr * 64 + cc * 2; return st * 1024 + (ob ^ (((ob >> 9) & 1) << 5)); }
DEV void stage_rc(int b, int& R, int& C) { const int st = b / 1024, sb = b % 1024, swz = sb ^ (((sb >> 9) & 1) << 5); R = (st >> 1) * 16 + swz / 64; C = (st & 1) * 32 + (swz % 64) / 2; }

struct Unit { const char* A; const char* B; int i0, i1, i2, i3; };

template <bool GATHER, bool PERM, class Sched, class EpiF>
DEV void gemm_stream(LAS unsigned char* lds, const int K, const Sched& S, const EpiF& EF) {
    const int tid = opaque_tid(), wid = __builtin_amdgcn_readfirstlane(tid >> 6), lane = tid & 63, wr = wid >> 2, wc = wid & 3, fr = lane & 15, fq = lane >> 4;
    const int nt = K / BK;
    int Rr[2], Cc[2];
    unsigned voffB[2];
#pragma unroll
    for (int i = 0; i < 2; ++i) { stage_rc(tid * 16 + i * 8192, Rr[i], Cc[i]); voffB[i] = (unsigned)(Rr[i] * K + Cc[i]) * 2u; }
    const size_t kstep = (size_t)(BK * 2);
    const size_t hstepB = (size_t)HALF * K * 2;
    const size_t hstepA = GATHER ? 0 : hstepB;
    const unsigned ldsw = (unsigned)wid * 1024u;
    const int aoff = lds_byte(wr * 64 + fr, fq * 8), boff = lds_byte(wc * 32 + fr, fq * 8);
#define G8_SA(b, h) (((b) * 2 + (h)) * HTB)
#define G8_SB(b, h) ((4 + (b) * 2 + (h)) * HTB)
#define G8_STAGE(bufoff, gbase, v0_, v1_) do { \
        __builtin_amdgcn_global_load_lds((const unsigned*)((const char*)(gbase) + (v0_)), (LAS unsigned*)(lds + (bufoff) + ldsw), 16, 0, 0); \
        __builtin_amdgcn_global_load_lds((const unsigned*)((const char*)(gbase) + (v1_)), (LAS unsigned*)(lds + (bufoff) + ldsw + 8192), 16, 0, 0); } while (0)
#define G8_STAGE_B(b, h, gbase) G8_STAGE(G8_SB(b, h), gbase, voffB[0], voffB[1])
#define G8_STAGE_A(b, h, gbase, VA) G8_STAGE(G8_SA(b, h), gbase, VA[h][0], VA[h][1])
#define G8_LDA(dst, b, h) do { _Pragma("unroll") for (int m = 0; m < 4; ++m) _Pragma("unroll") for (int k = 0; k < 2; ++k) dst[m][k] = *(const LAS bf16x8*)(lds + G8_SA(b, h) + aoff + m * 2048 + k * 1024); } while (0)
#define G8_LDB(dst, b, h) do { _Pragma("unroll") for (int n = 0; n < 2; ++n) _Pragma("unroll") for (int k = 0; k < 2; ++k) dst[n][k] = *(const LAS bf16x8*)(lds + G8_SB(b, h) + boff + n * 2048 + k * 1024); } while (0)
#define G8_MMA(ai, bj, At, Bt) do { __builtin_amdgcn_s_setprio(1); _Pragma("unroll") for (int m = 0; m < 4; ++m) _Pragma("unroll") for (int n = 0; n < 2; ++n) _Pragma("unroll") for (int k = 0; k < 2; ++k) \
        acc[ai][bj][m][n] = __builtin_amdgcn_mfma_f32_16x16x32_bf16(Bt[n][k], At[m][k], acc[ai][bj][m][n], 0, 0, 0); __builtin_amdgcn_s_setprio(0); } while (0)
#define G8_WAIT_V(n) asm volatile("s_waitcnt vmcnt(" #n ")" ::: "memory")
#define G8_WAIT_L(n) asm volatile("s_waitcnt lgkmcnt(" #n ")" ::: "memory")
#define G8_BAR __builtin_amdgcn_s_barrier()
#define G8_SCHED __builtin_amdgcn_sched_barrier(0)
#define G8_VOFF(VA, u) do { _Pragma("unroll") for (int h_ = 0; h_ < 2; ++h_) _Pragma("unroll") for (int i_ = 0; i_ < 2; ++i_) \
        VA[h_][i_] = GATHER ? (S.rowoff(u, Rr[i_] + 128 * h_) + (unsigned)Cc[i_] * 2u) : (unsigned)(Rr[i_] * K + Cc[i_]) * 2u; } while (0)
    Unit cur, nxt; int ui = 0;
    if (!S.next(0, cur)) return;
    f32x4 acc[2][2][4][2];
#pragma unroll
    for (int a_ = 0; a_ < 2; ++a_)
#pragma unroll
        for (int b_ = 0; b_ < 2; ++b_)
#pragma unroll
            for (int m = 0; m < 4; ++m)
#pragma unroll
                for (int n = 0; n < 2; ++n) acc[a_][b_][m][n] = (f32x4){0.f, 0.f, 0.f, 0.f};
    bf16x8 At[4][2], B0[2][2], B1[2][2];
    unsigned vAc[2][2], vAn[2][2];
    G8_VOFF(vAc, cur);
#pragma unroll
    for (int h_ = 0; h_ < 2; ++h_)
#pragma unroll
        for (int i_ = 0; i_ < 2; ++i_) vAn[h_][i_] = vAc[h_][i_];
    const char* cA = cur.A; const char* cB = cur.B;
    G8_STAGE_B(0, 0, cB); G8_STAGE_A(0, 0, cA, vAc); G8_STAGE_B(0, 1, cB + hstepB); G8_STAGE_A(0, 1, cA + hstepA, vAc);
    if (wr == 1) G8_BAR;
    G8_WAIT_V(4); G8_BAR;
    G8_STAGE_B(1, 0, cB + kstep); G8_STAGE_A(1, 0, cA + kstep, vAc); G8_STAGE_B(1, 1, cB + hstepB + kstep);
    G8_WAIT_V(6); G8_BAR;
    for (;;) {
        const bool has_next = S.next(ui + 1, nxt);
        const char* nA = has_next ? nxt.A : cA; const char* nB = has_next ? nxt.B : cB;
#pragma unroll 1
        for (int t = 0; t < nt; t += 2) {
            const bool last = (t == nt - 2);
            const char* a1 = cA + (size_t)(t + 1) * kstep;
            const char* a2 = last ? nA : cA + (size_t)(t + 2) * kstep; const char* b2 = last ? nB : cB + (size_t)(t + 2) * kstep;
            const char* a3 = a2 + kstep; const char* b3 = b2 + kstep;
            unsigned vA2[2][2];
#pragma unroll
            for (int h_ = 0; h_ < 2; ++h_)
#pragma unroll
                for (int i_ = 0; i_ < 2; ++i_) vA2[h_][i_] = vAc[h_][i_];
            if constexpr (GATHER) { if (last && has_next) { G8_VOFF(vAn, nxt);
#pragma unroll
                for (int h_ = 0; h_ < 2; ++h_)
#pragma unroll
                    for (int i_ = 0; i_ < 2; ++i_) vA2[h_][i_] = vAn[h_][i_]; } }
            G8_LDB(B0, 0, 0); G8_SCHED; G8_LDA(At, 0, 0); G8_STAGE_A(1, 1, a1 + hstepA, vAc);
            G8_WAIT_L(8); G8_BAR; G8_WAIT_L(0); G8_MMA(0, 0, At, B0); G8_BAR; G8_SCHED;
            G8_LDB(B1, 0, 1); G8_STAGE_B(0, 0, b2);
            G8_BAR; G8_WAIT_L(0); G8_MMA(0, 1, At, B1); G8_BAR;
            G8_LDA(At, 0, 1); G8_STAGE_A(0, 0, a2, vA2);
            G8_BAR; G8_WAIT_L(0); G8_MMA(1, 0, At, B0); G8_BAR; G8_SCHED;
            G8_STAGE_B(0, 1, b2 + hstepB);
            G8_WAIT_V(6); G8_BAR; G8_MMA(1, 1, At, B1); G8_BAR;
            G8_LDB(B0, 1, 0); G8_SCHED; G8_LDA(At, 1, 0); G8_STAGE_A(0, 1, a2 + hstepA, vA2);
            G8_WAIT_L(8); G8_BAR; G8_WAIT_L(0); G8_MMA(0, 0, At, B0); G8_BAR; G8_SCHED;
            G8_LDB(B1, 1, 1); G8_STAGE_B(1, 0, b3);
            G8_BAR; G8_WAIT_L(0); G8_MMA(0, 1, At, B1); G8_BAR;
            G8_LDA(At, 1, 1); G8_STAGE_A(1, 0, a3, vA2);
            G8_BAR; G8_WAIT_L(0); G8_MMA(1, 0, At, B0); G8_BAR; G8_SCHED;
            G8_STAGE_B(1, 1, b3 + hstepB);
            G8_WAIT_V(6); G8_BAR; G8_MMA(1, 1, At, B1); G8_BAR;
        }
        {
            const auto epi = EF(cur);
#pragma unroll
            for (int ai = 0; ai < 2; ++ai)
#pragma unroll
                for (int m = 0; m < 4; ++m)
#pragma unroll
                    for (int bj = 0; bj < 2; ++bj) epi(128 * ai + 64 * wr + 16 * m + fr, 128 * bj + 32 * wc + (PERM ? 8 : 4) * fq, acc[ai][bj][m][0], acc[ai][bj][m][1]);
        }
        if (!has_next) break;
#pragma unroll
        for (int a_ = 0; a_ < 2; ++a_)
#pragma unroll
            for (int b_ = 0; b_ < 2; ++b_)
#pragma unroll
                for (int m = 0; m < 4; ++m)
#pragma unroll
                    for (int n = 0; n < 2; ++n) acc[a_][b_][m][n] = (f32x4){0.f, 0.f, 0.f, 0.f};
        if constexpr (GATHER) {
#pragma unroll
            for (int h_ = 0; h_ < 2; ++h_)
#pragma unroll
                for (int i_ = 0; i_ < 2; ++i_) vAc[h_][i_] = vAn[h_][i_]; }
        cur = nxt; cA = nA; cB = nB; ++ui;
    }
    G8_WAIT_V(0);
    if (wr == 0) G8_BAR;
    G8_BAR;
#undef G8_SA
#undef G8_SB
#undef G8_STAGE
#undef G8_STAGE_A
#undef G8_STAGE_B
#undef G8_LDA
#undef G8_LDB
#undef G8_MMA
#undef G8_WAIT_V
#undef G8_WAIT_L
#undef G8_BAR
#undef G8_SCHED
#undef G8_VOFF
}

struct UnitF { const char* A; const float* B0; const float* B1; int i0, i1, i2, i3; };
template <bool GATHER, class Sched, class EpiF>
DEV void gemm_stream_fb(LAS unsigned char* lds, const int K, const int ldb, const Sched& S, const EpiF& EF) {
    const int tid = opaque_tid(), wid = __builtin_amdgcn_readfirstlane(tid >> 6), lane = tid & 63, wr = wid >> 2, wc = wid & 3, fr = lane & 15, fq = lane >> 4;
    const int nt = K / BK;
    const size_t kstep = (size_t)(BK * 2);
    const size_t hstepA = GATHER ? 0 : (size_t)HALF * K * 2;
    const unsigned ldsw = (unsigned)wid * 1024u;
    const int aoff = lds_byte(wr * 64 + fr, fq * 8);
    const int g4 = lane >> 4, j16 = lane & 15, krow = j16 >> 2, c4 = j16 & 3, vg = wid & 1, kqb = wid >> 1;
    const unsigned bvoff = (unsigned)((4 * kqb + krow) * ldb + vg * 64 + g4 * 16 + c4 * 4) * 4u;
    const unsigned bwoff = (unsigned)(((kqb >> 1) * 8 + (vg * 2 + (g4 >> 1)) * 2 + (c4 & 1)) * 256 + (((4 * (kqb & 1) + krow) ^ (((kqb >> 1) & 1) << 2)) * 32) + ((g4 & 1) * 2 + (c4 >> 1)) * 8);
    const unsigned ldsu = (unsigned)__builtin_amdgcn_readfirstlane((int)(unsigned)(unsigned long long)lds);
    unsigned brd[2];
    { const int q = j16 >> 2, p = j16 & 3;
#pragma unroll
      for (int t = 0; t < 2; ++t) brd[t] = (unsigned)(fq * 2048 + wc * 512 + (((4 * t + q) ^ ((fq & 1) << 2)) * 32) + p * 8); }
#define F_SA(b, h) (((b) * 2 + (h)) * HTB)
#define F_SB(b, h) ((4 + (b) * 2 + (h)) * HTB)
#define F_GLDS(gsrc, ldsdst) do { unsigned keep_; const char* gs_ = (gsrc); const unsigned ld_ = (unsigned)__builtin_amdgcn_readfirstlane((int)(ldsdst)); \
        asm volatile("s_mov_b32 %0, m0\n\ts_mov_b32 m0, %2\n\ts_nop 0\n\tglobal_load_lds_dwordx4 %1, off\n\ts_mov_b32 m0, %0" : "=&s"(keep_) : "v"(gs_), "s"(ld_) : "memory"); } while (0)
#define F_STAGE_A(b, h, gbase, VA) do { \
        F_GLDS((const char*)(gbase) + VA[h][0], ldsu + (unsigned)F_SA(b, h) + ldsw); \
        F_GLDS((const char*)(gbase) + VA[h][1], ldsu + (unsigned)F_SA(b, h) + ldsw + 8192u); } while (0)
#define F_LDA(dst, b, h) do { _Pragma("unroll") for (int m = 0; m < 4; ++m) _Pragma("unroll") for (int k = 0; k < 2; ++k) dst[m][k] = *(const LAS bf16x8*)(lds + F_SA(b, h) + aoff + m * 2048 + k * 1024); } while (0)
#define F_LDB(dst, b, h) do { _Pragma("unroll") for (int n = 0; n < 2; ++n) _Pragma("unroll") for (int k = 0; k < 2; ++k) { \
        const s16x4 t0_ = __builtin_amdgcn_ds_read_tr16_b64_v4i16((LAS s16x4*)(lds + F_SB(b, h) + brd[0] + k * 8192 + n * 256)); \
        const s16x4 t1_ = __builtin_amdgcn_ds_read_tr16_b64_v4i16((LAS s16x4*)(lds + F_SB(b, h) + brd[1] + k * 8192 + n * 256)); \
        dst[n][k] = (bf16x8){t0_[0], t0_[1], t0_[2], t0_[3], t1_[0], t1_[1], t1_[2], t1_[3]}; } } while (0)
#define F_MMA(ai, bj) do { __builtin_amdgcn_s_setprio(1); _Pragma("unroll") for (int m = 0; m < 4; ++m) _Pragma("unroll") for (int n = 0; n < 2; ++n) _Pragma("unroll") for (int k = 0; k < 2; ++k) \
        acc[ai][bj][m][n] = __builtin_amdgcn_mfma_f32_16x16x32_bf16(Bx[n][k], At[m][k], acc[ai][bj][m][n], 0, 0, 0); __builtin_amdgcn_s_setprio(0); } while (0)
#define F_LOADB(SET, pb, ktile) do { const float* bp0_ = rfl_ptr((pb) + (size_t)((ktile) * 64) * ldb); const float* bp1_ = rfl_ptr(bp0_ + 16 * ldb); const float* bp2_ = rfl_ptr(bp0_ + 32 * ldb); const float* bp3_ = rfl_ptr(bp0_ + 48 * ldb); \
        asm volatile("s_nop 4\n\tglobal_load_dwordx4 %0, %4, %5\n\tglobal_load_dwordx4 %1, %4, %6\n\tglobal_load_dwordx4 %2, %4, %7\n\tglobal_load_dwordx4 %3, %4, %8" \
            : "=&v"(SET[0]), "=&v"(SET[1]), "=&v"(SET[2]), "=&v"(SET[3]) : "v"(bvoff), "s"(bp0_), "s"(bp1_), "s"(bp2_), "s"(bp3_) : "memory"); } while (0)
#define F_WAITSET(n, SET) asm volatile("s_waitcnt vmcnt(" #n ")" : "+v"(SET[0]), "+v"(SET[1]), "+v"(SET[2]), "+v"(SET[3]) :: "memory")
#define F_WRITEB(SET, b, h) do { const unsigned wa_ = ldsu + bwoff + (unsigned)F_SB(b, h); u32x2_t w0_, w1_, w2_, w3_; \
        w0_[0] = pack_bf16x2(SET[0][0], SET[0][1]); w0_[1] = pack_bf16x2(SET[0][2], SET[0][3]); w1_[0] = pack_bf16x2(SET[1][0], SET[1][1]); w1_[1] = pack_bf16x2(SET[1][2], SET[1][3]); \
        w2_[0] = pack_bf16x2(SET[2][0], SET[2][1]); w2_[1] = pack_bf16x2(SET[2][2], SET[2][3]); w3_[0] = pack_bf16x2(SET[3][0], SET[3][1]); w3_[1] = pack_bf16x2(SET[3][2], SET[3][3]); \
        asm volatile("ds_write_b64 %0, %1\n\tds_write_b64 %0, %2 offset:4096\n\tds_write_b64 %0, %3 offset:8192\n\tds_write_b64 %0, %4 offset:12288" \
            :: "v"(wa_), "v"(w0_), "v"(w1_), "v"(w2_), "v"(w3_) : "memory"); } while (0)
#define F_WAIT_V(n) asm volatile("s_waitcnt vmcnt(" #n ")" ::: "memory")
#define F_WAIT_L(n) asm volatile("s_waitcnt lgkmcnt(" #n ")" ::: "memory")
#define F_BAR __builtin_amdgcn_s_barrier()
#define F_SCHED __builtin_amdgcn_sched_barrier(0)
#define F_VOFF(VA, u) do { _Pragma("unroll") for (int i_ = 0; i_ < 2; ++i_) { int R_, C_; stage_rc(tid * 16 + i_ * 8192, R_, C_); _Pragma("unroll") for (int h_ = 0; h_ < 2; ++h_) \
        VA[h_][i_] = GATHER ? (S.rowoff(u, R_ + 128 * h_) + (unsigned)C_ * 2u) : (unsigned)(R_ * K + C_) * 2u; } } while (0)
    UnitF cur, nxt; int ui = 0;
    if (!S.next(0, cur)) return;
    f32x4 acc[2][2][4][2];
#pragma unroll
    for (int a_ = 0; a_ < 2; ++a_)
#pragma unroll
        for (int b_ = 0; b_ < 2; ++b_)
#pragma unroll
            for (int m = 0; m < 4; ++m)
#pragma unroll
                for (int n = 0; n < 2; ++n) acc[a_][b_][m][n] = (f32x4){0.f, 0.f, 0.f, 0.f};
    bf16x8 At[4][2], Bx[2][2];
    f32x4 X[4], Y[4];
    unsigned vAc[2][2];
    F_VOFF(vAc, cur);
    const char* cA = cur.A; const float* cP0 = rfl_ptr(cur.B0); const float* cP1 = rfl_ptr(cur.B1);
    F_LOADB(X, cP0, 0); F_LOADB(Y, cP1, 0); F_STAGE_A(0, 0, cA, vAc); F_STAGE_A(0, 1, cA + hstepA, vAc);
    if (wr == 1) F_BAR;
    F_WAITSET(0, X); F_WAITSET(0, Y); F_WRITEB(X, 0, 0); F_WRITEB(Y, 0, 1);
    F_SCHED;
    F_LOADB(X, cP0, 1); F_STAGE_A(1, 0, cA + kstep, vAc); F_LOADB(Y, cP1, 1);
    F_WAIT_L(0); F_BAR;
    F_BAR;
    for (;;) {
        const bool has_next = S.next(ui + 1, nxt);
        const char* nA = has_next ? nxt.A : cA; const float* nP0 = has_next ? rfl_ptr(nxt.B0) : cP0; const float* nP1 = has_next ? rfl_ptr(nxt.B1) : cP1;
#pragma unroll 1
        for (int t = 0; t < nt; t += 2) {
            const bool last = (t == nt - 2);
            const char* a1 = cA + (size_t)(t + 1) * kstep;
            const char* a2 = last ? nA : cA + (size_t)(t + 2) * kstep;
            const char* a3 = a2 + kstep;
            const float* p20 = last ? nP0 : cP0; const float* p21 = last ? nP1 : cP1; const int k2 = last ? 0 : t + 2;
            F_LDB(Bx, 0, 0); F_LDA(At, 0, 0); F_STAGE_A(1, 1, a1 + hstepA, vAc);
            F_BAR; F_WAIT_L(0); F_MMA(0, 0); F_BAR; F_SCHED;
            if constexpr (GATHER) { if (last && has_next && (nxt.i0 != cur.i0 || nxt.i1 != cur.i1)) { F_VOFF(vAc, nxt); } }
            F_LDB(Bx, 0, 1); F_SCHED; F_WAITSET(8, X); F_WRITEB(X, 1, 0); F_SCHED; F_LOADB(X, p20, k2);
            F_WAIT_L(0); F_BAR; F_MMA(0, 1); F_BAR; F_SCHED;
            F_LDA(At, 0, 1); F_LDB(Bx, 0, 0); F_STAGE_A(0, 0, a2, vAc);
            F_BAR; F_WAIT_L(0); F_MMA(1, 0); F_BAR; F_SCHED;
            F_LDB(Bx, 0, 1); F_SCHED; F_WAITSET(6, Y); F_WRITEB(Y, 1, 1); F_SCHED; F_LOADB(Y, p21, k2);
            F_WAIT_L(0); F_BAR; F_MMA(1, 1); F_BAR; F_SCHED;
            F_LDB(Bx, 1, 0); F_LDA(At, 1, 0); F_STAGE_A(0, 1, a2 + hstepA, vAc);
            F_BAR; F_WAIT_L(0); F_MMA(0, 0); F_BAR; F_SCHED;
            F_LDB(Bx, 1, 1); F_SCHED; F_WAITSET(8, X); F_WRITEB(X, 0, 0); F_SCHED; F_LOADB(X, p20, k2 + 1);
            F_WAIT_L(0); F_BAR; F_MMA(0, 1); F_BAR; F_SCHED;
            F_LDA(At, 1, 1); F_LDB(Bx, 1, 0); F_STAGE_A(1, 0, a3, vAc);
            F_BAR; F_WAIT_L(0); F_MMA(1, 0); F_BAR; F_SCHED;
            F_LDB(Bx, 1, 1); F_SCHED; F_WAITSET(6, Y); F_WRITEB(Y, 0, 1); F_SCHED; F_LOADB(Y, p21, k2 + 1);
            F_WAIT_L(0); F_BAR; F_MMA(1, 1); F_BAR; F_SCHED;
        }
        EF(cur).apply(acc, wr, wc, fr, fq);
        if (!has_next) break;
#pragma unroll
        for (int a_ = 0; a_ < 2; ++a_)
#pragma unroll
            for (int b_ = 0; b_ < 2; ++b_)
#pragma unroll
                for (int m = 0; m < 4; ++m)
#pragma unroll
                    for (int n = 0; n < 2; ++n) acc[a_][b_][m][n] = (f32x4){0.f, 0.f, 0.f, 0.f};
        cur = nxt; cA = nA; cP0 = nP0; cP1 = nP1; ++ui;
    }
    F_WAITSET(0, X); F_WAITSET(0, Y);
    asm volatile("" :: "v"(X[0]), "v"(X[1]), "v"(X[2]), "v"(X[3]), "v"(Y[0]), "v"(Y[1]), "v"(Y[2]), "v"(Y[3]));
    if (wr == 0) F_BAR;
    F_BAR;
#undef F_SA
#undef F_SB
#undef F_STAGE_A
#undef F_GLDS
#undef F_LDA
#undef F_LDB
#undef F_MMA
#undef F_LOADB
#undef F_WAITSET
#undef F_WRITEB
#undef F_WAIT_V
#undef F_WAIT_L
#undef F_BAR
#undef F_SCHED
#undef F_VOFF
}
}

typedef short s16x4 __attribute__((ext_vector_type(4)));


struct FAMapPlain { const bf16_t* A; int lda; int row0; DEV const bf16_t* operator()(int r) const { return A + (size_t)(row0 + r) * lda; } DEV const bf16_t* aorigin() const { return A; } };
struct FAMapGather { const bf16_t* A; int lda; const int* lslot; int base; int cnt; int r0;
    DEV const bf16_t* operator()(int r) const { int rr = r0 + r; rr = rr < cnt ? rr : cnt - 1; return A + (size_t)(lslot[base + rr] >> 3) * lda; } DEV const bf16_t* aorigin() const { return A; } };
struct FAMapSlot { const bf16_t* A; int lda; const int* lslot; int base; int cnt; int r0;
    DEV const bf16_t* operator()(int r) const { int rr = r0 + r; rr = rr < cnt ? rr : cnt - 1; return A + (size_t)lslot[base + rr] * lda; } DEV const bf16_t* aorigin() const { return A; } };
struct FBMapPlain { const float* W; int ldb; int col0; DEV const float* ptr(int vb) const { return W + col0 + vb * 16; } DEV int ld() const { return ldb; } };
struct FBMapPair { const float* Wg; const float* Wu; int ldb; int col0;
    DEV const float* ptr(int vb) const { return Wg + (ptrdiff_t)(vb & 1) * (Wu - Wg) + col0 + (vb >> 1) * 16; } DEV int ld() const { return ldb; } };

template <int BM, class AMap, class BMap, class Epi>
DEV void gemm_unit(char* smem, const AMap& amap, const BMap& bmap, const Epi& epi, int K) {
    constexpr int NA = BM / 64, MI = BM / 32, ABYTES = BM * 128, STG = ABYTES + 32768;
    const int tid = opaque_tid(), lane = tid & 63, wid = tid >> 6, wr = wid >> 2, wc = wid & 3, fr = lane & 15, fq = lane >> 4;
    const bf16_t* aptr[NA];
#pragma unroll
    for (int i = 0; i < NA; ++i) { const int c = tid + 512 * i, row = c >> 3, pch = c & 7; aptr[i] = amap(row) + ((pch ^ (row & 7)) << 3); }
    const int g = lane >> 4, j16 = lane & 15, krow = j16 >> 2, c4 = j16 & 3, vg = wid & 3, kh = wid >> 2;
    const int ldb = bmap.ld();
    const float* bptr = bmap.ptr(vg * 4 + g) + 4 * c4 + (size_t)(4 * kh + krow) * ldb;
    unsigned bwr[2];
#pragma unroll
    for (int o = 0; o < 2; ++o) bwr[o] = ABYTES + (vg * 4 + g) * 256 + (((4 * kh + krow) ^ (o << 2)) * 32) + c4 * 8;
    unsigned ard[2];
#pragma unroll
    for (int ks = 0; ks < 2; ++ks) { const int row = wr * (BM / 2) + fr; ard[ks] = row * 128 + (((ks * 4 + fq) ^ (row & 7)) << 4); }
    unsigned brd[2];
    { const int q = j16 >> 2, p = j16 & 3;
#pragma unroll
      for (int t = 0; t < 2; ++t) brd[t] = ABYTES + (fq * 16) * 256 + (((4 * t + q) ^ ((fq & 1) << 2)) * 32) + p * 8; }

    f32x4 acc[MI][4];
#pragma unroll
    for (int mi = 0; mi < MI; ++mi)
#pragma unroll
        for (int nf = 0; nf < 4; ++nf) acc[mi][nf] = (f32x4){0.f, 0.f, 0.f, 0.f};

    float4 breg[4];
    const int nk = K >> 6;
#define G_LOAD_A(kt, buf) do { _Pragma("unroll") for (int i = 0; i < NA; ++i) \
        __builtin_amdgcn_global_load_lds((const unsigned*)(aptr[i] + (kt) * 64), (LAS unsigned*)(smem + (buf) * STG + (tid + 512 * i) * 16), 16, 0, 0); } while (0)
#define G_LOAD_B(kt, h) do { _Pragma("unroll") for (int i = 0; i < 4; ++i) breg[i] = *(const float4*)(bptr + (size_t)((kt) * 64 + 8 * ((h) * 4 + i)) * ldb); } while (0)
#define G_WRITE_B(buf, h) do { char* sb_ = smem + (buf) * STG; \
        _Pragma("unroll") for (int i = 0; i < 4; ++i) { uint2 w; w.x = pack_bf16x2(breg[i].x, breg[i].y); w.y = pack_bf16x2(breg[i].z, breg[i].w); \
            *(uint2*)(sb_ + bwr[i & 1] + ((h) * 4 + i) * 16 * 256) = w; } } while (0)
#define G_COMPUTE(sb, ks) do { bf16x8 bf[4]; \
        _Pragma("unroll") for (int nf = 0; nf < 4; ++nf) { \
            const int nb = (nf >> 1) * 8 + wc * 2 + (nf & 1); const unsigned base = (ks) * 4 * 16 * 256 + nb * 256; \
            s16x4 t0 = __builtin_amdgcn_ds_read_tr16_b64_v4i16((LAS s16x4*)((sb) + brd[0] + base)); \
            s16x4 t1 = __builtin_amdgcn_ds_read_tr16_b64_v4i16((LAS s16x4*)((sb) + brd[1] + base)); \
            bf[nf] = (bf16x8){t0[0], t0[1], t0[2], t0[3], t1[0], t1[1], t1[2], t1[3]}; } \
        _Pragma("unroll") for (int mi = 0; mi < MI; ++mi) { \
            const bf16x8 af = *(const bf16x8*)((sb) + ard[ks] + mi * 16 * 128); \
            _Pragma("unroll") for (int nf = 0; nf < 4; ++nf) acc[mi][nf] = __builtin_amdgcn_mfma_f32_16x16x32_bf16(bf[nf], af, acc[mi][nf], 0, 0, 0); } } while (0)
    G_LOAD_A(0, 0); G_LOAD_B(0, 0); G_WRITE_B(0, 0); G_LOAD_B(0, 1); G_WRITE_B(0, 1);
    __syncthreads();
    for (int kt = 0; kt < nk; ++kt) {
        const bool more = kt + 1 < nk;
        const char* sb = smem + (kt & 1) * STG;
        if (more) { G_LOAD_A(kt + 1, (kt + 1) & 1); G_LOAD_B(kt + 1, 0); }
        G_COMPUTE(sb, 0);
        if (more) { G_WRITE_B((kt + 1) & 1, 0); G_LOAD_B(kt + 1, 1); }
        G_COMPUTE(sb, 1);
        if (more) { G_WRITE_B((kt + 1) & 1, 1); }
        __syncthreads();
    }
#undef G_LOAD_A
#undef G_LOAD_B
#undef G_WRITE_B
#undef G_COMPUTE
#pragma unroll
    for (int mi = 0; mi < MI; ++mi)
#pragma unroll
        for (int bj = 0; bj < 2; ++bj) epi(wr * (BM / 2) + mi * 16 + fr, bj * 128 + wc * 32 + 4 * fq, acc[mi][bj * 2], acc[mi][bj * 2 + 1]);
}


template <int BM, class AMap, class BMap, class Epi>
DEV void gemm_unit2(char* smem, const AMap& amap, const BMap& bmap, const Epi& epi, int K) {
    constexpr int NA = BM / 64, MI = BM / 32, ABYTES = BM * 128, STG = ABYTES + 32768;
    const int tid = opaque_tid(), lane = tid & 63, wid = tid >> 6, wr = wid >> 2, wc = wid & 3, fr = lane & 15, fq = lane >> 4;
    const char* abase = (const char*)amap.aorigin();
    unsigned aoffs[NA];
#pragma unroll
    for (int i = 0; i < NA; ++i) { const int c = tid + 512 * i, row = c >> 3, pch = c & 7; aoffs[i] = (unsigned)((const char*)(amap(row) + ((pch ^ (row & 7)) << 3)) - abase); }
    const int g = lane >> 4, j16 = lane & 15, krow = j16 >> 2, c4 = j16 & 3, vg = wid & 3, kh = wid >> 2;
    const int ldb = bmap.ld();
    const float* bptr = bmap.ptr(vg * 4 + g) + 4 * c4 + (size_t)(4 * kh + krow) * ldb;
    unsigned bwr[2];
#pragma unroll
    for (int o = 0; o < 2; ++o) bwr[o] = ABYTES + (vg * 4 + g) * 256 + (((4 * kh + krow) ^ (o << 2)) * 32) + c4 * 8;
    unsigned ard[2];
#pragma unroll
    for (int ks = 0; ks < 2; ++ks) { const int row = wr * (BM / 2) + fr; ard[ks] = row * 128 + (((ks * 4 + fq) ^ (row & 7)) << 4); }
    unsigned brd[2];
    { const int q = j16 >> 2, p = j16 & 3;
#pragma unroll
      for (int t = 0; t < 2; ++t) brd[t] = ABYTES + (fq * 16) * 256 + (((4 * t + q) ^ ((fq & 1) << 2)) * 32) + p * 8; }

    f32x4 acc[MI][4];
#pragma unroll
    for (int mi = 0; mi < MI; ++mi)
#pragma unroll
        for (int nf = 0; nf < 4; ++nf) acc[mi][nf] = (f32x4){0.f, 0.f, 0.f, 0.f};

    float4 breg[4];
    const int nk = K >> 6;
#define G_LOAD_A(kt, buf) do { _Pragma("unroll") for (int i = 0; i < NA; ++i) \
        __builtin_amdgcn_global_load_lds((const unsigned*)(abase + (size_t)(kt) * 128 + aoffs[i]), (LAS unsigned*)(smem + (buf) * STG + (tid + 512 * i) * 16), 16, 0, 0); } while (0)
#define G_LOAD_B(kt, h) do { _Pragma("unroll") for (int i = 0; i < 4; ++i) breg[i] = *(const float4*)(bptr + (size_t)((kt) * 64 + 8 * ((h) * 4 + i)) * ldb); } while (0)
#define G_WRITE_B(buf, h) do { char* sb_ = smem + (buf) * STG; \
        _Pragma("unroll") for (int i = 0; i < 4; ++i) { uint2 w; w.x = pack_bf16x2(breg[i].x, breg[i].y); w.y = pack_bf16x2(breg[i].z, breg[i].w); \
            *(uint2*)(sb_ + bwr[i & 1] + ((h) * 4 + i) * 16 * 256) = w; } } while (0)
#define G_AF(sb, ks, mi) (*(const bf16x8*)((sb) + ard[ks] + (mi) * 16 * 128))
#define G_MM(mi, afv) do { _Pragma("unroll") for (int nf = 0; nf < 4; ++nf) acc[mi][nf] = __builtin_amdgcn_mfma_f32_16x16x32_bf16(bf[nf], afv, acc[mi][nf], 0, 0, 0); } while (0)
#define G_COMPUTE(sb, ks) do { bf16x8 bf[4]; \
        _Pragma("unroll") for (int nf = 0; nf < 4; ++nf) { \
            const int nb = (nf >> 1) * 8 + wc * 2 + (nf & 1); const unsigned base = (ks) * 4 * 16 * 256 + nb * 256; \
            s16x4 t0 = __builtin_amdgcn_ds_read_tr16_b64_v4i16((LAS s16x4*)((sb) + brd[0] + base)); \
            s16x4 t1 = __builtin_amdgcn_ds_read_tr16_b64_v4i16((LAS s16x4*)((sb) + brd[1] + base)); \
            bf[nf] = (bf16x8){t0[0], t0[1], t0[2], t0[3], t1[0], t1[1], t1[2], t1[3]}; } \
        bf16x8 a0 = G_AF(sb, ks, 0), a1 = G_AF(sb, ks, 1), a2 = G_AF(sb, ks, 2), a3 = G_AF(sb, ks, 3); \
        G_MM(0, a0); a0 = G_AF(sb, ks, 4); G_MM(1, a1); a1 = G_AF(sb, ks, 5); G_MM(2, a2); a2 = G_AF(sb, ks, 6); G_MM(3, a3); a3 = G_AF(sb, ks, 7); \
        G_MM(4, a0); G_MM(5, a1); G_MM(6, a2); G_MM(7, a3); \
        if ((ks) == 0) { \
        __builtin_amdgcn_sched_group_barrier(0x100, 12, 0); \
        __builtin_amdgcn_sched_group_barrier(0x008, 4, 0); __builtin_amdgcn_sched_group_barrier(0x100, 1, 0); __builtin_amdgcn_sched_group_barrier(0x020, 2, 0); \
        __builtin_amdgcn_sched_group_barrier(0x008, 4, 0); __builtin_amdgcn_sched_group_barrier(0x100, 1, 0); __builtin_amdgcn_sched_group_barrier(0x020, 2, 0); \
        __builtin_amdgcn_sched_group_barrier(0x008, 4, 0); __builtin_amdgcn_sched_group_barrier(0x100, 1, 0); __builtin_amdgcn_sched_group_barrier(0x020, 2, 0); \
        __builtin_amdgcn_sched_group_barrier(0x008, 4, 0); __builtin_amdgcn_sched_group_barrier(0x100, 1, 0); __builtin_amdgcn_sched_group_barrier(0x020, 2, 0); \
        __builtin_amdgcn_sched_group_barrier(0x008, 4, 0); __builtin_amdgcn_sched_group_barrier(0x020, 1, 0); \
        __builtin_amdgcn_sched_group_barrier(0x008, 4, 0); __builtin_amdgcn_sched_group_barrier(0x020, 1, 0); \
        __builtin_amdgcn_sched_group_barrier(0x008, 4, 0); __builtin_amdgcn_sched_group_barrier(0x020, 1, 0); \
        __builtin_amdgcn_sched_group_barrier(0x008, 4, 0); __builtin_amdgcn_sched_group_barrier(0x020, 1, 0); \
        } else { \
        __builtin_amdgcn_sched_group_barrier(0x100, 12, 0); \
        __builtin_amdgcn_sched_group_barrier(0x008, 4, 0); __builtin_amdgcn_sched_group_barrier(0x100, 1, 0); \
        __builtin_amdgcn_sched_group_barrier(0x008, 4, 0); __builtin_amdgcn_sched_group_barrier(0x100, 1, 0); \
        __builtin_amdgcn_sched_group_barrier(0x008, 4, 0); __builtin_amdgcn_sched_group_barrier(0x100, 1, 0); \
        __builtin_amdgcn_sched_group_barrier(0x008, 4, 0); __builtin_amdgcn_sched_group_barrier(0x100, 1, 0); \
        __builtin_amdgcn_sched_group_barrier(0x008, 16, 0); } } while (0)
    float4 breg2[4];
#define G_LOAD_B2(kt) do { _Pragma("unroll") for (int i = 0; i < 4; ++i) breg2[i] = *(const float4*)(bptr + (size_t)((kt) * 64 + 8 * (4 + i)) * ldb); } while (0)
#define G_WRITE_B2(buf) do { char* sb_ = smem + (buf) * STG; \
        _Pragma("unroll") for (int i = 0; i < 4; ++i) { uint2 w; w.x = pack_bf16x2(breg2[i].x, breg2[i].y); w.y = pack_bf16x2(breg2[i].z, breg2[i].w); \
            *(uint2*)(sb_ + bwr[i & 1] + (4 + i) * 16 * 256) = w; } } while (0)
    G_LOAD_A(0, 0); G_LOAD_B(0, 0); G_LOAD_B2(0); G_WRITE_B(0, 0); G_WRITE_B2(0);
    __syncthreads();
    for (int kt = 0; kt < nk; ++kt) {
        const bool more = kt + 1 < nk;
        const char* sb = smem + (kt & 1) * STG;
        { const int kn = more ? kt + 1 : kt; G_LOAD_A(kn, (kt + 1) & 1); G_LOAD_B(kn, 0); G_LOAD_B2(kn); }
        G_COMPUTE(sb, 0);
        __builtin_amdgcn_sched_barrier(0);
        G_COMPUTE(sb, 1);
        if (more) { G_WRITE_B((kt + 1) & 1, 0); G_WRITE_B2((kt + 1) & 1); }
        __syncthreads();
    }
#undef G_LOAD_B2
#undef G_WRITE_B2
#undef G_LOAD_A
#undef G_LOAD_B
#undef G_WRITE_B
#undef G_COMPUTE
#undef G_AF
#undef G_MM
#pragma unroll
    for (int mi = 0; mi < MI; ++mi)
#pragma unroll
        for (int bj = 0; bj < 2; ++bj) epi(wr * (BM / 2) + mi * 16 + fr, bj * 128 + wc * 32 + 4 * fq, acc[mi][bj * 2], acc[mi][bj * 2 + 1]);
}


template <class AMap, class BMap, class Epi>
DEV void gemm_unit_bd(char* smem, const AMap& amap, const BMap& bmap, const Epi& epi, int K) {
    const int tid = opaque_tid(), lane = tid & 63, wid = tid >> 6, fr = lane & 15, fq = lane >> 4;
    const bf16_t* aptr[4];
#pragma unroll
    for (int i = 0; i < 4; ++i) { const int c = tid + 512 * i, row = c >> 3, pch = c & 7; aptr[i] = amap(row) + ((pch ^ (row & 7)) << 3); }
    const int ldb = bmap.ld();
    const float* bp0 = bmap.ptr(2 * wid) + fr + (size_t)(8 * fq) * ldb;
    const float* bp1 = bmap.ptr(2 * wid + 1) + fr + (size_t)(8 * fq) * ldb;
    unsigned ard[2];
#pragma unroll
    for (int ks = 0; ks < 2; ++ks) ard[ks] = fr * 128 + (((ks * 4 + fq) ^ (fr & 7)) << 4);
    f32x4 acc[16][2];
#pragma unroll
    for (int mi = 0; mi < 16; ++mi) { acc[mi][0] = (f32x4){0.f, 0.f, 0.f, 0.f}; acc[mi][1] = (f32x4){0.f, 0.f, 0.f, 0.f}; }
    float bq[2][2][8];
    const int nk = K >> 6;
#define BD_LOAD_A(kt) do { _Pragma("unroll") for (int i = 0; i < 4; ++i) \
        __builtin_amdgcn_global_load_lds((const unsigned*)(aptr[i] + (kt) * 64), (LAS unsigned*)(smem + ((kt) & 3) * 32768 + (tid + 512 * i) * 16), 16, 0, 0); } while (0)
#define BD_LOAD_B(kt) do { _Pragma("unroll") for (int ks = 0; ks < 2; ++ks) _Pragma("unroll") for (int j = 0; j < 8; ++j) { \
        const size_t ro = (size_t)((kt) * 64 + ks * 32 + j) * ldb; bq[0][ks][j] = bp0[ro]; bq[1][ks][j] = bp1[ro]; } } while (0)
    BD_LOAD_A(0); if (nk > 1) BD_LOAD_A(1); if (nk > 2) BD_LOAD_A(2);
    BD_LOAD_B(0);
    for (int kt = 0; kt < nk; ++kt) {
        bf16x8 bfr[2][2];
#pragma unroll
        for (int nf = 0; nf < 2; ++nf)
#pragma unroll
            for (int ks = 0; ks < 2; ++ks) {
                const unsigned p0 = pack_bf16x2(bq[nf][ks][0], bq[nf][ks][1]), p1 = pack_bf16x2(bq[nf][ks][2], bq[nf][ks][3]), p2 = pack_bf16x2(bq[nf][ks][4], bq[nf][ks][5]), p3 = pack_bf16x2(bq[nf][ks][6], bq[nf][ks][7]);
                const uint4 u = make_uint4(p0, p1, p2, p3);
                bfr[nf][ks] = __builtin_bit_cast(bf16x8, u);
            }
        asm volatile("s_waitcnt vmcnt(0)" ::: "memory");
        __builtin_amdgcn_s_barrier();
        if (kt + 3 < nk) BD_LOAD_A(kt + 3);
        if (kt + 1 < nk) BD_LOAD_B(kt + 1);
        asm volatile("" ::: "memory");
        const char* sb = smem + (kt & 3) * 32768;
#pragma unroll
        for (int ks = 0; ks < 2; ++ks)
#pragma unroll
            for (int mi = 0; mi < 16; ++mi) {
                const bf16x8 af = *(const bf16x8*)(sb + ard[ks] + mi * 2048);
                acc[mi][0] = __builtin_amdgcn_mfma_f32_16x16x32_bf16(bfr[0][ks], af, acc[mi][0], 0, 0, 0);
                acc[mi][1] = __builtin_amdgcn_mfma_f32_16x16x32_bf16(bfr[1][ks], af, acc[mi][1], 0, 0, 0);
            }
    }
#undef BD_LOAD_A
#undef BD_LOAD_B
#pragma unroll
    for (int mi = 0; mi < 16; ++mi) epi(mi * 16 + fr, 32 * wid + 4 * fq, acc[mi][0], acc[mi][1]);
}

struct FEpiStoreBf16 { bf16_t* C; int ldc; int row0; int col0;
    DEV void operator()(int r, int c, f32x4 v0, f32x4 v1) const { bf16_t* p = C + (size_t)(row0 + r) * ldc + col0 + c;
        uint2 a, b; a.x = pack_bf16x2(v0[0], v0[1]); a.y = pack_bf16x2(v0[2], v0[3]); b.x = pack_bf16x2(v1[0], v1[1]); b.y = pack_bf16x2(v1[2], v1[3]);
        *(uint2*)p = a; *(uint2*)(p + 16) = b; } };
struct FEpiStoreF32 { float* C; int ldc; int row0; int col0;
    DEV void operator()(int r, int c, f32x4 v0, f32x4 v1) const { float* p = C + (size_t)(row0 + r) * ldc + col0 + c; *(f32x4*)p = v0; *(f32x4*)(p + 16) = v1; } };
struct FEpiGateA { bf16_t* M; const bf16_t* proj; int row0; int col0;
    DEV void one(int r, int c, f32x4 v) const { const size_t row = row0 + r; const uint2 gr = *(const uint2*)(proj + row * NP + OFF_GA + col0 + c);
        float g0 = sigmoidf_(__uint_as_float(gr.x << 16)), g1 = sigmoidf_(__uint_as_float(gr.x & 0xffff0000u)), g2 = sigmoidf_(__uint_as_float(gr.y << 16)), g3 = sigmoidf_(__uint_as_float(gr.y & 0xffff0000u));
        uint2 o; o.x = pack_bf16x2(g0 * v[0], g1 * v[1]); o.y = pack_bf16x2(g2 * v[2], g3 * v[3]); *(uint2*)(M + row * D + col0 + c) = o; }
    DEV void operator()(int r, int c, f32x4 v0, f32x4 v1) const { one(r, c, v0); one(r, c + 16, v1); } };
struct FEpiGateB { bf16_t* M; const bf16_t* proj; int row0; int col0;
    DEV void one(int r, int c, f32x4 v) const { const size_t row = row0 + r; const uint2 gr = *(const uint2*)(proj + row * NP + OFF_GB + col0 + c);
        const uint2 mo = *(const uint2*)(M + row * D + col0 + c);
        float g0 = sigmoidf_(__uint_as_float(gr.x << 16)), g1 = sigmoidf_(__uint_as_float(gr.x & 0xffff0000u)), g2 = sigmoidf_(__uint_as_float(gr.y << 16)), g3 = sigmoidf_(__uint_as_float(gr.y & 0xffff0000u));
        float m0 = __uint_as_float(mo.x << 16), m1 = __uint_as_float(mo.x & 0xffff0000u), m2 = __uint_as_float(mo.y << 16), m3 = __uint_as_float(mo.y & 0xffff0000u);
        uint2 o; o.x = pack_bf16x2(m0 + g0 * v[0], m1 + g1 * v[1]); o.y = pack_bf16x2(m2 + g2 * v[2], m3 + g3 * v[3]); *(uint2*)(M + row * D + col0 + c) = o; }
    DEV void operator()(int r, int c, f32x4 v0, f32x4 v1) const { one(r, c, v0); one(r, c + 16, v1); } };
struct FEpiSwiGLU { bf16_t* act; int row0; int col0;
    DEV void operator()(int r, int c, f32x4 g, f32x4 u) const {
        uint2 o; o.x = pack_bf16x2(siluf_(g[0]) * u[0], siluf_(g[1]) * u[1]); o.y = pack_bf16x2(siluf_(g[2]) * u[2], siluf_(g[3]) * u[3]);
        *(uint2*)(act + (size_t)(row0 + r) * FF + col0 + (c >> 5) * 16 + (c & 15)) = o; } };
struct FEpiSwiGLUSlot { bf16_t* act; const int* lslot; int base; int cnt; int r0; int col0;
    DEV void operator()(int r, int c, f32x4 g, f32x4 u) const { const int rr = r0 + r; if (rr < cnt) {
        uint2 o; o.x = pack_bf16x2(siluf_(g[0]) * u[0], siluf_(g[1]) * u[1]); o.y = pack_bf16x2(siluf_(g[2]) * u[2], siluf_(g[3]) * u[3]);
        *(uint2*)(act + (size_t)lslot[base + rr] * FF + col0 + (c >> 5) * 16 + (c & 15)) = o; } } };
struct FEpiSlot { bf16_t* yslot; const int* lslot; const float* lw; int base; int cnt; int r0; int col0;
    DEV void operator()(int r, int c, f32x4 v0, f32x4 v1) const { const int rr = r0 + r; if (rr < cnt) { const int s = lslot[base + rr]; const float w = lw[base + rr];
        bf16_t* p = yslot + (size_t)s * D + col0 + c; uint2 a, b; a.x = pack_bf16x2(w * v0[0], w * v0[1]); a.y = pack_bf16x2(w * v0[2], w * v0[3]); b.x = pack_bf16x2(w * v1[0], w * v1[1]); b.y = pack_bf16x2(w * v1[2], w * v1[3]);
        *(uint2*)p = a; *(uint2*)(p + 16) = b; } } };

DEV unsigned sw128(int row, int chunk) { return (unsigned)(row * 128 + ((chunk ^ (row & 7)) << 4)); }
DEV unsigned sw256(int row, int chunk) { return (unsigned)(row * 256 + ((chunk ^ (row & 15)) << 4)); }
constexpr int HG_LDS_BYTES = 96 * 1024;

DEV void hgrn_load16(const bf16_t* hg, int t0, int seg, int xh, int d, unsigned short (&r)[16]) {
    const unsigned short* p = (const unsigned short*)hg + ((size_t)xh * T + t0 + 16 * seg) * 128 + d;
#pragma unroll
    for (int i = 0; i < 16; ++i) r[i] = p[i * 128];
}
DEV float raw2f(unsigned short r) { return __uint_as_float((unsigned)r << 16); }
DEV void hgrn_gates(const unsigned short (&rf)[16], const float* lbt, int h, int d, int seg, float* red, float (&fgv)[16], float (&b)[16], float& blast) {
    const float a0 = lbt[h * 128 + d], a1 = lbt[512 + h * 128 + d];
    const float lb = 1.f / (1.f + __expf(a1 - a0));
    float run = 0.f;
#pragma unroll
    for (int i = 0; i < 16; ++i) {
        const float f = raw2f(rf[i]);
        const float fg = lb + (1.f - lb) * sigmoidf_(f);
        fgv[i] = fg; run += __logf(fg); b[i] = run;
    }
    red[seg * 128 + d] = run;
    __syncthreads();
    const float r0 = red[d], r1 = red[128 + d], r2 = red[256 + d], r3 = red[384 + d];
    const float pre = (seg > 0 ? r0 : 0.f) + (seg > 1 ? r1 : 0.f) + (seg > 2 ? r2 : 0.f);
    blast = r0 + r1 + r2 + r3;
#pragma unroll
    for (int i = 0; i < 16; ++i) b[i] += pre;
}
DEV void pack16_store(char* smem, unsigned a0, unsigned a1, const float (&v)[16]) {
    uint4 lo, hi;
    lo.x = pack_bf16x2(v[0], v[1]); lo.y = pack_bf16x2(v[2], v[3]); lo.z = pack_bf16x2(v[4], v[5]); lo.w = pack_bf16x2(v[6], v[7]);
    hi.x = pack_bf16x2(v[8], v[9]); hi.y = pack_bf16x2(v[10], v[11]); hi.z = pack_bf16x2(v[12], v[13]); hi.w = pack_bf16x2(v[14], v[15]);
    *(uint4*)(smem + a0) = lo; *(uint4*)(smem + a1) = hi;
}

DEV void hgrn_phase1(char* smem, const bf16_t* proj, const float* lbt, float* kcT, float* dec, int c, int h) {
    const int tid = opaque_tid(), d = tid & 127, seg = tid >> 7, t0 = c * 64;
    const int lane = tid & 63, w = tid >> 6, fr = lane & 15, fq = lane >> 4;
    float* red = (float*)(smem + 32768);
    unsigned short rf[16], ri[16];
    hgrn_load16(proj, t0, seg, HX_F * 4 + h, d, rf);
    hgrn_load16(proj, t0, seg, HX_I * 4 + h, d, ri);
    float fgv[16], b[16], blast;
    hgrn_gates(rf, lbt, h, d, seg, red, fgv, b, blast);
    float kd[16], vv[16];
#pragma unroll
    for (int i = 0; i < 16; ++i) {
        kd[i] = (1.f - fgv[i]) * __expf(blast - b[i]);
        vv[i] = raw2f(ri[i]);
    }
    pack16_store(smem, sw128(d, 2 * seg), sw128(d, 2 * seg + 1), kd);
    pack16_store(smem + 16384, sw128(d, 2 * seg), sw128(d, 2 * seg + 1), vv);
    if (seg == 3) dec[(size_t)(c * 4 + h) * 128 + d] = __expf(blast);
    __syncthreads();
    f32x4 acc[8];
#pragma unroll
    for (int nv = 0; nv < 8; ++nv) acc[nv] = (f32x4){0.f, 0.f, 0.f, 0.f};
#pragma unroll
    for (int ks = 0; ks < 2; ++ks) {
        const bf16x8 xf = *(const bf16x8*)(smem + sw128(16 * w + fr, ks * 4 + fq));
#pragma unroll
        for (int nv = 0; nv < 8; ++nv) {
            const bf16x8 yf = *(const bf16x8*)(smem + 16384 + sw128(16 * nv + fr, ks * 4 + fq));
            acc[nv] = __builtin_amdgcn_mfma_f32_16x16x32_bf16(xf, yf, acc[nv], 0, 0, 0);
        }
    }
    float* out = kcT + (size_t)(c * 4 + h) * 16384;
#pragma unroll
    for (int nv = 0; nv < 8; ++nv) *(f32x4*)(out + (16 * nv + fr) * 128 + 16 * w + 4 * fq) = acc[nv];
    __syncthreads();
}

DEV void hgrn_phase2(const float* kcT, const float* dec, bf16_t* ST, int e) {
    const int h = e >> 14, d = e & 127;
    float S = 0.f;
    for (int c0 = 0; c0 < 256; c0 += 16) {
        float kc[16], dc[16];
#pragma unroll
        for (int i = 0; i < 16; ++i) { kc[i] = kcT[(size_t)(c0 + i) * 65536 + e]; dc[i] = dec[(size_t)((c0 + i) * 4 + h) * 128 + d]; }
#pragma unroll
        for (int i = 0; i < 16; ++i) { ST[(size_t)(c0 + i) * 65536 + e] = f2bf(S); S = dc[i] * S + kc[i]; }
    }
}

DEV void hgrn_phase3(char* smem, const bf16_t* proj, const float* lbt, const bf16_t* ST, const float* hw, bf16_t* ob, int c, int h) {
    constexpr int O_QT = 0, O_KT = 16384, O_VT = 32768, O_ST = 49152, O_AT = 81920, O_RED = 90112, O_SSQ = 92160;
    const int tid = opaque_tid(), d = tid & 127, seg = tid >> 7, t0 = c * 64;
    const int lane = tid & 63, w = tid >> 6, fr = lane & 15, fq = lane >> 4;
    {
        unsigned short rf[16], rq[16], ri[16];
        hgrn_load16(proj, t0, seg, HX_F * 4 + h, d, rf);
        hgrn_load16(proj, t0, seg, HX_Q * 4 + h, d, rq);
        hgrn_load16(proj, t0, seg, HX_I * 4 + h, d, ri);
        const bf16_t* sp = ST + (size_t)(c * 4 + h) * 16384;
#pragma unroll
        for (int i = 0; i < 4; ++i) { const int idx = tid + 512 * i, row = idx >> 4, ch = (idx & 15) ^ (row & 15);
            __builtin_amdgcn_global_load_lds((const unsigned*)(sp + row * 128 + ch * 8), (LAS unsigned*)(smem + O_ST + idx * 16), 16, 0, 0); }
        float fgv[16], b[16], blast;
        hgrn_gates(rf, lbt, h, d, seg, (float*)(smem + O_RED), fgv, b, blast);
        float vv[16];
#pragma unroll
        for (int i = 0; i < 16; ++i) {
            const int t = 16 * seg + i;
            const float qv = raw2f(rq[i]);
            const float eb = __expf(b[i]);
            const float qt = siluf_(qv) * eb, kt = (1.f - fgv[i]) / eb;
            const unsigned off = sw256(t, d >> 3) + (d & 7) * 2;
            *(bf16_t*)(smem + O_QT + off) = f2bf(qt);
            *(bf16_t*)(smem + O_KT + off) = f2bf(kt);
            vv[i] = raw2f(ri[i]);
        }
        pack16_store(smem + O_VT, sw128(d, 2 * seg), sw128(d, 2 * seg + 1), vv);
    }
    __syncthreads();
    {
        const int tb = w & 3;
#pragma unroll
        for (int u = 0; u < 2; ++u) {
            const int sb = (w >> 2) * 2 + u;
            f32x4 acc = (f32x4){0.f, 0.f, 0.f, 0.f};
            if (sb <= tb) {
#pragma unroll
                for (int ks = 0; ks < 4; ++ks) {
                    const bf16x8 xf = *(const bf16x8*)(smem + O_KT + sw256(16 * sb + fr, ks * 4 + fq));
                    const bf16x8 yf = *(const bf16x8*)(smem + O_QT + sw256(16 * tb + fr, ks * 4 + fq));
                    acc = __builtin_amdgcn_mfma_f32_16x16x32_bf16(xf, yf, acc, 0, 0, 0);
                }
                const int t = 16 * tb + fr, s0 = 16 * sb + 4 * fq;
#pragma unroll
                for (int jj = 0; jj < 4; ++jj) if (s0 + jj > t) acc[jj] = 0.f;
            }
            uint2 o; o.x = pack_bf16x2(acc[0], acc[1]); o.y = pack_bf16x2(acc[2], acc[3]);
            *(uint2*)(smem + O_AT + sw128(16 * tb + fr, 2 * sb + (fq >> 1)) + 8 * (fq & 1)) = o;
        }
    }
    __syncthreads();
    const int tb = w & 3, vh = w >> 2;
    const size_t trow = (size_t)(t0 + 16 * tb + fr);
    uint2 grv[4];
#pragma unroll
    for (int n = 0; n < 4; ++n) grv[n] = *(const uint2*)(proj + ((size_t)(HX_G * 4 + h) * T + trow) * 128 + 16 * (4 * vh + n) + 4 * fq);
    f32x4 acc[4];
#pragma unroll
    for (int n = 0; n < 4; ++n) acc[n] = (f32x4){0.f, 0.f, 0.f, 0.f};
#pragma unroll
    for (int ks = 0; ks < 2; ++ks) {
        const bf16x8 yf = *(const bf16x8*)(smem + O_AT + sw128(16 * tb + fr, ks * 4 + fq));
#pragma unroll
        for (int n = 0; n < 4; ++n) {
            const bf16x8 xf = *(const bf16x8*)(smem + O_VT + sw128(16 * (4 * vh + n) + fr, ks * 4 + fq));
            acc[n] = __builtin_amdgcn_mfma_f32_16x16x32_bf16(xf, yf, acc[n], 0, 0, 0);
        }
    }
#pragma unroll
    for (int ks = 0; ks < 4; ++ks) {
        const bf16x8 yf = *(const bf16x8*)(smem + O_QT + sw256(16 * tb + fr, ks * 4 + fq));
#pragma unroll
        for (int n = 0; n < 4; ++n) {
            const bf16x8 xf = *(const bf16x8*)(smem + O_ST + sw256(16 * (4 * vh + n) + fr, ks * 4 + fq));
            acc[n] = __builtin_amdgcn_mfma_f32_16x16x32_bf16(xf, yf, acc[n], 0, 0, 0);
        }
    }
    float ss = 0.f;
#pragma unroll
    for (int n = 0; n < 4; ++n)
#pragma unroll
        for (int jj = 0; jj < 4; ++jj) ss += acc[n][jj] * acc[n][jj];
    ss += __shfl_xor(ss, 16); ss += __shfl_xor(ss, 32);
    float* ssq = (float*)(smem + O_SSQ);
    if (fq == 0) ssq[vh * 64 + 16 * tb + fr] = ss;
    __syncthreads();
    const float tot = ssq[16 * tb + fr] + ssq[64 + 16 * tb + fr];
    const float rs = rsqrtf(tot * (1.f / 128.f) + EPS);
#pragma unroll
    for (int n = 0; n < 4; ++n) {
        const int v0 = 16 * (4 * vh + n) + 4 * fq;
        const uint2 gr = grv[n];
        const f32x4 wv = *(const f32x4*)(hw + v0);
        const float g0 = siluf_(__uint_as_float(gr.x << 16)), g1 = siluf_(__uint_as_float(gr.x & 0xffff0000u)), g2 = siluf_(__uint_as_float(gr.y << 16)), g3 = siluf_(__uint_as_float(gr.y & 0xffff0000u));
        uint2 o; o.x = pack_bf16x2(acc[n][0] * rs * wv[0] * g0, acc[n][1] * rs * wv[1] * g1); o.y = pack_bf16x2(acc[n][2] * rs * wv[2] * g2, acc[n][3] * rs * wv[3] * g3);
        *(uint2*)(ob + trow * 512 + h * 128 + v0) = o;
    }
    __syncthreads();
}


constexpr int LDS_BAR_OFF = GEMM_LDS_BYTES;
constexpr int LDS_PREF_OFF = GEMM_LDS_BYTES + 256;
constexpr int LDS_CNT_OFF = LDS_PREF_OFF + 1040;
constexpr int LDS_TOTAL = GEMM_LDS_BYTES + 256 + 2304;

DEV void phase_mod(const Params& p, char* smem) {
    const int tid = opaque_tid(), ks = tid >> 3, sub = tid & 7;
    float* red = (float*)smem;
    for (int cb = blockIdx.x; cb < 256; cb += gridDim.x) {
        const int j0 = cb * 24;
        float a0 = 0.f, a1 = 0.f, a2 = 0.f;
#pragma unroll 4
        for (int i = 0; i < 16; ++i) {
            const int k = ks + 64 * i;
            const float sc = siluf_(p.c[k]);
            const float* w = p.w_ada + (size_t)k * (6 * D) + j0 + 3 * sub;
            a0 += sc * w[0]; a1 += sc * w[1]; a2 += sc * w[2];
        }
        red[ks * 24 + 3 * sub] = a0; red[ks * 24 + 3 * sub + 1] = a1; red[ks * 24 + 3 * sub + 2] = a2;
        __syncthreads();
        if (tid < 24) { float sacc = p.b_ada[j0 + tid]; for (int q = 0; q < 64; ++q) sacc += red[q * 24 + tid]; p.mod[j0 + tid] = sacc; }
        __syncthreads();
    }
}

DEV void phase_norm1(const Params& p) {
    const int tid_ = opaque_tid(), lane = tid_ & 63, gw = blockIdx.x * 8 + (tid_ >> 6), nw = gridDim.x * 8;
    float wsc[16], shv[16];
#pragma unroll
    for (int i = 0; i < 4; ++i) {
        const int c = i * 256 + lane * 4;
        const float4 w = *(const float4*)(p.npm + c), sc = *(const float4*)(p.mod + D + c), sh = *(const float4*)(p.mod + c);
        wsc[4 * i] = w.x * (1.f + sc.x); wsc[4 * i + 1] = w.y * (1.f + sc.y); wsc[4 * i + 2] = w.z * (1.f + sc.z); wsc[4 * i + 3] = w.w * (1.f + sc.w);
        shv[4 * i] = sh.x; shv[4 * i + 1] = sh.y; shv[4 * i + 2] = sh.z; shv[4 * i + 3] = sh.w;
    }
    float4 v[4];
    if (gw < T) {
#pragma unroll
        for (int i = 0; i < 4; ++i) v[i] = *(const float4*)(p.x + (size_t)gw * D + i * 256 + lane * 4);
    }
    for (int row = gw; row < T; row += nw) {
        const int nrow = row + nw < T ? row + nw : row;
        float4 vn[4];
#pragma unroll
        for (int i = 0; i < 4; ++i) vn[i] = *(const float4*)(p.x + (size_t)nrow * D + i * 256 + lane * 4);
        float ss = 0.f;
#pragma unroll
        for (int i = 0; i < 4; ++i) ss += v[i].x * v[i].x + v[i].y * v[i].y + v[i].z * v[i].z + v[i].w * v[i].w;
        ss = wave_sum(ss);
        const float rs = rsqrtf(ss * (1.f / D) + EPS);
#pragma unroll
        for (int i = 0; i < 4; ++i) {
            const int c = i * 256 + lane * 4;
            uint2 o; o.x = pack_bf16x2(v[i].x * rs * wsc[4 * i] + shv[4 * i], v[i].y * rs * wsc[4 * i + 1] + shv[4 * i + 1]);
            o.y = pack_bf16x2(v[i].z * rs * wsc[4 * i + 2] + shv[4 * i + 2], v[i].w * rs * wsc[4 * i + 3] + shv[4 * i + 3]);
            *(uint2*)(p.h1 + (size_t)row * D + c) = o;
        }
#pragma unroll
        for (int i = 0; i < 4; ++i) v[i] = vn[i];
    }
}

DEV void phase_conv(const Params& p) {
    const int gt = blockIdx.x * 512 + opaque_tid(), nt = gridDim.x * 512;
    const int c8 = (gt & 63) * 8;
    float w[3][8];
#pragma unroll
    for (int j = 0; j < 3; ++j) { const float4 w0 = *(const float4*)(p.conv_w + j * 512 + c8), w1 = *(const float4*)(p.conv_w + j * 512 + c8 + 4);
        w[j][0] = w0.x; w[j][1] = w0.y; w[j][2] = w0.z; w[j][3] = w0.w; w[j][4] = w1.x; w[j][5] = w1.y; w[j][6] = w1.z; w[j][7] = w1.w; }
    uint4 cc[3], cx[3], cb;
#define CONV_LOAD(t_, CC, CX, CB) do { _Pragma("unroll") for (int j = 0; j < 3; ++j) { const int tt = (t_) - 2 + j, tc = tt < 0 ? 0 : tt; \
        CC[j] = *(const uint4*)(p.proj + (size_t)tc * NP + OFF_CC + c8); CX[j] = *(const uint4*)(p.proj + (size_t)tc * NP + OFF_CX + c8); } \
        CB = *(const uint4*)(p.proj + (size_t)(t_) * NP + OFF_CB + c8); } while (0)
    if (gt < T * 64) CONV_LOAD(gt >> 6, cc, cx, cb);
    for (int idx = gt; idx < T * 64; idx += nt) {
        const int t = idx >> 6, tn = (idx + nt < T * 64) ? ((idx + nt) >> 6) : t;
        uint4 ccn[3], cxn[3], cbn;
        CONV_LOAD(tn, ccn, cxn, cbn);
        float acc[8];
#pragma unroll
        for (int q = 0; q < 8; ++q) acc[q] = 0.f;
#pragma unroll
        for (int j = 0; j < 3; ++j) {
            const float mk = (t - 2 + j >= 0) ? 1.f : 0.f;
            acc[0] += mk * w[j][0] * lo_bf(cc[j].x) * lo_bf(cx[j].x); acc[1] += mk * w[j][1] * hi_bf(cc[j].x) * hi_bf(cx[j].x);
            acc[2] += mk * w[j][2] * lo_bf(cc[j].y) * lo_bf(cx[j].y); acc[3] += mk * w[j][3] * hi_bf(cc[j].y) * hi_bf(cx[j].y);
            acc[4] += mk * w[j][4] * lo_bf(cc[j].z) * lo_bf(cx[j].z); acc[5] += mk * w[j][5] * hi_bf(cc[j].z) * hi_bf(cx[j].z);
            acc[6] += mk * w[j][6] * lo_bf(cc[j].w) * lo_bf(cx[j].w); acc[7] += mk * w[j][7] * hi_bf(cc[j].w) * hi_bf(cx[j].w);
        }
        uint4 o;
        o.x = pack_bf16x2(lo_bf(cb.x) * acc[0], hi_bf(cb.x) * acc[1]); o.y = pack_bf16x2(lo_bf(cb.y) * acc[2], hi_bf(cb.y) * acc[3]);
        o.z = pack_bf16x2(lo_bf(cb.z) * acc[4], hi_bf(cb.z) * acc[5]); o.w = pack_bf16x2(lo_bf(cb.w) * acc[6], hi_bf(cb.w) * acc[7]);
        *(uint4*)(p.a1 + (size_t)t * 512 + c8) = o;
#pragma unroll
        for (int j = 0; j < 3; ++j) { cc[j] = ccn[j]; cx[j] = cxn[j]; }
        cb = cbn;
    }
#undef CONV_LOAD
}

DEV void phase_mid(const Params& p) {
    const int tid_ = opaque_tid(), lane = tid_ & 63, gw = blockIdx.x * 8 + (tid_ >> 6), nw = gridDim.x * 8;
    float gwm[16], wsc[16], shv[16];
#pragma unroll
    for (int i = 0; i < 4; ++i) {
        const int c = i * 256 + lane * 4;
        const float4 g1 = *(const float4*)(p.mod + 2 * D + c), w = *(const float4*)(p.npostm + c), w2 = *(const float4*)(p.npf + c), sc = *(const float4*)(p.mod + 4 * D + c), sh = *(const float4*)(p.mod + 3 * D + c);
        gwm[4 * i] = g1.x * w.x; gwm[4 * i + 1] = g1.y * w.y; gwm[4 * i + 2] = g1.z * w.z; gwm[4 * i + 3] = g1.w * w.w;
        wsc[4 * i] = w2.x * (1.f + sc.x); wsc[4 * i + 1] = w2.y * (1.f + sc.y); wsc[4 * i + 2] = w2.z * (1.f + sc.z); wsc[4 * i + 3] = w2.w * (1.f + sc.w);
        shv[4 * i] = sh.x; shv[4 * i + 1] = sh.y; shv[4 * i + 2] = sh.z; shv[4 * i + 3] = sh.w;
    }
    uint2 yr[4]; float4 xr[4];
    if (gw < T) {
#pragma unroll
        for (int i = 0; i < 4; ++i) { yr[i] = *(const uint2*)(p.y + (size_t)gw * D + i * 256 + lane * 4); xr[i] = *(const float4*)(p.x + (size_t)gw * D + i * 256 + lane * 4); }
    }
    for (int row = gw; row < T; row += nw) {
        const int nrow = row + nw < T ? row + nw : row;
        uint2 yn[4]; float4 xn[4];
#pragma unroll
        for (int i = 0; i < 4; ++i) { yn[i] = *(const uint2*)(p.y + (size_t)nrow * D + i * 256 + lane * 4); xn[i] = *(const float4*)(p.x + (size_t)nrow * D + i * 256 + lane * 4); }
        float yv[16], xv[16]; float ss = 0.f;
#pragma unroll
        for (int i = 0; i < 4; ++i) {
            yv[4 * i] = lo_bf(yr[i].x); yv[4 * i + 1] = hi_bf(yr[i].x); yv[4 * i + 2] = lo_bf(yr[i].y); yv[4 * i + 3] = hi_bf(yr[i].y);
#pragma unroll
            for (int j = 0; j < 4; ++j) ss += yv[4 * i + j] * yv[4 * i + j];
        }
        ss = wave_sum(ss);
        const float rs = rsqrtf(ss * (1.f / D) + EPS);
        float ss2 = 0.f;
#pragma unroll
        for (int i = 0; i < 4; ++i) {
            const int c = i * 256 + lane * 4;
            float4 o;
            o.x = xr[i].x + gwm[4 * i] * (yv[4 * i] * rs); o.y = xr[i].y + gwm[4 * i + 1] * (yv[4 * i + 1] * rs); o.z = xr[i].z + gwm[4 * i + 2] * (yv[4 * i + 2] * rs); o.w = xr[i].w + gwm[4 * i + 3] * (yv[4 * i + 3] * rs);
            xv[4 * i] = o.x; xv[4 * i + 1] = o.y; xv[4 * i + 2] = o.z; xv[4 * i + 3] = o.w;
            ss2 += o.x * o.x + o.y * o.y + o.z * o.z + o.w * o.w;
            { uint2 xo; xo.x = pack_bf16x2(o.x, o.y); xo.y = pack_bf16x2(o.z, o.w); *(uint2*)(p.y + (size_t)row * D + c) = xo; }
        }
        ss2 = wave_sum(ss2);
        const float rs2 = rsqrtf(ss2 * (1.f / D) + EPS);
#pragma unroll
        for (int i = 0; i < 4; ++i) {
            const int c = i * 256 + lane * 4;
            uint2 o; o.x = pack_bf16x2(xv[4 * i] * rs2 * wsc[4 * i] + shv[4 * i], xv[4 * i + 1] * rs2 * wsc[4 * i + 1] + shv[4 * i + 1]);
            o.y = pack_bf16x2(xv[4 * i + 2] * rs2 * wsc[4 * i + 2] + shv[4 * i + 2], xv[4 * i + 3] * rs2 * wsc[4 * i + 3] + shv[4 * i + 3]);
            *(uint2*)(p.h2 + (size_t)row * D + c) = o;
        }
#pragma unroll
        for (int i = 0; i < 4; ++i) { yr[i] = yn[i]; xr[i] = xn[i]; }
    }
}

template <int CTRL> DEV float dpp_f(float v) { return __builtin_bit_cast(float, __builtin_amdgcn_update_dpp(0, __builtin_bit_cast(int, v), CTRL, 0xf, 0xf, true)); }
DEV float row16_max(float v) {
    v = fmaxf(v, dpp_f<0xB1>(v)); v = fmaxf(v, dpp_f<0x4E>(v)); v = fmaxf(v, dpp_f<0x141>(v)); v = fmaxf(v, dpp_f<0x140>(v)); return v;
}
DEV float wave_max_uniform(float v) {
    v = row16_max(v);
    const float r0 = __builtin_bit_cast(float, __builtin_amdgcn_readlane(__builtin_bit_cast(int, v), 0)), r1 = __builtin_bit_cast(float, __builtin_amdgcn_readlane(__builtin_bit_cast(int, v), 16));
    const float r2 = __builtin_bit_cast(float, __builtin_amdgcn_readlane(__builtin_bit_cast(int, v), 32)), r3 = __builtin_bit_cast(float, __builtin_amdgcn_readlane(__builtin_bit_cast(int, v), 48));
    return fmaxf(fmaxf(r0, r1), fmaxf(r2, r3));
}
DEV void phase_route(const Params& p) {
    const int tid_ = opaque_tid(), lane = tid_ & 63, gw = blockIdx.x * 8 + (tid_ >> 6), nw = gridDim.x * 8;
    const float4 rb = *(const float4*)(p.rbias + lane * 4);
    float4 lgn = gw < T ? *(const float4*)(p.logits + (size_t)gw * E + lane * 4) : make_float4(0.f, 0.f, 0.f, 0.f);
    int ppos = 0, pek = 0, pslot = -1; float pw = 0.f;
    for (int t = gw; t < T; t += nw) {
        const float4 lg = lgn;
        if (t + nw < T) lgn = *(const float4*)(p.logits + (size_t)(t + nw) * E + lane * 4);
        const float s0 = sigmoidf_(lg.x), s1 = sigmoidf_(lg.y), s2 = sigmoidf_(lg.z), s3 = sigmoidf_(lg.w);
        const float e0 = s0 + rb.x, e1 = s1 + rb.y, e2 = s2 + rb.z, e3 = s3 + rb.w;
        float m1 = fmaxf(fmaxf(e0, e1), fmaxf(e2, e3));
        float m2;
        { const float a = fmaxf(e0, e1), b = fminf(e0, e1), c = fmaxf(e2, e3), d = fminf(e2, e3); m2 = fmaxf(fminf(a, c), fmaxf(b, d)); }
#define RT_MERGE(CTRL) do { const float o1 = dpp_f<CTRL>(m1), o2 = dpp_f<CTRL>(m2); const float n1 = fmaxf(m1, o1), n2 = fmaxf(fminf(m1, o1), fmaxf(m2, o2)); m1 = n1; m2 = n2; } while (0)
        RT_MERGE(0xB1); RT_MERGE(0x4E); RT_MERGE(0x141);
#undef RT_MERGE
        const float gs = m1 + m2; const int g = lane >> 3;
        int rank = 0;
#pragma unroll
        for (int j = 0; j < 8; ++j) { const float gj = __builtin_bit_cast(float, __builtin_amdgcn_readlane(__builtin_bit_cast(int, gs), j * 8)); rank += (gj > gs || (gj == gs && j < g)) ? 1 : 0; }
        const bool gsel = rank < 4;
        float v0 = gsel ? e0 : -INFINITY, v1 = gsel ? e1 : -INFINITY, v2 = gsel ? e2 : -INFINITY, v3 = gsel ? e3 : -INFINITY;
        float wk = 0.f; int ek = 0; float wsum = 0.f;
#pragma unroll 1
        for (int r = 0; r < TOPK; ++r) {
            const float lm = fmaxf(fmaxf(v0, v1), fmaxf(v2, v3));
            const float mx = wave_max_uniform(lm);
            const unsigned long long bal = __ballot(lm == mx);
            const int owner = __builtin_ctzll(bal);
            const int sub = (v0 == mx) ? 0 : (v1 == mx) ? 1 : (v2 == mx) ? 2 : 3;
            const float sv_l = sub == 0 ? s0 : sub == 1 ? s1 : sub == 2 ? s2 : s3;
            const int osub = __builtin_amdgcn_readlane(sub, owner);
            const float sv = __builtin_bit_cast(float, __builtin_amdgcn_readlane(__builtin_bit_cast(int, sv_l), owner));
            if (lane == owner) { if (osub == 0) v0 = -INFINITY; else if (osub == 1) v1 = -INFINITY; else if (osub == 2) v2 = -INFINITY; else v3 = -INFINITY; }
            wsum += sv;
            if (lane == r) { wk = sv; ek = owner * 4 + osub; }
        }
        int pos = 0;
        if (lane < TOPK) pos = (int)atomicAdd(&p.counts[ek << 5], 1u);
        if (lane < TOPK && pslot >= 0) { p.lslot[(size_t)pek * T + ppos] = pslot; p.lw[(size_t)pek * T + ppos] = pw; }
        ppos = pos; pek = ek; pslot = t * TOPK + lane; pw = wk / (wsum + 1e-20f) * 2.5f;
    }
    if (lane < TOPK && pslot >= 0) { p.lslot[(size_t)pek * T + ppos] = pslot; p.lw[(size_t)pek * T + ppos] = pw; }
}

DEV void phase_final(const Params& p) {
    const int tid_ = opaque_tid(), lane = tid_ & 63, gw = blockIdx.x * 8 + (tid_ >> 6), nw = gridDim.x * 8;
    float gwf[16];
#pragma unroll
    for (int i = 0; i < 4; ++i) {
        const int c = i * 256 + lane * 4;
        const float4 g2 = *(const float4*)(p.mod + 5 * D + c), w = *(const float4*)(p.npostf + c);
        gwf[4 * i] = g2.x * w.x; gwf[4 * i + 1] = g2.y * w.y; gwf[4 * i + 2] = g2.z * w.z; gwf[4 * i + 3] = g2.w * w.w;
    }
    uint2 sh[4], xr[4], ys[4][TOPK];
#define FIN_LOAD(r_, SH, XR, YS) do { _Pragma("unroll") for (int i = 0; i < 4; ++i) { const int c = i * 256 + lane * 4; SH[i] = *(const uint2*)(p.shout + (size_t)(r_) * D + c); XR[i] = *(const uint2*)(p.y + (size_t)(r_) * D + c); \
        _Pragma("unroll") for (int k = 0; k < TOPK; ++k) YS[i][k] = *(const uint2*)(p.yslot + ((size_t)(r_) * TOPK + k) * D + c); } } while (0)
    if (gw < T) FIN_LOAD(gw, sh, xr, ys);
    for (int row = gw; row < T; row += nw) {
        const int nrow = row + nw < T ? row + nw : row;
        uint2 shn[4], xrn[4], ysn[4][TOPK];
        FIN_LOAD(nrow, shn, xrn, ysn);
        float mv[16]; float ss = 0.f;
#pragma unroll
        for (int i = 0; i < 4; ++i) {
            float a0 = lo_bf(sh[i].x), a1 = hi_bf(sh[i].x), a2 = lo_bf(sh[i].y), a3 = hi_bf(sh[i].y);
#pragma unroll
            for (int k = 0; k < TOPK; ++k) { const uint2 q = ys[i][k]; a0 += lo_bf(q.x); a1 += hi_bf(q.x); a2 += lo_bf(q.y); a3 += hi_bf(q.y); }
            mv[4 * i] = a0; mv[4 * i + 1] = a1; mv[4 * i + 2] = a2; mv[4 * i + 3] = a3;
            ss += a0 * a0 + a1 * a1 + a2 * a2 + a3 * a3;
        }
        ss = wave_sum(ss);
        const float rs = rsqrtf(ss * (1.f / D) + EPS);
#pragma unroll
        for (int i = 0; i < 4; ++i) {
            const int c = i * 256 + lane * 4;
            float4 o; o.x = lo_bf(xr[i].x); o.y = hi_bf(xr[i].x); o.z = lo_bf(xr[i].y); o.w = hi_bf(xr[i].y);
            o.x += gwf[4 * i] * (mv[4 * i] * rs); o.y += gwf[4 * i + 1] * (mv[4 * i + 1] * rs); o.z += gwf[4 * i + 2] * (mv[4 * i + 2] * rs); o.w += gwf[4 * i + 3] * (mv[4 * i + 3] * rs);
            *(float4*)(p.out + (size_t)row * D + c) = o;
        }
#pragma unroll
        for (int i = 0; i < 4; ++i) { sh[i] = shn[i]; xr[i] = xrn[i];
#pragma unroll
            for (int k = 0; k < TOPK; ++k) ys[i][k] = ysn[i][k]; }
    }
#undef FIN_LOAD
}

DEV bool dense_unit(int r, int nM, int nN, int& pm, int& pn) {
    const int b = blockIdx.x, G = gridDim.x;
    if ((G & 7) == 0 && (nM & 7) == 0) {
        const int per = nM >> 3, nlb = G >> 3, li = r * nlb + (b >> 3);
        if (li >= per * nN) return false;
        pm = (b & 7) * per + li % per; pn = li / per; return true;
    }
    const int u = r * G + b; if (u >= nM * nN) return false;
    pm = u / nN; pn = u % nN; return true;
}
struct DenseSched {
    const char* A; const char* Bt; int K; int nN;
    DEV bool next(int i, g8::Unit& u) const { int pm, pn; if (!dense_unit(i, T / 256, nN, pm, pn)) return false;
        u.A = A + (size_t)pm * 256 * K * 2; u.B = Bt + (size_t)pn * 256 * K * 2; u.i0 = pm; u.i1 = pn; u.i2 = 0; u.i3 = 0; return true; }
    DEV unsigned rowoff(const g8::Unit&, int) const { return 0u; }
};
struct SubSched {
    const char* A; const char* Bt; int K; int nN; int b0;
    DEV bool next(int i, g8::Unit& u) const { const int nb = (int)gridDim.x - b0, v = i * nb + ((int)blockIdx.x - b0); if (v >= 64 * nN) return false; const int pm = v / nN, pn = v % nN;
        u.A = A + (size_t)pm * 256 * K * 2; u.B = Bt + (size_t)pn * 256 * K * 2; u.i0 = pm; u.i1 = pn; u.i2 = 0; u.i3 = 0; return true; }
    DEV unsigned rowoff(const g8::Unit&, int) const { return 0u; }
};

DEV int perm_expert(int j) { return (j & 31) * 8 + (j >> 5); }
DEV void build_pref(const Params& p, char* smem) {
    int* sp = (int*)(smem + LDS_PREF_OFF);
    const int tid = opaque_tid();
    if (tid < 256) { sp[tid + 1] = (int)((p.counts[perm_expert(tid) << 5] + 255u) >> 8); ((int*)(smem + LDS_CNT_OFF))[tid] = (int)p.counts[tid << 5]; }
    if (tid == 0) sp[0] = 0;
    __syncthreads();
    for (int off = 1; off < 256; off <<= 1) {
        int v = 0;
        if (tid < 256 && tid + 1 - off >= 1) v = sp[tid + 1 - off];
        __syncthreads();
        if (tid < 256) sp[tid + 1] += v;
        __syncthreads();
    }
}
template <int NT, int K, bool BYSLOT>
struct ExpSched {
    const int* sp; const unsigned* counts; const int* lslot; const char* A; const char* Bt; size_t bt_estride;
    DEV bool next(int i, g8::Unit& u) const {
        const int G = gridDim.x, b = blockIdx.x;
        int tile, pn, lo, hi;
        if ((G & 7) == 0) { const int xl = b & 7, li = i * (G >> 3) + (b >> 3); pn = li % NT; tile = sp[32 * xl] + li / NT; if (tile >= sp[32 * xl + 32]) return false; lo = 32 * xl; hi = 32 * xl + 32; }
        else { const int li = i * G + b; pn = li % NT; tile = li / NT; if (tile >= sp[256]) return false; lo = 0; hi = 256; }
        while (hi - lo > 1) { const int mid = (lo + hi) >> 1; if (sp[mid] <= tile) lo = mid; else hi = mid; }
        const int e = perm_expert(lo);
        u.A = A; u.B = Bt + (size_t)e * bt_estride + (size_t)pn * 256 * K * 2;
        u.i0 = e; u.i1 = (tile - sp[lo]) * 256; u.i2 = (int)counts[e << 5]; u.i3 = pn; return true;
    }
    DEV unsigned rowoff(const g8::Unit& u, int row) const {
        int rr = u.i1 + row; rr = rr < u.i2 ? rr : u.i2 - 1;
        const int slot = lslot[(size_t)u.i0 * T + rr];
        return (unsigned)(BYSLOT ? slot : (slot >> 3)) * (unsigned)(K * 2);
    }
};


template <int NT, int K, bool BYSLOT>
struct ExpSchedF {
    const int* sp; const unsigned* counts; const int* lslot; const char* A; const float* W0; const float* W1; size_t estride; int colstep; int half1;
    DEV bool next(int i, g8::UnitF& u) const {
        const int G = (int)gridDim.x, b = (int)blockIdx.x, q = (G & 7) == 0 ? (b & 7) * (G >> 3) + (b >> 3) : b;
        const int nitems = sp[256], full = nitems / G;
        int item, pn;
        if (i < full * NT) { item = (i / NT) * G + q; pn = i - (i / NT) * NT; }
        else { const int it = i * G + q; item = it / NT; pn = it - item * NT; }
        if (item >= nitems) return false;
        int lo = 0, hi = 256;
        while (hi - lo > 1) { const int mid = (lo + hi) >> 1; if (sp[mid] <= item) lo = mid; else hi = mid; }
        const int e = perm_expert(lo);
        u.A = A; u.B0 = W0 + (size_t)e * estride + pn * colstep; u.B1 = W1 + (size_t)e * estride + pn * colstep + half1;
        u.i0 = e; u.i1 = (item - sp[lo]) * 256; u.i2 = sp[260 + e]; u.i3 = pn; return true;
    }
    DEV unsigned rowoff(const g8::UnitF& u, int row) const {
        int rr = u.i1 + row; rr = rr < u.i2 ? rr : u.i2 - 1;
        const int slot = lslot[(size_t)u.i0 * T + rr];
        return (unsigned)(BYSLOT ? slot : (slot >> 3)) * (unsigned)(K * 2);
    }
};


struct PEpiStoreBf16 { bf16_t* C; int ldc; int row0; int col0;
    DEV void operator()(int r, int c, f32x4 v0, f32x4 v1) const { uint4 o; o.x = pack_bf16x2(v0[0], v0[1]); o.y = pack_bf16x2(v0[2], v0[3]); o.z = pack_bf16x2(v1[0], v1[1]); o.w = pack_bf16x2(v1[2], v1[3]);
        *(uint4*)(C + (size_t)(row0 + r) * ldc + col0 + c) = o; } };
struct PEpiProj { bf16_t* C; size_t gstride; int ldc; int row0;
    DEV void operator()(int r, int c, f32x4 v0, f32x4 v1) const { uint4 o; o.x = pack_bf16x2(v0[0], v0[1]); o.y = pack_bf16x2(v0[2], v0[3]); o.z = pack_bf16x2(v1[0], v1[1]); o.w = pack_bf16x2(v1[2], v1[3]);
        *(uint4*)(C + (size_t)(c >> 7) * gstride + (size_t)(row0 + r) * ldc + (c & 127)) = o; } };
struct PEpiGateA { bf16_t* M; const bf16_t* proj; int row0; int col0;
    DEV void operator()(int r, int c, f32x4 v0, f32x4 v1) const { const size_t row = row0 + r; const uint4 gr = *(const uint4*)(proj + row * NP + OFF_GA + col0 + c);
        uint4 o; o.x = pack_bf16x2(sigmoidf_(lo_bf(gr.x)) * v0[0], sigmoidf_(hi_bf(gr.x)) * v0[1]); o.y = pack_bf16x2(sigmoidf_(lo_bf(gr.y)) * v0[2], sigmoidf_(hi_bf(gr.y)) * v0[3]);
        o.z = pack_bf16x2(sigmoidf_(lo_bf(gr.z)) * v1[0], sigmoidf_(hi_bf(gr.z)) * v1[1]); o.w = pack_bf16x2(sigmoidf_(lo_bf(gr.w)) * v1[2], sigmoidf_(hi_bf(gr.w)) * v1[3]);
        *(uint4*)(M + row * D + col0 + c) = o; } };
struct PEpiGateB { bf16_t* M; const bf16_t* proj; int row0; int col0;
    DEV void operator()(int r, int c, f32x4 v0, f32x4 v1) const { const size_t row = row0 + r; const uint4 gr = *(const uint4*)(proj + row * NP + OFF_GB + col0 + c); const uint4 mo = *(const uint4*)(M + row * D + col0 + c);
        uint4 o; o.x = pack_bf16x2(lo_bf(mo.x) + sigmoidf_(lo_bf(gr.x)) * v0[0], hi_bf(mo.x) + sigmoidf_(hi_bf(gr.x)) * v0[1]); o.y = pack_bf16x2(lo_bf(mo.y) + sigmoidf_(lo_bf(gr.y)) * v0[2], hi_bf(mo.y) + sigmoidf_(hi_bf(gr.y)) * v0[3]);
        o.z = pack_bf16x2(lo_bf(mo.z) + sigmoidf_(lo_bf(gr.z)) * v1[0], hi_bf(mo.z) + sigmoidf_(hi_bf(gr.z)) * v1[1]); o.w = pack_bf16x2(lo_bf(mo.w) + sigmoidf_(lo_bf(gr.w)) * v1[2], hi_bf(mo.w) + sigmoidf_(hi_bf(gr.w)) * v1[3]);
        *(uint4*)(M + row * D + col0 + c) = o; } };

struct HEpiSwiGLUSlot {
    bf16_t* act; const int* lslot; int base; int cnt; int r0; int col0;
    DEV void apply(const f32x4 (&acc)[2][2][4][2], int wr, int wc, int fr, int fq) const {
        int sl[2][4];
#pragma unroll
        for (int ai = 0; ai < 2; ++ai)
#pragma unroll
            for (int m = 0; m < 4; ++m) { int rr = r0 + 128 * ai + 64 * wr + 16 * m + fr; rr = rr < cnt ? rr : cnt - 1; sl[ai][m] = lslot[base + rr]; }
#pragma unroll
        for (int ai = 0; ai < 2; ++ai)
#pragma unroll
            for (int m = 0; m < 4; ++m) asm volatile("" : "+v"(sl[ai][m]));
#pragma unroll
        for (int ai = 0; ai < 2; ++ai)
#pragma unroll
            for (int m = 0; m < 4; ++m) { const int rr = r0 + 128 * ai + 64 * wr + 16 * m + fr; if (rr < cnt) {
                const f32x4 g0 = acc[ai][0][m][0], u0 = acc[ai][1][m][0], g1 = acc[ai][0][m][1], u1 = acc[ai][1][m][1];
                uint4 o; o.x = pack_bf16x2(siluf_(g0[0]) * u0[0], siluf_(g0[1]) * u0[1]); o.y = pack_bf16x2(siluf_(g0[2]) * u0[2], siluf_(g0[3]) * u0[3]);
                o.z = pack_bf16x2(siluf_(g1[0]) * u1[0], siluf_(g1[1]) * u1[1]); o.w = pack_bf16x2(siluf_(g1[2]) * u1[2], siluf_(g1[3]) * u1[3]);
                *(uint4*)(act + (size_t)sl[ai][m] * FF + col0 + 32 * wc + 8 * fq) = o; } } } };
struct HEpiSlot {
    bf16_t* yslot; const int* lslot; const float* lw; int base; int cnt; int r0; int col0;
    DEV void apply(const f32x4 (&acc)[2][2][4][2], int wr, int wc, int fr, int fq) const {
        int sl[2][4]; float wv[2][4];
#pragma unroll
        for (int ai = 0; ai < 2; ++ai)
#pragma unroll
            for (int m = 0; m < 4; ++m) { int rr = r0 + 128 * ai + 64 * wr + 16 * m + fr; rr = rr < cnt ? rr : cnt - 1; sl[ai][m] = lslot[base + rr]; wv[ai][m] = lw[base + rr]; }
#pragma unroll
        for (int ai = 0; ai < 2; ++ai)
#pragma unroll
            for (int m = 0; m < 4; ++m) asm volatile("" : "+v"(sl[ai][m]), "+v"(wv[ai][m]));
#pragma unroll
        for (int ai = 0; ai < 2; ++ai)
#pragma unroll
            for (int m = 0; m < 4; ++m) { const int rr = r0 + 128 * ai + 64 * wr + 16 * m + fr; if (rr < cnt) { const float w = wv[ai][m]; bf16_t* rowp = yslot + (size_t)sl[ai][m] * D + col0 + 32 * wc + 8 * fq;
#pragma unroll
                for (int bj = 0; bj < 2; ++bj) { const f32x4 v0 = acc[ai][bj][m][0], v1 = acc[ai][bj][m][1];
                    uint4 o; o.x = pack_bf16x2(w * v0[0], w * v0[1]); o.y = pack_bf16x2(w * v0[2], w * v0[3]); o.z = pack_bf16x2(w * v1[0], w * v1[1]); o.w = pack_bf16x2(w * v1[2], w * v1[3]);
                    *(uint4*)(rowp + 128 * bj) = o; } } } } };

struct FEpiP9 { float* logits; bf16_t* acts; int row0; int pn;
    DEV void operator()(int r, int c, f32x4 v0, f32x4 v1) const {
        if (pn == 0) { float* q = logits + (size_t)(row0 + r) * E + c; *(f32x4*)q = v0; *(f32x4*)(q + 16) = v1; }
        else { uint2 o; o.x = pack_bf16x2(siluf_(v0[0]) * v1[0], siluf_(v0[1]) * v1[1]); o.y = pack_bf16x2(siluf_(v0[2]) * v1[2], siluf_(v0[3]) * v1[3]);
               *(uint2*)(acts + (size_t)(row0 + r) * FF + (pn - 1) * 128 + (c >> 5) * 16 + (c & 15)) = o; } } };

DEV void cvt_tile(const float* src, bf16_t* dst, int ld, int dstK, int pair, int k0, int n0, int lane) {
    const int nq = lane & 15, kq = lane >> 4;
    const float* sp_ = src + (size_t)(k0 + 8 * kq) * ld + n0 + 4 * nq;
    float4 v[8];
#pragma unroll
    for (int r = 0; r < 8; ++r) v[r] = *(const float4*)(sp_ + (size_t)r * ld);
#pragma unroll
    for (int q = 0; q < 4; ++q) {
        const int n = n0 + 4 * nq + q;
        const int c32 = n & 31;
        const int row = pair == 3 ? ((n & ~31) + ((c32 >> 2) & 1) * 16 + (c32 >> 3) * 4 + (c32 & 3)) : pair ? (((n >> 4) * 2 + (pair - 1)) * 16 + (n & 15)) : n;
        float e[8];
#pragma unroll
        for (int r = 0; r < 8; ++r) e[r] = q == 0 ? v[r].x : q == 1 ? v[r].y : q == 2 ? v[r].z : v[r].w;
        uint4 o; o.x = pack_bf16x2(e[0], e[1]); o.y = pack_bf16x2(e[2], e[3]); o.z = pack_bf16x2(e[4], e[5]); o.w = pack_bf16x2(e[6], e[7]);
        *(uint4*)(dst + (size_t)row * dstK + k0 + 8 * kq) = o;
    }
}
DEV void phase_convert(const Params& p) {
    const int tid_ = opaque_tid(), lane = tid_ & 63, gw = blockIdx.x * 8 + (tid_ >> 6), nw = gridDim.x * 8;
    constexpr int R0 = 2816, R1 = R0 + 256, R2 = R1 + 256, R3 = R2 + 512, R4 = R3 + 128, R5 = R4 + 128, R6 = R5 + 128, R7 = R6 + 128, R8 = R7 + 32768, R9 = R8 + 32768, R10 = R9 + 32768;
    for (int t = gw; t < R7; t += nw) {
        const float* src; bf16_t* dst; int K, N, pair, loc;
        if (t < R0) { src = p.w_in; dst = p.WinT; K = 1024; N = NIN; pair = 3; loc = t; }
        else if (t < R1) { src = p.w_conv_out; dst = p.WcoT; K = 512; N = D; pair = 3; loc = t - R0; }
        else if (t < R2) { src = p.w_hgrn_out; dst = p.WhoT; K = 512; N = D; pair = 3; loc = t - R1; }
        else if (t < R3) { src = p.w_o; dst = p.WoT; K = 1024; N = D; pair = 3; loc = t - R2; }
        else if (t < R4) { src = p.w_router; dst = p.WrsT; K = 1024; N = E; pair = 0; loc = t - R3; }
        else if (t < R5) { src = p.wgs; dst = p.WrsT + (size_t)256 * 1024; K = 1024; N = FF; pair = 1; loc = t - R4; }
        else if (t < R6) { src = p.wus; dst = p.WrsT + (size_t)256 * 1024; K = 1024; N = FF; pair = 2; loc = t - R5; }
        else if (t < R7) { src = p.wds; dst = p.WdsT; K = 256; N = D; pair = 3; loc = t - R6; }
        else if (t < R8) { const int l = t - R7, e = l >> 7; src = p.wge + (size_t)e * D * FF; dst = p.WgeuT + (size_t)e * 512 * 1024; K = 1024; N = FF; pair = 1; loc = l & 127; }
        else if (t < R9) { const int l = t - R8, e = l >> 7; src = p.wue + (size_t)e * D * FF; dst = p.WgeuT + (size_t)e * 512 * 1024; K = 1024; N = FF; pair = 2; loc = l & 127; }
        else { const int l = t - R9, e = l >> 7; src = p.wde + (size_t)e * FF * D; dst = p.WdeT + (size_t)e * 1024 * 256; K = 256; N = D; pair = 0; loc = l & 127; }
        const int nnt = N >> 6, kt = loc / nnt, ntile = loc % nnt;
        cvt_tile(src, dst, N, K, pair, kt * 32, ntile * 64, lane);
    }
}

__global__ void __launch_bounds__(512, 2) k_mega(Params p) {
    extern __shared__ __attribute__((aligned(16))) char smem[];
    volatile LAS unsigned* st = (volatile LAS unsigned*)(smem + LDS_BAR_OFF);
    LAS unsigned char* lds = (LAS unsigned char*)smem;
    if (threadIdx.x == 0) { st[0] = 0u; st[1] = 0u; st[2] = 0u; st[3] = 0u; }
    __syncthreads();
    const XcdBarrier bar = xcd_barrier_post(p.bar, st);

    phase_mod(p, smem);
    phase_convert(p);
    xcd_barrier(bar);
    phase_norm1(p);
    xcd_barrier(bar);
    g8::gemm_stream<false, true>(lds, D, DenseSched{(const char*)p.h1, (const char*)p.WinT, D, NIN / 256},
        [&](const g8::Unit& u) { const int col0 = u.i1 * 256; const bool hx = col0 >= 1536 && col0 < 3584;
            const size_t off = hx ? (size_t)T * NP + (size_t)((col0 - 1536) >> 7) * T * 128 : (size_t)(col0 < 1536 ? col0 : col0 - 2048);
            return PEpiProj{p.proj + off, hx ? (size_t)T * 128 : (size_t)128, hx ? 128 : NP, u.i0 * 256}; });
    xcd_barrier(bar);
    phase_conv(p);
    for (int u = blockIdx.x; u < 1024; u += gridDim.x) hgrn_phase1(smem, p.proj + (size_t)T * NP, p.lbt, p.kcT, p.dec, u >> 2, u & 3);
    xcd_barrier(bar);
    {
        const int tsc = opaque_tid();
        if (tsc < 256) for (int e = blockIdx.x * 256 + tsc; e < 65536; e += gridDim.x * 256) hgrn_phase2(p.kcT, p.dec, p.ST, e);
        g8::gemm_stream<false, true>(lds, 512, DenseSched{(const char*)p.a1, (const char*)p.WcoT, 512, D / 256},
            [&](const g8::Unit& u) { return PEpiGateA{p.m, p.proj, u.i0 * 256, u.i1 * 256}; });
    }
    xcd_barrier(bar);
    for (int u = blockIdx.x; u < 1024; u += gridDim.x) hgrn_phase3(smem, p.proj + (size_t)T * NP, p.lbt, p.ST, p.hnw, p.ob, u >> 2, u & 3);
    xcd_barrier(bar);
    g8::gemm_stream<false, true>(lds, 512, DenseSched{(const char*)p.ob, (const char*)p.WhoT, 512, D / 256},
        [&](const g8::Unit& u) { return PEpiGateB{p.m, p.proj, u.i0 * 256, u.i1 * 256}; });
    xcd_barrier(bar);
    g8::gemm_stream<false, true>(lds, D, DenseSched{(const char*)p.m, (const char*)p.WoT, D, D / 256},
        [&](const g8::Unit& u) { return PEpiStoreBf16{p.y, D, u.i0 * 256, u.i1 * 256}; });
    xcd_barrier(bar);
    phase_mid(p);
    xcd_barrier(bar);
    g8::gemm_stream<false, false>(lds, D, DenseSched{(const char*)p.h2, (const char*)p.WrsT, D, 3},
        [&](const g8::Unit& u) { return FEpiP9{p.logits, p.acts, u.i0 * 256, u.i1}; });
    xcd_barrier(bar);
    phase_route(p);
    g8::gemm_stream<false, true>(lds, FF, DenseSched{(const char*)p.acts, (const char*)p.WdsT, FF, D / 256},
        [&](const g8::Unit& u) { return PEpiStoreBf16{p.shout, D, u.i0 * 256, u.i1 * 256}; });
    xcd_barrier(bar);
    build_pref(p, smem);
    g8::gemm_stream_fb<true>(lds, D, FF, ExpSchedF<2, D, false>{(const int*)(smem + LDS_PREF_OFF), p.counts, p.lslot, (const char*)p.h2, p.wge, p.wue, (size_t)D * FF, 128, 0},
        [&](const g8::UnitF& u) { return HEpiSwiGLUSlot{p.act, p.lslot, u.i0 * T, u.i2, u.i1, u.i3 * 128}; });
    xcd_barrier(bar);
    g8::gemm_stream_fb<true>(lds, FF, D, ExpSchedF<4, FF, true>{(const int*)(smem + LDS_PREF_OFF), p.counts, p.lslot, (const char*)p.act, p.wde, p.wde, (size_t)FF * D, 256, 128},
        [&](const g8::UnitF& u) { return HEpiSlot{p.yslot, p.lslot, p.lw, u.i0 * T, u.i2, u.i1, u.i3 * 256}; });
    xcd_barrier(bar);
    phase_final(p);
}

extern "C" void kernel_launch(void* const* d_in, const int* in_sizes, int n_in, void* d_out, int out_size, void* d_ws, size_t ws_size, hipStream_t stream) {
    Params p; memset(&p, 0, sizeof(p));
    p.x = (const float*)d_in[0]; p.c = (const float*)d_in[1]; p.w_ada = (const float*)d_in[2]; p.b_ada = (const float*)d_in[3];
    p.npm = (const float*)d_in[4]; p.npostm = (const float*)d_in[5]; p.w_in = (const float*)d_in[6]; p.conv_w = (const float*)d_in[7];
    p.w_conv_out = (const float*)d_in[8]; p.lbt = (const float*)d_in[9]; p.hnw = (const float*)d_in[10]; p.w_hgrn_out = (const float*)d_in[11];
    p.w_o = (const float*)d_in[12]; p.npf = (const float*)d_in[13]; p.npostf = (const float*)d_in[14]; p.w_router = (const float*)d_in[15];
    p.rbias = (const float*)d_in[16]; p.wge = (const float*)d_in[17]; p.wue = (const float*)d_in[18]; p.wde = (const float*)d_in[19];
    p.wgs = (const float*)d_in[20]; p.wus = (const float*)d_in[21]; p.wds = (const float*)d_in[22];
    p.out = (float*)d_out;
    char* base = (char*)d_ws; size_t off = 0;
    auto take = [&](size_t bytes) { char* r = base + off; off += (bytes + 255) & ~(size_t)255; return r; };
    char* ctrl = take(65536);
    p.bar = (unsigned*)ctrl; p.counts = (unsigned*)(ctrl + 16384);
    p.mod = (float*)take(6 * D * 4);
    p.WinT = (bf16_t*)take((size_t)NIN * D * 2);
    p.WcoT = (bf16_t*)take((size_t)D * 512 * 2);
    p.WhoT = (bf16_t*)take((size_t)D * 512 * 2);
    p.WoT = (bf16_t*)take((size_t)D * D * 2);
    p.WrsT = (bf16_t*)take((size_t)768 * D * 2);
    p.WdsT = (bf16_t*)take((size_t)D * FF * 2);
    p.WgeuT = (bf16_t*)take((size_t)E * 512 * D * 2);
    p.WdeT = (bf16_t*)take((size_t)E * D * FF * 2);
    char* r1 = take((size_t)T * NIN * 2 + (size_t)256 * 65536 * 4 + (size_t)256 * 65536 * 2);
    p.proj = (bf16_t*)r1; p.kcT = (float*)(r1 + (size_t)T * NIN * 2); p.ST = (bf16_t*)(r1 + (size_t)T * NIN * 2 + (size_t)256 * 65536 * 4);
    p.yslot = (bf16_t*)r1;
    p.dec = (float*)take((size_t)256 * 512 * 4);
    char* r2 = take((size_t)3 * T * D * 2);
    p.h1 = (bf16_t*)r2; p.m = (bf16_t*)(r2 + (size_t)T * D * 2); p.y = (bf16_t*)(r2 + (size_t)2 * T * D * 2);
    p.act = (bf16_t*)r2;
    p.a1 = (bf16_t*)take((size_t)T * 512 * 2);
    p.ob = (bf16_t*)take((size_t)T * 512 * 2);
    p.h2 = (bf16_t*)take((size_t)T * D * 2);
    p.logits = (float*)take((size_t)T * E * 4);
    p.lslot = (int*)take((size_t)E * T * 4);
    p.lw = (float*)take((size_t)E * T * 4);
    p.acts = (bf16_t*)take((size_t)T * FF * 2);
    p.shout = (bf16_t*)take((size_t)T * D * 2);

    static int grid = 0;
    if (!grid) {
        (void)hipFuncSetAttribute((const void*)k_mega, hipFuncAttributeMaxDynamicSharedMemorySize, LDS_TOTAL);
        int dev = 0, cus = 0, per_cu = 0;
        (void)hipGetDevice(&dev);
        (void)hipDeviceGetAttribute(&cus, hipDeviceAttributeMultiprocessorCount, dev);
        (void)hipOccupancyMaxActiveBlocksPerMultiprocessor(&per_cu, (const void*)k_mega, 512, LDS_TOTAL);
        if (cus <= 0) cus = 256;
        grid = cus * (per_cu < 1 ? per_cu : 1);
        if (grid <= 0) grid = cus;
    }
    (void)hipMemsetAsync(ctrl, 0, 65536, stream);
    k_mega<<<grid, 512, LDS_TOTAL, stream>>>(p);
}
```

```cpp
#include <hip/hip_runtime.h>
#include <stdint.h>
#include <string.h>
#include <stddef.h>

typedef unsigned short bf16_t;
#define DEV __device__ __forceinline__

constexpr int T = 16384, D = 1024, NIN = 5632, E = 256, FF = 256, TOPK = 8;
constexpr int NP = 3584, OFF_CB = 0, OFF_CC = 512, OFF_CX = 1024, OFF_GA = 1536, OFF_GB = 2560, HX_Q = 0, HX_F = 1, HX_I = 2, HX_G = 3;
constexpr float EPS = 1e-6f;

DEV float bf2f(bf16_t v) { return __uint_as_float(((unsigned)v) << 16); }
DEV bf16_t f2bf(float f) { unsigned u = __float_as_uint(f); u += 0x7FFFu + ((u >> 16) & 1u); return (bf16_t)(u >> 16); }
DEV float sigmoidf_(float x) { return __builtin_amdgcn_rcpf(1.f + __expf(-x)); }
DEV float siluf_(float x) { return x * __builtin_amdgcn_rcpf(1.f + __expf(-x)); }
typedef unsigned wt_u4 __attribute__((ext_vector_type(4)));
DEV void st16_wt(void* q, uint4 v) { const wt_u4 w = {v.x, v.y, v.z, v.w}; asm volatile("global_store_dwordx4 %0, %1, off sc1\n\ts_nop 1" :: "v"(q), "v"(w) : "memory"); }
template <int CTRL> DEV float dpp_add_(float v) { return v + __builtin_bit_cast(float, __builtin_amdgcn_update_dpp(0, __builtin_bit_cast(int, v), CTRL, 0xf, 0xf, true)); }
DEV float wave_sum(float v) {
    v = dpp_add_<0xB1>(v); v = dpp_add_<0x4E>(v); v = dpp_add_<0x141>(v); v = dpp_add_<0x140>(v);
    const float r0 = __builtin_bit_cast(float, __builtin_amdgcn_readlane(__builtin_bit_cast(int, v), 0)), r1 = __builtin_bit_cast(float, __builtin_amdgcn_readlane(__builtin_bit_cast(int, v), 16));
    const float r2 = __builtin_bit_cast(float, __builtin_amdgcn_readlane(__builtin_bit_cast(int, v), 32)), r3 = __builtin_bit_cast(float, __builtin_amdgcn_readlane(__builtin_bit_cast(int, v), 48));
    return (r0 + r1) + (r2 + r3);
}
DEV int opaque_tid() { int t = threadIdx.x; asm volatile("" : "+v"(t)); return t; }
DEV float lo_bf(unsigned u) { return __uint_as_float(u << 16); }
DEV float hi_bf(unsigned u) { return __uint_as_float(u & 0xffff0000u); }

#define XB_TMO      128
#define XB_XCNT(j)  (256  + 64 * (j))
#define XB_XSUB(j)  (1280 + 64 * (j))
#define XB_XGEN(j)  (2304 + 64 * (j))
#define XB_TOP      3328
#define XB_TOPGEN   3392
#define XCD_BAR_WORDS 3456
#define XB_SPIN_CAP (1u << 18)
#define LAS __attribute__((address_space(3)))
__device__ __forceinline__ unsigned xb_ld(unsigned* p)              { return __hip_atomic_load(p, __ATOMIC_RELAXED, __HIP_MEMORY_SCOPE_AGENT); }
__device__ __forceinline__ unsigned xb_add(unsigned* p, unsigned v) { return __hip_atomic_fetch_add(p, v, __ATOMIC_RELAXED, __HIP_MEMORY_SCOPE_AGENT); }
__device__ __forceinline__ unsigned xb_xcc_id() { return (unsigned)__builtin_amdgcn_s_getreg((3 << 11) | 20) & 0xFu; }
#define XB_SPIN(cond, bar) do { unsigned _sp = 0; while (cond) { __builtin_amdgcn_s_sleep(1); \
    if ((++_sp & 255u) == 0u) { if (xb_ld(&(bar)[XB_TMO])) break; if (_sp > XB_SPIN_CAP) { atomicAdd(&(bar)[XB_TMO], 1u); break; } } } } while (0)
struct XcdBarrier { unsigned* bar; unsigned x; volatile LAS unsigned* st; };
__device__ __forceinline__ XcdBarrier xcd_barrier_post(unsigned* bar, volatile LAS unsigned* st) {
    XcdBarrier b; b.bar = bar; b.x = xb_xcc_id(); b.st = st;
    if (threadIdx.x == 0) (void)xb_add(&bar[XB_XCNT(b.x)], 1u);
    return b;
}
__device__ __forceinline__ void xcd_barrier_complete(unsigned* bar, unsigned x, unsigned& nloc, unsigned& nx) {
    const unsigned G = gridDim.x * gridDim.y * gridDim.z;
    unsigned sum, cnt, mine, sp = 0u;
    for (;;) {
        sum = 0u; cnt = 0u; mine = 0u;
#pragma unroll
        for (unsigned j = 0; j < 16; ++j) { const unsigned c = xb_ld(&bar[XB_XCNT(j)]); sum += c; cnt += (c > 0u) ? 1u : 0u; mine = (j == x) ? c : mine; }
        if (sum == G) break;
        __builtin_amdgcn_s_sleep(1);
        if ((++sp & 255u) == 0u) { if (xb_ld(&bar[XB_TMO])) break; if (sp > XB_SPIN_CAP) { atomicAdd(&bar[XB_TMO], 1u); break; } }
    }
    nloc = mine > 0u ? mine : 1u; nx = cnt > 0u ? cnt : 1u;
}
__device__ __forceinline__ void xcd_barrier(const XcdBarrier& b) {
    asm volatile("s_waitcnt vmcnt(0)" ::: "memory");
    __syncthreads();
    if (threadIdx.x == 0) {
        unsigned* bar = b.bar;
        __builtin_amdgcn_s_waitcnt(0);
        unsigned nloc = b.st[0], nx = b.st[1];
        if (nloc == 0u) { xcd_barrier_complete(bar, b.x, nloc, nx); b.st[0] = nloc; b.st[1] = nx; }
        const unsigned old = xb_add(&bar[XB_XSUB(b.x)], 1u);
        const unsigned gen = old / nloc;
        if (old + 1u == (gen + 1u) * nloc) {
            __builtin_amdgcn_fence(__ATOMIC_RELEASE, "agent");
            asm volatile("s_waitcnt vmcnt(0)" ::: "memory");
            const unsigned og = xb_add(&bar[XB_TOP], 1u);
            const unsigned tg = og / nx;
            if (og + 1u == (tg + 1u) * nx) xb_add(&bar[XB_TOPGEN], 1u);
            else XB_SPIN(xb_ld(&bar[XB_TOPGEN]) == tg, bar);
            __builtin_amdgcn_fence(__ATOMIC_ACQUIRE, "agent");
            xb_add(&bar[XB_XGEN(b.x)], 1u);
            asm volatile("s_waitcnt vmcnt(0)" ::: "memory");
        } else {
            XB_SPIN(xb_ld(&bar[XB_XGEN(b.x)]) == gen, bar);
            __builtin_amdgcn_fence(__ATOMIC_ACQUIRE, "agent");
            asm volatile("s_waitcnt vmcnt(0)" ::: "memory");
        }
    }
    __syncthreads();
}

struct Params {
    const float *x, *c, *w_ada, *b_ada, *npm, *npostm, *w_in, *conv_w, *w_conv_out, *lbt, *hnw, *w_hgrn_out, *w_o, *npf, *npostf, *w_router, *rbias, *wge, *wue, *wde, *wgs, *wus, *wds;
    float* out;
    unsigned* bar;
    unsigned* counts;
    bf16_t *WinT, *WcoT, *WhoT, *WoT, *WrsT, *WdsT, *WgeuT, *WdeT;
    float* mod;
    bf16_t* h1;
    bf16_t* proj;
    float* kcT;
    float* dec;
    bf16_t* ST;
    bf16_t* a1;
    bf16_t* ob;
    bf16_t* m;
    bf16_t* y;
    bf16_t* h2;
    float* logits;
    int* lslot;
    float* lw;
    bf16_t* act;
    bf16_t* yslot;
    bf16_t* acts;
    bf16_t* shout;
};
typedef short bf16x8 __attribute__((ext_vector_type(8)));
typedef float f32x4 __attribute__((ext_vector_type(4)));
typedef short s16x4 __attribute__((ext_vector_type(4)));
typedef unsigned u32x2_t __attribute__((ext_vector_type(2)));
constexpr int GEMM_LDS_BYTES = 131072;
typedef __bf16 hwbf16x2 __attribute__((ext_vector_type(2)));
DEV unsigned pack_bf16x2(float lo, float hi) { hwbf16x2 v = {(__bf16)lo, (__bf16)hi}; return __builtin_bit_cast(unsigned, v); }

DEV const float* rfl_ptr(const float* p) { const unsigned long long v = (unsigned long long)p; const unsigned lo = (unsigned)__builtin_amdgcn_readfirstlane((int)(unsigned)v), hi = (unsigned)__builtin_amdgcn_readfirstlane((int)(unsigned)(v >> 32)); return (const float*)(((unsigned long long)hi << 32) | lo); }
namespace g8 {
constexpr int BK = 64, HALF = 128, HTB = HALF * BK * 2;
DEV int lds_byte(int r, int c) { const int st = (r >> 4) * 2 + (c >> 5), rr = r & 15, cc = c & 31, ob = rr * 64 + cc * 2; return st * 1024 + (ob ^ (((ob >> 9) & 1) << 5)); }
DEV void stage_rc(int b, int& R, int& C) { const int st = b / 1024, sb = b % 1024, swz = sb ^ (((sb >> 9) & 1) << 5); R = (st >> 1) * 16 + swz / 64; C = (st & 1) * 32 + (swz % 64) / 2; }

struct Unit { const char* A; const char* B; int i0, i1, i2, i3; };

struct NoMid { static constexpr bool on = false; };
template <class T, class = void> struct has_pre { static constexpr bool value = false; };
template <class T> struct has_pre<T, decltype((void)T::pre)> { static constexpr bool value = true; };
template <bool GATHER, bool PERM, class Sched, class EpiF, class MidF = NoMid>
DEV void gemm_stream(LAS unsigned char* lds, const int K, const Sched& S, const EpiF& EF, const MidF& MF = MidF()) {
    const int tid = opaque_tid(), wid = __builtin_amdgcn_readfirstlane(tid >> 6), lane = tid & 63, wr = wid >> 2, wc = wid & 3, fr = lane & 15, fq = lane >> 4;
    const int nt = K / BK;
    int Rr[2], Cc[2];
    unsigned voffB[2];
#pragma unroll
    for (int i = 0; i < 2; ++i) { stage_rc(tid * 16 + i * 8192, Rr[i], Cc[i]); voffB[i] = (unsigned)(Rr[i] * K + Cc[i]) * 2u; }
    const size_t kstep = (size_t)(BK * 2);
    const size_t hstepB = (size_t)HALF * K * 2;
    const size_t hstepA = GATHER ? 0 : hstepB;
    const unsigned ldsw = (unsigned)wid * 1024u;
    const int aoff = lds_byte(wr * 64 + fr, fq * 8), boff = lds_byte(wc * 32 + fr, fq * 8);
#define G8_SA(b, h) (((b) * 2 + (h)) * HTB)
#define G8_SB(b, h) ((4 + (b) * 2 + (h)) * HTB)
#define G8_STAGE(bufoff, gbase, v0_, v1_) do { \
        __builtin_amdgcn_global_load_lds((const unsigned*)((const char*)(gbase) + (v0_)), (LAS unsigned*)(lds + (bufoff) + ldsw), 16, 0, 0); \
        __builtin_amdgcn_global_load_lds((const unsigned*)((const char*)(gbase) + (v1_)), (LAS unsigned*)(lds + (bufoff) + ldsw + 8192), 16, 0, 0); } while (0)
#define G8_STAGE_B(b, h, gbase) G8_STAGE(G8_SB(b, h), gbase, voffB[0], voffB[1])
#define G8_STAGE_A(b, h, gbase, VA) G8_STAGE(G8_SA(b, h), gbase, VA[h][0], VA[h][1])
#define G8_LDA(dst, b, h) do { _Pragma("unroll") for (int m = 0; m < 4; ++m) _Pragma("unroll") for (int k = 0; k < 2; ++k) dst[m][k] = *(const LAS bf16x8*)(lds + G8_SA(b, h) + aoff + m * 2048 + k * 1024); } while (0)
#define G8_LDB(dst, b, h) do { _Pragma("unroll") for (int n = 0; n < 2; ++n) _Pragma("unroll") for (int k = 0; k < 2; ++k) dst[n][k] = *(const LAS bf16x8*)(lds + G8_SB(b, h) + boff + n * 2048 + k * 1024); } while (0)
#define G8_MMA(ai, bj, At, Bt) do { __builtin_amdgcn_s_setprio(1); _Pragma("unroll") for (int m = 0; m < 4; ++m) _Pragma("unroll") for (int n = 0; n < 2; ++n) _Pragma("unroll") for (int k = 0; k < 2; ++k) \
        acc[ai][bj][m][n] = __builtin_amdgcn_mfma_f32_16x16x32_bf16(Bt[n][k], At[m][k], acc[ai][bj][m][n], 0, 0, 0); __builtin_amdgcn_s_setprio(0); } while (0)
#define G8_WAIT_V(n) asm volatile("s_waitcnt vmcnt(" #n ")" ::: "memory")
#define G8_WAIT_L(n) asm volatile("s_waitcnt lgkmcnt(" #n ")" ::: "memory")
#define G8_BAR __builtin_amdgcn_s_barrier()
#define G8_SCHED __builtin_amdgcn_sched_barrier(0)
#define G8_VOFF(VA, u) do { _Pragma("unroll") for (int h_ = 0; h_ < 2; ++h_) _Pragma("unroll") for (int i_ = 0; i_ < 2; ++i_) \
        VA[h_][i_] = GATHER ? (S.rowoff(u, Rr[i_] + 128 * h_) + (unsigned)Cc[i_] * 2u) : (unsigned)(Rr[i_] * K + Cc[i_]) * 2u; } while (0)
    Unit cur, nxt; int ui = 0;
    if (!S.next(0, cur)) return;
    f32x4 acc[2][2][4][2];
#pragma unroll
    for (int a_ = 0; a_ < 2; ++a_)
#pragma unroll
        for (int b_ = 0; b_ < 2; ++b_)
#pragma unroll
            for (int m = 0; m < 4; ++m)
#pragma unroll
                for (int n = 0; n < 2; ++n) acc[a_][b_][m][n] = (f32x4){0.f, 0.f, 0.f, 0.f};
    bf16x8 At[4][2], B0[2][2], B1[2][2];
    unsigned vAc[2][2], vAn[2][2];
    G8_VOFF(vAc, cur);
#pragma unroll
    for (int h_ = 0; h_ < 2; ++h_)
#pragma unroll
        for (int i_ = 0; i_ < 2; ++i_) vAn[h_][i_] = vAc[h_][i_];
    const char* cA = cur.A; const char* cB = cur.B;
    G8_STAGE_B(0, 0, cB); G8_STAGE_A(0, 0, cA, vAc); G8_STAGE_B(0, 1, cB + hstepB); G8_STAGE_A(0, 1, cA + hstepA, vAc);
    if (wr == 1) G8_BAR;
    G8_WAIT_V(4); G8_BAR;
    G8_STAGE_B(1, 0, cB + kstep); G8_STAGE_A(1, 0, cA + kstep, vAc); G8_STAGE_B(1, 1, cB + hstepB + kstep);
    G8_WAIT_V(6); G8_BAR;
    for (;;) {
        const bool has_next = S.next(ui + 1, nxt);
        const char* nA = has_next ? nxt.A : cA; const char* nB = has_next ? nxt.B : cB;
#pragma unroll 1
        for (int t = 0; t < nt; t += 2) {
            const bool last = (t == nt - 2);
            const char* a1 = cA + (size_t)(t + 1) * kstep;
            const char* a2 = last ? nA : cA + (size_t)(t + 2) * kstep; const char* b2 = last ? nB : cB + (size_t)(t + 2) * kstep;
            const char* a3 = a2 + kstep; const char* b3 = b2 + kstep;
            if constexpr (MidF::on) { if (t == (nt >> 1)) {
                const auto mid = MF.make(cur);
                int fro = fr; asm volatile("" : "+v"(fro));
                uint4 ga[2][2][2], gb[2][2][2];
#define MID_LOAD(g_, P_) do { _Pragma("unroll") for (int m2 = 0; m2 < 2; ++m2) _Pragma("unroll") for (int bj = 0; bj < 2; ++bj) \
                    mid.load(128 * ((g_) >> 1) + 64 * wr + 16 * (2 * ((g_) & 1) + m2) + fro, 128 * bj + 32 * wc + (PERM ? 8 : 4) * fq, ga[P_][m2][bj], gb[P_][m2][bj]); } while (0)
#define MID_APPLY(g_, P_) do { _Pragma("unroll") for (int m2 = 0; m2 < 2; ++m2) _Pragma("unroll") for (int bj = 0; bj < 2; ++bj) \
                    mid.apply(ga[P_][m2][bj], gb[P_][m2][bj], acc[(g_) >> 1][bj][2 * ((g_) & 1) + m2][0], acc[(g_) >> 1][bj][2 * ((g_) & 1) + m2][1]); } while (0)
                MID_LOAD(0, 0); MID_LOAD(1, 1); MID_APPLY(0, 0); G8_SCHED; MID_LOAD(2, 0); MID_APPLY(1, 1); G8_SCHED; MID_LOAD(3, 1); MID_APPLY(2, 0); G8_SCHED; MID_APPLY(3, 1);
#undef MID_LOAD
#undef MID_APPLY
            } }
            unsigned vA2[2][2];
#pragma unroll
            for (int h_ = 0; h_ < 2; ++h_)
#pragma unroll
                for (int i_ = 0; i_ < 2; ++i_) vA2[h_][i_] = vAc[h_][i_];
            if constexpr (GATHER) { if (last && has_next) { G8_VOFF(vAn, nxt);
#pragma unroll
                for (int h_ = 0; h_ < 2; ++h_)
#pragma unroll
                    for (int i_ = 0; i_ < 2; ++i_) vA2[h_][i_] = vAn[h_][i_]; } }
            G8_LDB(B0, 0, 0); G8_SCHED; G8_LDA(At, 0, 0); G8_STAGE_A(1, 1, a1 + hstepA, vAc);
            G8_WAIT_L(8); G8_BAR; G8_WAIT_L(0); G8_MMA(0, 0, At, B0); G8_BAR; G8_SCHED;
            G8_LDB(B1, 0, 1); G8_STAGE_B(0, 0, b2);
            G8_BAR; G8_WAIT_L(0); G8_MMA(0, 1, At, B1); G8_BAR;
            G8_LDA(At, 0, 1); G8_STAGE_A(0, 0, a2, vA2);
            G8_BAR; G8_WAIT_L(0); G8_MMA(1, 0, At, B0); G8_BAR; G8_SCHED;
            G8_STAGE_B(0, 1, b2 + hstepB);
            G8_WAIT_V(6); G8_BAR; G8_MMA(1, 1, At, B1); G8_BAR;
            G8_LDB(B0, 1, 0); G8_SCHED; G8_LDA(At, 1, 0); G8_STAGE_A(0, 1, a2 + hstepA, vA2);
            G8_WAIT_L(8); G8_BAR; G8_WAIT_L(0); G8_MMA(0, 0, At, B0); G8_BAR; G8_SCHED;
            G8_LDB(B1, 1, 1); G8_STAGE_B(1, 0, b3);
            G8_BAR; G8_WAIT_L(0); G8_MMA(0, 1, At, B1); G8_BAR;
            G8_LDA(At, 1, 1); G8_STAGE_A(1, 0, a3, vA2);
            G8_BAR; G8_WAIT_L(0); G8_MMA(1, 0, At, B0); G8_BAR; G8_SCHED;
            G8_STAGE_B(1, 1, b3 + hstepB);
            G8_WAIT_V(6); G8_BAR; G8_MMA(1, 1, At, B1); G8_BAR;
        }
        {
            const auto epi = EF(cur);
            if constexpr (has_pre<decltype(epi)>::value) {
#pragma unroll
                for (int ai = 0; ai < 2; ++ai) {
                    uint4 g[4][2];
#pragma unroll
                    for (int m = 0; m < 4; ++m)
#pragma unroll
                        for (int bj = 0; bj < 2; ++bj) epi.load(128 * ai + 64 * wr + 16 * m + fr, 128 * bj + 32 * wc + (PERM ? 8 : 4) * fq, g[m][bj]);
#pragma unroll
                    for (int m = 0; m < 4; ++m)
#pragma unroll
                        for (int bj = 0; bj < 2; ++bj) epi.store(128 * ai + 64 * wr + 16 * m + fr, 128 * bj + 32 * wc + (PERM ? 8 : 4) * fq, g[m][bj], acc[ai][bj][m][0], acc[ai][bj][m][1]);
                }
            } else {
#pragma unroll
            for (int ai = 0; ai < 2; ++ai)
#pragma unroll
                for (int m = 0; m < 4; ++m)
#pragma unroll
                    for (int bj = 0; bj < 2; ++bj) epi(128 * ai + 64 * wr + 16 * m + fr, 128 * bj + 32 * wc + (PERM ? 8 : 4) * fq, acc[ai][bj][m][0], acc[ai][bj][m][1]);
            }
        }
        if (!has_next) break;
#pragma unroll
        for (int a_ = 0; a_ < 2; ++a_)
#pragma unroll
            for (int b_ = 0; b_ < 2; ++b_)
#pragma unroll
                for (int m = 0; m < 4; ++m)
#pragma unroll
                    for (int n = 0; n < 2; ++n) acc[a_][b_][m][n] = (f32x4){0.f, 0.f, 0.f, 0.f};
        if constexpr (GATHER) {
#pragma unroll
            for (int h_ = 0; h_ < 2; ++h_)
#pragma unroll
                for (int i_ = 0; i_ < 2; ++i_) vAc[h_][i_] = vAn[h_][i_]; }
        cur = nxt; cA = nA; cB = nB; ++ui;
    }
    G8_WAIT_V(0);
    if (wr == 0) G8_BAR;
    G8_BAR;
#undef G8_SA
#undef G8_SB
#undef G8_STAGE
#undef G8_STAGE_A
#undef G8_STAGE_B
#undef G8_LDA
#undef G8_LDB
#undef G8_MMA
#undef G8_WAIT_V
#undef G8_WAIT_L
#undef G8_BAR
#undef G8_SCHED
#undef G8_VOFF
}

struct UnitF { const char* A; const float* B0; const float* B1; int i0, i1, i2, i3; };
template <bool GATHER, bool LISTS, class Sched, class EpiF>
DEV void gemm_stream_fb(LAS unsigned char* lds, const int K, const int ldb, const Sched& S, const EpiF& EF) {
    const int tid = opaque_tid(), wid = __builtin_amdgcn_readfirstlane(tid >> 6), lane = tid & 63, wr = wid >> 2, wc = wid & 3, fr = lane & 15, fq = lane >> 4;
    const int nt = K / BK;
    const size_t kstep = (size_t)(BK * 2);
    const size_t hstepA = GATHER ? 0 : (size_t)HALF * K * 2;
    const unsigned ldsw = (unsigned)wid * 1024u;
    const int aoff = lds_byte(wr * 64 + fr, fq * 8);
    const int g4 = lane >> 4, j16 = lane & 15, krow = j16 >> 2, c4 = j16 & 3, vg = wid & 1, kqb = wid >> 1;
    const unsigned bvoff = (unsigned)((4 * kqb + krow) * ldb + vg * 64 + g4 * 16 + c4 * 4) * 4u;
    const unsigned bwoff = (unsigned)(((kqb >> 1) * 8 + (vg * 2 + (g4 >> 1)) * 2 + (c4 & 1)) * 256 + (((4 * (kqb & 1) + krow) ^ (((kqb >> 1) & 1) << 2)) * 32) + ((g4 & 1) * 2 + (c4 >> 1)) * 8);
    const unsigned ldsu = (unsigned)__builtin_amdgcn_readfirstlane((int)(unsigned)(unsigned long long)lds);
    unsigned brd[2];
    { const int q = j16 >> 2, p = j16 & 3;
#pragma unroll
      for (int t = 0; t < 2; ++t) brd[t] = (unsigned)(fq * 2048 + wc * 512 + (((4 * t + q) ^ ((fq & 1) << 2)) * 32) + p * 8); }
    unsigned bq0a_ = ldsu + 4u * (unsigned)HTB + brd[0], bq1a_ = ldsu + 4u * (unsigned)HTB + brd[1], wba_ = ldsu + 4u * (unsigned)HTB + bwoff;
    asm volatile("" : "+v"(bq0a_), "+v"(bq1a_), "+v"(wba_));
    const LAS unsigned char* const bq0 = (const LAS unsigned char*)(unsigned long long)bq0a_; const LAS unsigned char* const bq1 = (const LAS unsigned char*)(unsigned long long)bq1a_;
#define F_SA(b, h) (((b) * 2 + (h)) * HTB)
#define F_SB(b, h) ((4 + (b) * 2 + (h)) * HTB)
#define F_GLDS(gsrc, ldsdst) do { unsigned keep_; const char* gs_ = (gsrc); const unsigned ld_ = (unsigned)__builtin_amdgcn_readfirstlane((int)(ldsdst)); \
        asm volatile("s_mov_b32 %0, m0\n\ts_mov_b32 m0, %2\n\ts_nop 0\n\tglobal_load_lds_dwordx4 %1, off\n\ts_mov_b32 m0, %0" : "=&s"(keep_) : "v"(gs_), "s"(ld_) : "memory"); } while (0)
#define F_GLDS_S(sbase, voff, ldsdst) do { unsigned keep_; const char* sb_ = (const char*)rfl_ptr((const float*)(sbase)); const unsigned vo_ = (voff); const unsigned ld_ = (unsigned)__builtin_amdgcn_readfirstlane((int)(ldsdst)); \
        asm volatile("s_mov_b32 %0, m0\n\ts_mov_b32 m0, %3\n\ts_nop 0\n\tglobal_load_lds_dwordx4 %1, %2\n\ts_mov_b32 m0, %0" : "=&s"(keep_) : "v"(vo_), "s"(sb_), "s"(ld_) : "memory"); } while (0)
#define F_STAGE_A(b, h, gbase, VA) do { \
        F_GLDS_S(gbase, VA[h][0], ldsu + (unsigned)F_SA(b, h) + ldsw); \
        F_GLDS_S(gbase, VA[h][1], ldsu + (unsigned)F_SA(b, h) + ldsw + 8192u); } while (0)
#define F_LDA(dst, b, h) do { _Pragma("unroll") for (int m = 0; m < 4; ++m) _Pragma("unroll") for (int k = 0; k < 2; ++k) dst[m][k] = *(const LAS bf16x8*)(lds + F_SA(b, h) + aoff + m * 2048 + k * 1024); } while (0)
#define F_LDB(dst, b, h) do { _Pragma("unroll") for (int n = 0; n < 2; ++n) _Pragma("unroll") for (int k = 0; k < 2; ++k) { \
        const s16x4 t0_ = __builtin_amdgcn_ds_read_tr16_b64_v4i16((LAS s16x4*)(bq0 + ((b) * 2 + (h)) * HTB + k * 8192 + n * 256)); \
        const s16x4 t1_ = __builtin_amdgcn_ds_read_tr16_b64_v4i16((LAS s16x4*)(bq1 + ((b) * 2 + (h)) * HTB + k * 8192 + n * 256)); \
        dst[n][k] = (bf16x8){t0_[0], t0_[1], t0_[2], t0_[3], t1_[0], t1_[1], t1_[2], t1_[3]}; } } while (0)
#define F_MMA(ai, bj) do { __builtin_amdgcn_s_setprio(1); _Pragma("unroll") for (int m = 0; m < 4; ++m) _Pragma("unroll") for (int n = 0; n < 2; ++n) _Pragma("unroll") for (int k = 0; k < 2; ++k) \
        acc[ai][bj][m][n] = __builtin_amdgcn_mfma_f32_16x16x32_bf16(Bx[n][k], At[m][k], acc[ai][bj][m][n], 0, 0, 0); __builtin_amdgcn_s_setprio(0); } while (0)
#define F_LOADB(SET, pb, ktile) do { const float* bp0_ = rfl_ptr((pb) + (size_t)((ktile) * 64) * ldb); const float* bp1_ = rfl_ptr(bp0_ + 16 * ldb); const float* bp2_ = rfl_ptr(bp0_ + 32 * ldb); const float* bp3_ = rfl_ptr(bp0_ + 48 * ldb); \
        asm volatile("s_nop 4\n\tglobal_load_dwordx4 %0, %4, %5\n\tglobal_load_dwordx4 %1, %4, %6\n\tglobal_load_dwordx4 %2, %4, %7\n\tglobal_load_dwordx4 %3, %4, %8" \
            : "=&v"(SET[0]), "=&v"(SET[1]), "=&v"(SET[2]), "=&v"(SET[3]) : "v"(bvoff), "s"(bp0_), "s"(bp1_), "s"(bp2_), "s"(bp3_) : "memory"); } while (0)
#define F_WAITSET(n, SET) asm volatile("s_waitcnt vmcnt(" #n ")" : "+v"(SET[0]), "+v"(SET[1]), "+v"(SET[2]), "+v"(SET[3]) :: "memory")
#define F_WRITEB(SET, b, h) do { u32x2_t w0_, w1_, w2_, w3_; \
        w0_[0] = pack_bf16x2(SET[0][0], SET[0][1]); w0_[1] = pack_bf16x2(SET[0][2], SET[0][3]); w1_[0] = pack_bf16x2(SET[1][0], SET[1][1]); w1_[1] = pack_bf16x2(SET[1][2], SET[1][3]); \
        w2_[0] = pack_bf16x2(SET[2][0], SET[2][1]); w2_[1] = pack_bf16x2(SET[2][2], SET[2][3]); w3_[0] = pack_bf16x2(SET[3][0], SET[3][1]); w3_[1] = pack_bf16x2(SET[3][2], SET[3][3]); \
        asm volatile("ds_write_b64 %0, %1 offset:%5\n\tds_write_b64 %0, %2 offset:%6\n\tds_write_b64 %0, %3 offset:%7\n\tds_write_b64 %0, %4 offset:%8" \
            :: "v"(wba_), "v"(w0_), "v"(w1_), "v"(w2_), "v"(w3_), "n"(((b) * 2 + (h)) * HTB), "n"(((b) * 2 + (h)) * HTB + 4096), "n"(((b) * 2 + (h)) * HTB + 8192), "n"(((b) * 2 + (h)) * HTB + 12288) : "memory"); } while (0)
#define F_WAIT_V(n) asm volatile("s_waitcnt vmcnt(" #n ")" ::: "memory")
#define F_WAIT_L(n) asm volatile("s_waitcnt lgkmcnt(" #n ")" ::: "memory")
#define F_BAR __builtin_amdgcn_s_barrier()
#define F_SCHED __builtin_amdgcn_sched_barrier(0)
#define F_VOFF(VA, u) do { _Pragma("unroll") for (int i_ = 0; i_ < 2; ++i_) { int R_, C_; stage_rc(tid * 16 + i_ * 8192, R_, C_); _Pragma("unroll") for (int h_ = 0; h_ < 2; ++h_) \
        VA[h_][i_] = GATHER ? (S.rowoff(u, R_ + 128 * h_) + (unsigned)C_ * 2u) : (unsigned)(R_ * K + C_) * 2u; } } while (0)
    UnitF cur, nxt; int ui = 0;
    if (!S.next(0, cur)) return;
    constexpr unsigned LIST_OFF = 131072u + 256u + 2304u;
    int lbuf = 0;
#define F_LISTS(u) do { if (wid == 0) { F_GLDS((const char*)S.list0(u) + lane * 16, ldsu + LIST_OFF + (unsigned)lbuf * 2048u); F_GLDS((const char*)S.list1(u) + lane * 16, ldsu + LIST_OFF + (unsigned)lbuf * 2048u + 1024u); } } while (0)
    f32x4 acc[2][2][4][2];
#pragma unroll
    for (int a_ = 0; a_ < 2; ++a_)
#pragma unroll
        for (int b_ = 0; b_ < 2; ++b_)
#pragma unroll
            for (int m = 0; m < 4; ++m)
#pragma unroll
                for (int n = 0; n < 2; ++n) acc[a_][b_][m][n] = (f32x4){0.f, 0.f, 0.f, 0.f};
    bf16x8 At[4][2], Bx[2][2];
    f32x4 X[4], Y[4];
    unsigned vAc[2][2];
    F_VOFF(vAc, cur);
    const char* cA = cur.A; const float* cP0 = rfl_ptr(cur.B0); const float* cP1 = rfl_ptr(cur.B1);
    if constexpr (LISTS) { F_LISTS(cur); }
    F_LOADB(X, cP0, 0); F_LOADB(Y, cP1, 0); F_STAGE_A(0, 0, cA, vAc); F_STAGE_A(0, 1, cA + hstepA, vAc);
    if (wr == 1) F_BAR;
    F_WAITSET(0, X); F_WAITSET(0, Y); F_WRITEB(X, 0, 0); F_WRITEB(Y, 0, 1);
    F_SCHED;
    F_LOADB(X, cP0, 1); F_STAGE_A(1, 0, cA + kstep, vAc); F_LOADB(Y, cP1, 1);
    F_WAIT_L(0); F_BAR;
    F_BAR;
    for (;;) {
        const bool has_next = S.next(ui + 1, nxt);
        const char* nA = has_next ? nxt.A : cA; const float* nP0 = has_next ? rfl_ptr(nxt.B0) : cP0; const float* nP1 = has_next ? rfl_ptr(nxt.B1) : cP1;
#pragma unroll 1
        for (int t = 0; t < nt; t += 2) {
            const bool last = (t == nt - 2);
            const char* a1 = cA + (size_t)(t + 1) * kstep;
            const char* a2 = last ? nA : cA + (size_t)(t + 2) * kstep;
            const char* a3 = a2 + kstep;
            const float* p20 = last ? nP0 : cP0; const float* p21 = last ? nP1 : cP1; const int k2 = last ? 0 : t + 2;
            F_LDB(Bx, 0, 0); F_LDA(At, 0, 0); F_STAGE_A(1, 1, a1 + hstepA, vAc);
            F_BAR; F_WAIT_L(0); F_MMA(0, 0); F_BAR; F_SCHED;
            if constexpr (GATHER) { if (last && has_next && (nxt.i0 != cur.i0 || nxt.i1 != cur.i1)) { F_VOFF(vAc, nxt); } }
            F_LDB(Bx, 0, 1); F_SCHED; F_WAITSET(8, X); F_WRITEB(X, 1, 0); F_SCHED; F_LOADB(X, p20, k2);
            F_WAIT_L(0); F_BAR; F_MMA(0, 1); F_BAR; F_SCHED;
            F_LDA(At, 0, 1); F_LDB(Bx, 0, 0); F_STAGE_A(0, 0, a2, vAc);
            F_BAR; F_WAIT_L(0); F_MMA(1, 0); F_BAR; F_SCHED;
            F_LDB(Bx, 0, 1); F_SCHED; F_WAITSET(6, Y); F_WRITEB(Y, 1, 1); F_SCHED; F_LOADB(Y, p21, k2);
            F_WAIT_L(0); F_BAR; F_MMA(1, 1); F_BAR; F_SCHED;
            F_LDB(Bx, 1, 0); F_LDA(At, 1, 0); F_STAGE_A(0, 1, a2 + hstepA, vAc);
            F_BAR; F_WAIT_L(0); F_MMA(0, 0); F_BAR; F_SCHED;
            F_LDB(Bx, 1, 1); F_SCHED; F_WAITSET(8, X); F_WRITEB(X, 0, 0); F_SCHED; F_LOADB(X, p20, k2 + 1);
            F_WAIT_L(0); F_BAR; F_MMA(0, 1); F_BAR; F_SCHED;
            F_LDA(At, 1, 1); F_LDB(Bx, 1, 0); F_STAGE_A(1, 0, a3, vAc);
            F_BAR; F_WAIT_L(0); F_MMA(1, 0); F_BAR; F_SCHED;
            F_LDB(Bx, 1, 1); F_SCHED; F_WAITSET(6, Y); F_WRITEB(Y, 0, 1); F_SCHED; F_LOADB(Y, p21, k2 + 1);
            F_WAIT_L(0); F_BAR; F_MMA(1, 1); F_BAR; F_SCHED;
        }
        if constexpr (LISTS) EF(cur).apply(acc, wr, wc, fr, fq, (const LAS int*)(lds + LIST_OFF + (unsigned)lbuf * 2048u));
        else EF(cur).apply(acc, wr, wc, fr, fq);
        if (!has_next) break;
        if constexpr (LISTS) { if (nxt.i0 != cur.i0 || nxt.i1 != cur.i1) { lbuf ^= 1; F_LISTS(nxt); } }
#pragma unroll
        for (int a_ = 0; a_ < 2; ++a_)
#pragma unroll
            for (int b_ = 0; b_ < 2; ++b_)
#pragma unroll
                for (int m = 0; m < 4; ++m)
#pragma unroll
                    for (int n = 0; n < 2; ++n) acc[a_][b_][m][n] = (f32x4){0.f, 0.f, 0.f, 0.f};
        cur = nxt; cA = nA; cP0 = nP0; cP1 = nP1; ++ui;
    }
    F_WAITSET(0, X); F_WAITSET(0, Y);
    asm volatile("" :: "v"(X[0]), "v"(X[1]), "v"(X[2]), "v"(X[3]), "v"(Y[0]), "v"(Y[1]), "v"(Y[2]), "v"(Y[3]));
    if (wr == 0) F_BAR;
    F_BAR;
#undef F_SA
#undef F_SB
#undef F_STAGE_A
#undef F_GLDS
#undef F_GLDS_S
#undef F_LISTS
#undef F_LDA
#undef F_LDB
#undef F_MMA
#undef F_LOADB
#undef F_WAITSET
#undef F_WRITEB
#undef F_WAIT_V
#undef F_WAIT_L
#undef F_BAR
#undef F_SCHED
#undef F_VOFF
}
}

typedef short s16x4 __attribute__((ext_vector_type(4)));


struct FAMapPlain { const bf16_t* A; int lda; int row0; DEV const bf16_t* operator()(int r) const { return A + (size_t)(row0 + r) * lda; } DEV const bf16_t* aorigin() const { return A; } };
struct FAMapGather { const bf16_t* A; int lda; const int* lslot; int base; int cnt; int r0;
    DEV const bf16_t* operator()(int r) const { int rr = r0 + r; rr = rr < cnt ? rr : cnt - 1; return A + (size_t)(lslot[base + rr] >> 3) * lda; } DEV const bf16_t* aorigin() const { return A; } };
struct FAMapSlot { const bf16_t* A; int lda; const int* lslot; int base; int cnt; int r0;
    DEV const bf16_t* operator()(int r) const { int rr = r0 + r; rr = rr < cnt ? rr : cnt - 1; return A + (size_t)lslot[base + rr] * lda; } DEV const bf16_t* aorigin() const { return A; } };
struct FBMapPlain { const float* W; int ldb; int col0; DEV const float* ptr(int vb) const { return W + col0 + vb * 16; } DEV int ld() const { return ldb; } };
struct FBMapPair { const float* Wg; const float* Wu; int ldb; int col0;
    DEV const float* ptr(int vb) const { return Wg + (ptrdiff_t)(vb & 1) * (Wu - Wg) + col0 + (vb >> 1) * 16; } DEV int ld() const { return ldb; } };

template <int BM, class AMap, class BMap, class Epi>
DEV void gemm_unit(char* smem, const AMap& amap, const BMap& bmap, const Epi& epi, int K) {
    constexpr int NA = BM / 64, MI = BM / 32, ABYTES = BM * 128, STG = ABYTES + 32768;
    const int tid = opaque_tid(), lane = tid & 63, wid = tid >> 6, wr = wid >> 2, wc = wid & 3, fr = lane & 15, fq = lane >> 4;
    const bf16_t* aptr[NA];
#pragma unroll
    for (int i = 0; i < NA; ++i) { const int c = tid + 512 * i, row = c >> 3, pch = c & 7; aptr[i] = amap(row) + ((pch ^ (row & 7)) << 3); }
    const int g = lane >> 4, j16 = lane & 15, krow = j16 >> 2, c4 = j16 & 3, vg = wid & 3, kh = wid >> 2;
    const int ldb = bmap.ld();
    const float* bptr = bmap.ptr(vg * 4 + g) + 4 * c4 + (size_t)(4 * kh + krow) * ldb;
    unsigned bwr[2];
#pragma unroll
    for (int o = 0; o < 2; ++o) bwr[o] = ABYTES + (vg * 4 + g) * 256 + (((4 * kh + krow) ^ (o << 2)) * 32) + c4 * 8;
    unsigned ard[2];
#pragma unroll
    for (int ks = 0; ks < 2; ++ks) { const int row = wr * (BM / 2) + fr; ard[ks] = row * 128 + (((ks * 4 + fq) ^ (row & 7)) << 4); }
    unsigned brd[2];
    { const int q = j16 >> 2, p = j16 & 3;
#pragma unroll
      for (int t = 0; t < 2; ++t) brd[t] = ABYTES + (fq * 16) * 256 + (((4 * t + q) ^ ((fq & 1) << 2)) * 32) + p * 8; }

    f32x4 acc[MI][4];
#pragma unroll
    for (int mi = 0; mi < MI; ++mi)
#pragma unroll
        for (int nf = 0; nf < 4; ++nf) acc[mi][nf] = (f32x4){0.f, 0.f, 0.f, 0.f};

    float4 breg[4];
    const int nk = K >> 6;
#define G_LOAD_A(kt, buf) do { _Pragma("unroll") for (int i = 0; i < NA; ++i) \
        __builtin_amdgcn_global_load_lds((const unsigned*)(aptr[i] + (kt) * 64), (LAS unsigned*)(smem + (buf) * STG + (tid + 512 * i) * 16), 16, 0, 0); } while (0)
#define G_LOAD_B(kt, h) do { _Pragma("unroll") for (int i = 0; i < 4; ++i) breg[i] = *(const float4*)(bptr + (size_t)((kt) * 64 + 8 * ((h) * 4 + i)) * ldb); } while (0)
#define G_WRITE_B(buf, h) do { char* sb_ = smem + (buf) * STG; \
        _Pragma("unroll") for (int i = 0; i < 4; ++i) { uint2 w; w.x = pack_bf16x2(breg[i].x, breg[i].y); w.y = pack_bf16x2(breg[i].z, breg[i].w); \
            *(uint2*)(sb_ + bwr[i & 1] + ((h) * 4 + i) * 16 * 256) = w; } } while (0)
#define G_COMPUTE(sb, ks) do { bf16x8 bf[4]; \
        _Pragma("unroll") for (int nf = 0; nf < 4; ++nf) { \
            const int nb = (nf >> 1) * 8 + wc * 2 + (nf & 1); const unsigned base = (ks) * 4 * 16 * 256 + nb * 256; \
            s16x4 t0 = __builtin_amdgcn_ds_read_tr16_b64_v4i16((LAS s16x4*)((sb) + brd[0] + base)); \
            s16x4 t1 = __builtin_amdgcn_ds_read_tr16_b64_v4i16((LAS s16x4*)((sb) + brd[1] + base)); \
            bf[nf] = (bf16x8){t0[0], t0[1], t0[2], t0[3], t1[0], t1[1], t1[2], t1[3]}; } \
        _Pragma("unroll") for (int mi = 0; mi < MI; ++mi) { \
            const bf16x8 af = *(const bf16x8*)((sb) + ard[ks] + mi * 16 * 128); \
            _Pragma("unroll") for (int nf = 0; nf < 4; ++nf) acc[mi][nf] = __builtin_amdgcn_mfma_f32_16x16x32_bf16(bf[nf], af, acc[mi][nf], 0, 0, 0); } } while (0)
    G_LOAD_A(0, 0); G_LOAD_B(0, 0); G_WRITE_B(0, 0); G_LOAD_B(0, 1); G_WRITE_B(0, 1);
    __syncthreads();
    for (int kt = 0; kt < nk; ++kt) {
        const bool more = kt + 1 < nk;
        const char* sb = smem + (kt & 1) * STG;
        if (more) { G_LOAD_A(kt + 1, (kt + 1) & 1); G_LOAD_B(kt + 1, 0); }
        G_COMPUTE(sb, 0);
        if (more) { G_WRITE_B((kt + 1) & 1, 0); G_LOAD_B(kt + 1, 1); }
        G_COMPUTE(sb, 1);
        if (more) { G_WRITE_B((kt + 1) & 1, 1); }
        __syncthreads();
    }
#undef G_LOAD_A
#undef G_LOAD_B
#undef G_WRITE_B
#undef G_COMPUTE
#pragma unroll
    for (int mi = 0; mi < MI; ++mi)
#pragma unroll
        for (int bj = 0; bj < 2; ++bj) epi(wr * (BM / 2) + mi * 16 + fr, bj * 128 + wc * 32 + 4 * fq, acc[mi][bj * 2], acc[mi][bj * 2 + 1]);
}


template <int BM, class AMap, class BMap, class Epi>
DEV void gemm_unit2(char* smem, const AMap& amap, const BMap& bmap, const Epi& epi, int K) {
    constexpr int NA = BM / 64, MI = BM / 32, ABYTES = BM * 128, STG = ABYTES + 32768;
    const int tid = opaque_tid(), lane = tid & 63, wid = tid >> 6, wr = wid >> 2, wc = wid & 3, fr = lane & 15, fq = lane >> 4;
    const char* abase = (const char*)amap.aorigin();
    unsigned aoffs[NA];
#pragma unroll
    for (int i = 0; i < NA; ++i) { const int c = tid + 512 * i, row = c >> 3, pch = c & 7; aoffs[i] = (unsigned)((const char*)(amap(row) + ((pch ^ (row & 7)) << 3)) - abase); }
    const int g = lane >> 4, j16 = lane & 15, krow = j16 >> 2, c4 = j16 & 3, vg = wid & 3, kh = wid >> 2;
    const int ldb = bmap.ld();
    const float* bptr = bmap.ptr(vg * 4 + g) + 4 * c4 + (size_t)(4 * kh + krow) * ldb;
    unsigned bwr[2];
#pragma unroll
    for (int o = 0; o < 2; ++o) bwr[o] = ABYTES + (vg * 4 + g) * 256 + (((4 * kh + krow) ^ (o << 2)) * 32) + c4 * 8;
    unsigned ard[2];
#pragma unroll
    for (int ks = 0; ks < 2; ++ks) { const int row = wr * (BM / 2) + fr; ard[ks] = row * 128 + (((ks * 4 + fq) ^ (row & 7)) << 4); }
    unsigned brd[2];
    { const int q = j16 >> 2, p = j16 & 3;
#pragma unroll
      for (int t = 0; t < 2; ++t) brd[t] = ABYTES + (fq * 16) * 256 + (((4 * t + q) ^ ((fq & 1) << 2)) * 32) + p * 8; }

    f32x4 acc[MI][4];
#pragma unroll
    for (int mi = 0; mi < MI; ++mi)
#pragma unroll
        for (int nf = 0; nf < 4; ++nf) acc[mi][nf] = (f32x4){0.f, 0.f, 0.f, 0.f};

    float4 breg[4];
    const int nk = K >> 6;
#define G_LOAD_A(kt, buf) do { _Pragma("unroll") for (int i = 0; i < NA; ++i) \
        __builtin_amdgcn_global_load_lds((const unsigned*)(abase + (size_t)(kt) * 128 + aoffs[i]), (LAS unsigned*)(smem + (buf) * STG + (tid + 512 * i) * 16), 16, 0, 0); } while (0)
#define G_LOAD_B(kt, h) do { _Pragma("unroll") for (int i = 0; i < 4; ++i) breg[i] = *(const float4*)(bptr + (size_t)((kt) * 64 + 8 * ((h) * 4 + i)) * ldb); } while (0)
#define G_WRITE_B(buf, h) do { char* sb_ = smem + (buf) * STG; \
        _Pragma("unroll") for (int i = 0; i < 4; ++i) { uint2 w; w.x = pack_bf16x2(breg[i].x, breg[i].y); w.y = pack_bf16x2(breg[i].z, breg[i].w); \
            *(uint2*)(sb_ + bwr[i & 1] + ((h) * 4 + i) * 16 * 256) = w; } } while (0)
#define G_AF(sb, ks, mi) (*(const bf16x8*)((sb) + ard[ks] + (mi) * 16 * 128))
#define G_MM(mi, afv) do { _Pragma("unroll") for (int nf = 0; nf < 4; ++nf) acc[mi][nf] = __builtin_amdgcn_mfma_f32_16x16x32_bf16(bf[nf], afv, acc[mi][nf], 0, 0, 0); } while (0)
#define G_COMPUTE(sb, ks) do { bf16x8 bf[4]; \
        _Pragma("unroll") for (int nf = 0; nf < 4; ++nf) { \
            const int nb = (nf >> 1) * 8 + wc * 2 + (nf & 1); const unsigned base = (ks) * 4 * 16 * 256 + nb * 256; \
            s16x4 t0 = __builtin_amdgcn_ds_read_tr16_b64_v4i16((LAS s16x4*)((sb) + brd[0] + base)); \
            s16x4 t1 = __builtin_amdgcn_ds_read_tr16_b64_v4i16((LAS s16x4*)((sb) + brd[1] + base)); \
            bf[nf] = (bf16x8){t0[0], t0[1], t0[2], t0[3], t1[0], t1[1], t1[2], t1[3]}; } \
        bf16x8 a0 = G_AF(sb, ks, 0), a1 = G_AF(sb, ks, 1), a2 = G_AF(sb, ks, 2), a3 = G_AF(sb, ks, 3); \
        G_MM(0, a0); a0 = G_AF(sb, ks, 4); G_MM(1, a1); a1 = G_AF(sb, ks, 5); G_MM(2, a2); a2 = G_AF(sb, ks, 6); G_MM(3, a3); a3 = G_AF(sb, ks, 7); \
        G_MM(4, a0); G_MM(5, a1); G_MM(6, a2); G_MM(7, a3); \
        if ((ks) == 0) { \
        __builtin_amdgcn_sched_group_barrier(0x100, 12, 0); \
        __builtin_amdgcn_sched_group_barrier(0x008, 4, 0); __builtin_amdgcn_sched_group_barrier(0x100, 1, 0); __builtin_amdgcn_sched_group_barrier(0x020, 2, 0); \
        __builtin_amdgcn_sched_group_barrier(0x008, 4, 0); __builtin_amdgcn_sched_group_barrier(0x100, 1, 0); __builtin_amdgcn_sched_group_barrier(0x020, 2, 0); \
        __builtin_amdgcn_sched_group_barrier(0x008, 4, 0); __builtin_amdgcn_sched_group_barrier(0x100, 1, 0); __builtin_amdgcn_sched_group_barrier(0x020, 2, 0); \
        __builtin_amdgcn_sched_group_barrier(0x008, 4, 0); __builtin_amdgcn_sched_group_barrier(0x100, 1, 0); __builtin_amdgcn_sched_group_barrier(0x020, 2, 0); \
        __builtin_amdgcn_sched_group_barrier(0x008, 4, 0); __builtin_amdgcn_sched_group_barrier(0x020, 1, 0); \
        __builtin_amdgcn_sched_group_barrier(0x008, 4, 0); __builtin_amdgcn_sched_group_barrier(0x020, 1, 0); \
        __builtin_amdgcn_sched_group_barrier(0x008, 4, 0); __builtin_amdgcn_sched_group_barrier(0x020, 1, 0); \
        __builtin_amdgcn_sched_group_barrier(0x008, 4, 0); __builtin_amdgcn_sched_group_barrier(0x020, 1, 0); \
        } else { \
        __builtin_amdgcn_sched_group_barrier(0x100, 12, 0); \
        __builtin_amdgcn_sched_group_barrier(0x008, 4, 0); __builtin_amdgcn_sched_group_barrier(0x100, 1, 0); \
        __builtin_amdgcn_sched_group_barrier(0x008, 4, 0); __builtin_amdgcn_sched_group_barrier(0x100, 1, 0); \
        __builtin_amdgcn_sched_group_barrier(0x008, 4, 0); __builtin_amdgcn_sched_group_barrier(0x100, 1, 0); \
        __builtin_amdgcn_sched_group_barrier(0x008, 4, 0); __builtin_amdgcn_sched_group_barrier(0x100, 1, 0); \
        __builtin_amdgcn_sched_group_barrier(0x008, 16, 0); } } while (0)
    float4 breg2[4];
#define G_LOAD_B2(kt) do { _Pragma("unroll") for (int i = 0; i < 4; ++i) breg2[i] = *(const float4*)(bptr + (size_t)((kt) * 64 + 8 * (4 + i)) * ldb); } while (0)
#define G_WRITE_B2(buf) do { char* sb_ = smem + (buf) * STG; \
        _Pragma("unroll") for (int i = 0; i < 4; ++i) { uint2 w; w.x = pack_bf16x2(breg2[i].x, breg2[i].y); w.y = pack_bf16x2(breg2[i].z, breg2[i].w); \
            *(uint2*)(sb_ + bwr[i & 1] + (4 + i) * 16 * 256) = w; } } while (0)
    G_LOAD_A(0, 0); G_LOAD_B(0, 0); G_LOAD_B2(0); G_WRITE_B(0, 0); G_WRITE_B2(0);
    __syncthreads();
    for (int kt = 0; kt < nk; ++kt) {
        const bool more = kt + 1 < nk;
        const char* sb = smem + (kt & 1) * STG;
        { const int kn = more ? kt + 1 : kt; G_LOAD_A(kn, (kt + 1) & 1); G_LOAD_B(kn, 0); G_LOAD_B2(kn); }
        G_COMPUTE(sb, 0);
        __builtin_amdgcn_sched_barrier(0);
        G_COMPUTE(sb, 1);
        if (more) { G_WRITE_B((kt + 1) & 1, 0); G_WRITE_B2((kt + 1) & 1); }
        __syncthreads();
    }
#undef G_LOAD_B2
#undef G_WRITE_B2
#undef G_LOAD_A
#undef G_LOAD_B
#undef G_WRITE_B
#undef G_COMPUTE
#undef G_AF
#undef G_MM
#pragma unroll
    for (int mi = 0; mi < MI; ++mi)
#pragma unroll
        for (int bj = 0; bj < 2; ++bj) epi(wr * (BM / 2) + mi * 16 + fr, bj * 128 + wc * 32 + 4 * fq, acc[mi][bj * 2], acc[mi][bj * 2 + 1]);
}


template <class AMap, class BMap, class Epi>
DEV void gemm_unit_bd(char* smem, const AMap& amap, const BMap& bmap, const Epi& epi, int K) {
    const int tid = opaque_tid(), lane = tid & 63, wid = tid >> 6, fr = lane & 15, fq = lane >> 4;
    const bf16_t* aptr[4];
#pragma unroll
    for (int i = 0; i < 4; ++i) { const int c = tid + 512 * i, row = c >> 3, pch = c & 7; aptr[i] = amap(row) + ((pch ^ (row & 7)) << 3); }
    const int ldb = bmap.ld();
    const float* bp0 = bmap.ptr(2 * wid) + fr + (size_t)(8 * fq) * ldb;
    const float* bp1 = bmap.ptr(2 * wid + 1) + fr + (size_t)(8 * fq) * ldb;
    unsigned ard[2];
#pragma unroll
    for (int ks = 0; ks < 2; ++ks) ard[ks] = fr * 128 + (((ks * 4 + fq) ^ (fr & 7)) << 4);
    f32x4 acc[16][2];
#pragma unroll
    for (int mi = 0; mi < 16; ++mi) { acc[mi][0] = (f32x4){0.f, 0.f, 0.f, 0.f}; acc[mi][1] = (f32x4){0.f, 0.f, 0.f, 0.f}; }
    float bq[2][2][8];
    const int nk = K >> 6;
#define BD_LOAD_A(kt) do { _Pragma("unroll") for (int i = 0; i < 4; ++i) \
        __builtin_amdgcn_global_load_lds((const unsigned*)(aptr[i] + (kt) * 64), (LAS unsigned*)(smem + ((kt) & 3) * 32768 + (tid + 512 * i) * 16), 16, 0, 0); } while (0)
#define BD_LOAD_B(kt) do { _Pragma("unroll") for (int ks = 0; ks < 2; ++ks) _Pragma("unroll") for (int j = 0; j < 8; ++j) { \
        const size_t ro = (size_t)((kt) * 64 + ks * 32 + j) * ldb; bq[0][ks][j] = bp0[ro]; bq[1][ks][j] = bp1[ro]; } } while (0)
    BD_LOAD_A(0); if (nk > 1) BD_LOAD_A(1); if (nk > 2) BD_LOAD_A(2);
    BD_LOAD_B(0);
    for (int kt = 0; kt < nk; ++kt) {
        bf16x8 bfr[2][2];
#pragma unroll
        for (int nf = 0; nf < 2; ++nf)
#pragma unroll
            for (int ks = 0; ks < 2; ++ks) {
                const unsigned p0 = pack_bf16x2(bq[nf][ks][0], bq[nf][ks][1]), p1 = pack_bf16x2(bq[nf][ks][2], bq[nf][ks][3]), p2 = pack_bf16x2(bq[nf][ks][4], bq[nf][ks][5]), p3 = pack_bf16x2(bq[nf][ks][6], bq[nf][ks][7]);
                const uint4 u = make_uint4(p0, p1, p2, p3);
                bfr[nf][ks] = __builtin_bit_cast(bf16x8, u);
            }
        asm volatile("s_waitcnt vmcnt(0)" ::: "memory");
        __builtin_amdgcn_s_barrier();
        if (kt + 3 < nk) BD_LOAD_A(kt + 3);
        if (kt + 1 < nk) BD_LOAD_B(kt + 1);
        asm volatile("" ::: "memory");
        const char* sb = smem + (kt & 3) * 32768;
#pragma unroll
        for (int ks = 0; ks < 2; ++ks)
#pragma unroll
            for (int mi = 0; mi < 16; ++mi) {
                const bf16x8 af = *(const bf16x8*)(sb + ard[ks] + mi * 2048);
                acc[mi][0] = __builtin_amdgcn_mfma_f32_16x16x32_bf16(bfr[0][ks], af, acc[mi][0], 0, 0, 0);
                acc[mi][1] = __builtin_amdgcn_mfma_f32_16x16x32_bf16(bfr[1][ks], af, acc[mi][1], 0, 0, 0);
            }
    }
#undef BD_LOAD_A
#undef BD_LOAD_B
#pragma unroll
    for (int mi = 0; mi < 16; ++mi) epi(mi * 16 + fr, 32 * wid + 4 * fq, acc[mi][0], acc[mi][1]);
}

struct FEpiStoreBf16 { bf16_t* C; int ldc; int row0; int col0;
    DEV void operator()(int r, int c, f32x4 v0, f32x4 v1) const { bf16_t* p = C + (size_t)(row0 + r) * ldc + col0 + c;
        uint2 a, b; a.x = pack_bf16x2(v0[0], v0[1]); a.y = pack_bf16x2(v0[2], v0[3]); b.x = pack_bf16x2(v1[0], v1[1]); b.y = pack_bf16x2(v1[2], v1[3]);
        *(uint2*)p = a; *(uint2*)(p + 16) = b; } };
struct FEpiStoreF32 { float* C; int ldc; int row0; int col0;
    DEV void operator()(int r, int c, f32x4 v0, f32x4 v1) const { float* p = C + (size_t)(row0 + r) * ldc + col0 + c; *(f32x4*)p = v0; *(f32x4*)(p + 16) = v1; } };
struct FEpiGateA { bf16_t* M; const bf16_t* proj; int row0; int col0;
    DEV void one(int r, int c, f32x4 v) const { const size_t row = row0 + r; const uint2 gr = *(const uint2*)(proj + row * NP + OFF_GA + col0 + c);
        float g0 = sigmoidf_(__uint_as_float(gr.x << 16)), g1 = sigmoidf_(__uint_as_float(gr.x & 0xffff0000u)), g2 = sigmoidf_(__uint_as_float(gr.y << 16)), g3 = sigmoidf_(__uint_as_float(gr.y & 0xffff0000u));
        uint2 o; o.x = pack_bf16x2(g0 * v[0], g1 * v[1]); o.y = pack_bf16x2(g2 * v[2], g3 * v[3]); *(uint2*)(M + row * D + col0 + c) = o; }
    DEV void operator()(int r, int c, f32x4 v0, f32x4 v1) const { one(r, c, v0); one(r, c + 16, v1); } };
struct FEpiGateB { bf16_t* M; const bf16_t* proj; int row0; int col0;
    DEV void one(int r, int c, f32x4 v) const { const size_t row = row0 + r; const uint2 gr = *(const uint2*)(proj + row * NP + OFF_GB + col0 + c);
        const uint2 mo = *(const uint2*)(M + row * D + col0 + c);
        float g0 = sigmoidf_(__uint_as_float(gr.x << 16)), g1 = sigmoidf_(__uint_as_float(gr.x & 0xffff0000u)), g2 = sigmoidf_(__uint_as_float(gr.y << 16)), g3 = sigmoidf_(__uint_as_float(gr.y & 0xffff0000u));
        float m0 = __uint_as_float(mo.x << 16), m1 = __uint_as_float(mo.x & 0xffff0000u), m2 = __uint_as_float(mo.y << 16), m3 = __uint_as_float(mo.y & 0xffff0000u);
        uint2 o; o.x = pack_bf16x2(m0 + g0 * v[0], m1 + g1 * v[1]); o.y = pack_bf16x2(m2 + g2 * v[2], m3 + g3 * v[3]); *(uint2*)(M + row * D + col0 + c) = o; }
    DEV void operator()(int r, int c, f32x4 v0, f32x4 v1) const { one(r, c, v0); one(r, c + 16, v1); } };
struct FEpiSwiGLU { bf16_t* act; int row0; int col0;
    DEV void operator()(int r, int c, f32x4 g, f32x4 u) const {
        uint2 o; o.x = pack_bf16x2(siluf_(g[0]) * u[0], siluf_(g[1]) * u[1]); o.y = pack_bf16x2(siluf_(g[2]) * u[2], siluf_(g[3]) * u[3]);
        *(uint2*)(act + (size_t)(row0 + r) * FF + col0 + (c >> 5) * 16 + (c & 15)) = o; } };
struct FEpiSwiGLUSlot { bf16_t* act; const int* lslot; int base; int cnt; int r0; int col0;
    DEV void operator()(int r, int c, f32x4 g, f32x4 u) const { const int rr = r0 + r; if (rr < cnt) {
        uint2 o; o.x = pack_bf16x2(siluf_(g[0]) * u[0], siluf_(g[1]) * u[1]); o.y = pack_bf16x2(siluf_(g[2]) * u[2], siluf_(g[3]) * u[3]);
        *(uint2*)(act + (size_t)lslot[base + rr] * FF + col0 + (c >> 5) * 16 + (c & 15)) = o; } } };
struct FEpiSlot { bf16_t* yslot; const int* lslot; const float* lw; int base; int cnt; int r0; int col0;
    DEV void operator()(int r, int c, f32x4 v0, f32x4 v1) const { const int rr = r0 + r; if (rr < cnt) { const int s = lslot[base + rr]; const float w = lw[base + rr];
        bf16_t* p = yslot + (size_t)s * D + col0 + c; uint2 a, b; a.x = pack_bf16x2(w * v0[0], w * v0[1]); a.y = pack_bf16x2(w * v0[2], w * v0[3]); b.x = pack_bf16x2(w * v1[0], w * v1[1]); b.y = pack_bf16x2(w * v1[2], w * v1[3]);
        *(uint2*)p = a; *(uint2*)(p + 16) = b; } } };

DEV unsigned sw128(int row, int chunk) { return (unsigned)(row * 128 + ((chunk ^ (row & 7)) << 4)); }
DEV unsigned sw256(int row, int chunk) { return (unsigned)(row * 256 + ((chunk ^ (row & 15)) << 4)); }
constexpr int HG_LDS_BYTES = 96 * 1024;

DEV void hgrn_load16(const bf16_t* hg, int t0, int seg, int xh, int d, unsigned short (&r)[16]) {
    const unsigned short* p = (const unsigned short*)hg + ((size_t)xh * T + t0 + 16 * seg) * 128 + d;
#pragma unroll
    for (int i = 0; i < 16; ++i) r[i] = p[i * 128];
}
DEV float raw2f(unsigned short r) { return __uint_as_float((unsigned)r << 16); }
DEV void hgrn_gates(const unsigned short (&rf)[16], const float lb, int d, int seg, float* red, float (&fgv)[16], float (&b)[16], float& blast) {
    float run = 0.f;
#pragma unroll
    for (int i = 0; i < 16; ++i) {
        const float f = raw2f(rf[i]);
        const float fg = lb + (1.f - lb) * sigmoidf_(f);
        fgv[i] = fg; run += __logf(fg); b[i] = run;
    }
    red[seg * 128 + d] = run;
    __syncthreads();
    const float r0 = red[d], r1 = red[128 + d], r2 = red[256 + d], r3 = red[384 + d];
    const float pre = (seg > 0 ? r0 : 0.f) + (seg > 1 ? r1 : 0.f) + (seg > 2 ? r2 : 0.f);
    blast = r0 + r1 + r2 + r3;
#pragma unroll
    for (int i = 0; i < 16; ++i) b[i] += pre;
}
DEV void pack16_store(char* smem, unsigned a0, unsigned a1, const float (&v)[16]) {
    uint4 lo, hi;
    lo.x = pack_bf16x2(v[0], v[1]); lo.y = pack_bf16x2(v[2], v[3]); lo.z = pack_bf16x2(v[4], v[5]); lo.w = pack_bf16x2(v[6], v[7]);
    hi.x = pack_bf16x2(v[8], v[9]); hi.y = pack_bf16x2(v[10], v[11]); hi.z = pack_bf16x2(v[12], v[13]); hi.w = pack_bf16x2(v[14], v[15]);
    *(uint4*)(smem + a0) = lo; *(uint4*)(smem + a1) = hi;
}

DEV void hgrn_phase1(char* smem, const float lb, float* kcT, float* dec, int c, int h, const unsigned short (&rf)[16], const unsigned short (&ri)[16]) {
    const int tid = opaque_tid(), d = tid & 127, seg = tid >> 7;
    const int lane = tid & 63, w = tid >> 6, fr = lane & 15, fq = lane >> 4;
    float* red = (float*)(smem + 32768);
    float fgv[16], b[16], blast;
    hgrn_gates(rf, lb, d, seg, red, fgv, b, blast);
    float kd[16], vv[16];
#pragma unroll
    for (int i = 0; i < 16; ++i) {
        kd[i] = (1.f - fgv[i]) * __expf(blast - b[i]);
        vv[i] = raw2f(ri[i]);
    }
    pack16_store(smem, sw128(d, 2 * seg), sw128(d, 2 * seg + 1), kd);
    pack16_store(smem + 16384, sw128(d, 2 * seg), sw128(d, 2 * seg + 1), vv);
    if (seg == 3) dec[(size_t)(c * 4 + h) * 128 + d] = __expf(blast);
    __syncthreads();
    f32x4 acc[8];
#pragma unroll
    for (int nv = 0; nv < 8; ++nv) acc[nv] = (f32x4){0.f, 0.f, 0.f, 0.f};
#pragma unroll
    for (int ks = 0; ks < 2; ++ks) {
        const bf16x8 xf = *(const bf16x8*)(smem + sw128(16 * w + fr, ks * 4 + fq));
#pragma unroll
        for (int nv = 0; nv < 8; ++nv) {
            const bf16x8 yf = *(const bf16x8*)(smem + 16384 + sw128(16 * nv + fr, ks * 4 + fq));
            acc[nv] = __builtin_amdgcn_mfma_f32_16x16x32_bf16(xf, yf, acc[nv], 0, 0, 0);
        }
    }
    bf16_t* out = (bf16_t*)kcT + (size_t)(c * 4 + h) * 16384;
#pragma unroll
    for (int nv = 0; nv < 8; ++nv) { uint2 o; o.x = pack_bf16x2(acc[nv][0], acc[nv][1]); o.y = pack_bf16x2(acc[nv][2], acc[nv][3]); *(uint2*)(out + (16 * nv + fr) * 128 + 16 * w + 4 * fq) = o; }
    __syncthreads();
}

DEV void hgrn_phase2(const float* kcT, const float* dec, bf16_t* ST, int e) {
    const int h = e >> 14, d = e & 127;
    float S = 0.f;
    for (int c0 = 0; c0 < 256; c0 += 16) {
        float kc[16], dc[16];
#pragma unroll
        for (int i = 0; i < 16; ++i) { kc[i] = bf2f(((const bf16_t*)kcT)[(size_t)(c0 + i) * 65536 + e]); dc[i] = dec[(size_t)((c0 + i) * 4 + h) * 128 + d]; }
#pragma unroll
        for (int i = 0; i < 16; ++i) { ST[(size_t)(c0 + i) * 65536 + e] = f2bf(S); S = dc[i] * S + kc[i]; }
    }
}

DEV void hgrn_stage_S(char* smem, int o_st, const bf16_t* ST, int c, int h) {
    const int tid = opaque_tid(), w = tid >> 6;
    const bf16_t* sp = ST + (size_t)(c * 4 + h) * 16384;
    const unsigned base = (unsigned)__builtin_amdgcn_readfirstlane((int)(unsigned)(unsigned long long)(LAS char*)smem) + (unsigned)o_st + (unsigned)__builtin_amdgcn_readfirstlane(w) * 1024u;
#pragma unroll
    for (int i = 0; i < 4; ++i) { const int idx = tid + 512 * i, row = idx >> 4, ch = (idx & 15) ^ (row & 15);
        const bf16_t* g = sp + row * 128 + ch * 8; unsigned keep; const unsigned la = base + (unsigned)i * 8192u;
        asm volatile("s_mov_b32 %0, m0\n\ts_mov_b32 m0, %2\n\ts_nop 0\n\tglobal_load_lds_dwordx4 %1, off\n\ts_mov_b32 m0, %0" : "=&s"(keep) : "v"(g), "s"(la) : "memory"); }
}
DEV void hgrn_phase3(char* smem, const int O_ST, const bf16_t* proj, const float lb, const float* hw, bf16_t* ob, int c, int h, const unsigned short (&rf)[16], const unsigned short (&rq)[16], const unsigned short (&ri)[16]) {
    constexpr int O_QT = 0, O_KT = 16384, O_VT = 32768, O_AT = 81920, O_RED = 90112, O_SSQ = 92160;
    const int tid = opaque_tid(), d = tid & 127, seg = tid >> 7, t0 = c * 64;
    const int lane = tid & 63, w = tid >> 6, fr = lane & 15, fq = lane >> 4;
    {
        float fgv[16], b[16], blast;
        hgrn_gates(rf, lb, d, seg, (float*)(smem + O_RED), fgv, b, blast);
        float vv[16];
#pragma unroll
        for (int i = 0; i < 16; ++i) {
            const int t = 16 * seg + i;
            const float qv = raw2f(rq[i]);
            const float eb = __expf(b[i]);
            const float qt = siluf_(qv) * eb, kt = (1.f - fgv[i]) * __builtin_amdgcn_rcpf(eb);
            const unsigned off = sw256(t, d >> 3) + (d & 7) * 2;
            *(bf16_t*)(smem + O_QT + off) = f2bf(qt);
            *(bf16_t*)(smem + O_KT + off) = f2bf(kt);
            vv[i] = raw2f(ri[i]);
        }
        pack16_store(smem + O_VT, sw128(d, 2 * seg), sw128(d, 2 * seg + 1), vv);
    }
    __syncthreads();
    {
        const int tb = w & 3;
#pragma unroll
        for (int u = 0; u < 2; ++u) {
            const int sb = (w >> 2) * 2 + u;
            f32x4 acc = (f32x4){0.f, 0.f, 0.f, 0.f};
            if (sb <= tb) {
#pragma unroll
                for (int ks = 0; ks < 4; ++ks) {
                    const bf16x8 xf = *(const bf16x8*)(smem + O_KT + sw256(16 * sb + fr, ks * 4 + fq));
                    const bf16x8 yf = *(const bf16x8*)(smem + O_QT + sw256(16 * tb + fr, ks * 4 + fq));
                    acc = __builtin_amdgcn_mfma_f32_16x16x32_bf16(xf, yf, acc, 0, 0, 0);
                }
                const int t = 16 * tb + fr, s0 = 16 * sb + 4 * fq;
#pragma unroll
                for (int jj = 0; jj < 4; ++jj) if (s0 + jj > t) acc[jj] = 0.f;
            }
            uint2 o; o.x = pack_bf16x2(acc[0], acc[1]); o.y = pack_bf16x2(acc[2], acc[3]);
            *(uint2*)(smem + O_AT + sw128(16 * tb + fr, 2 * sb + (fq >> 1)) + 8 * (fq & 1)) = o;
        }
    }
    __syncthreads();
    const int tb = w & 3, vh = w >> 2;
    const size_t trow = (size_t)(t0 + 16 * tb + fr);
    uint2 grv[4];
#pragma unroll
    for (int n = 0; n < 4; ++n) grv[n] = *(const uint2*)(proj + ((size_t)(HX_G * 4 + h) * T + trow) * 128 + 16 * (4 * vh + n) + 4 * fq);
    f32x4 wvv[4];
#pragma unroll
    for (int n = 0; n < 4; ++n) wvv[n] = *(const f32x4*)(hw + 16 * (4 * vh + n) + 4 * fq);
    f32x4 acc[4];
#pragma unroll
    for (int n = 0; n < 4; ++n) acc[n] = (f32x4){0.f, 0.f, 0.f, 0.f};
#pragma unroll
    for (int ks = 0; ks < 2; ++ks) {
        const bf16x8 yf = *(const bf16x8*)(smem + O_AT + sw128(16 * tb + fr, ks * 4 + fq));
#pragma unroll
        for (int n = 0; n < 4; ++n) {
            const bf16x8 xf = *(const bf16x8*)(smem + O_VT + sw128(16 * (4 * vh + n) + fr, ks * 4 + fq));
            acc[n] = __builtin_amdgcn_mfma_f32_16x16x32_bf16(xf, yf, acc[n], 0, 0, 0);
        }
    }
#pragma unroll
    for (int ks = 0; ks < 4; ++ks) {
        const bf16x8 yf = *(const bf16x8*)(smem + O_QT + sw256(16 * tb + fr, ks * 4 + fq));
#pragma unroll
        for (int n = 0; n < 4; ++n) {
            const bf16x8 xf = *(const bf16x8*)(smem + O_ST + sw256(16 * (4 * vh + n) + fr, ks * 4 + fq));
            acc[n] = __builtin_amdgcn_mfma_f32_16x16x32_bf16(xf, yf, acc[n], 0, 0, 0);
        }
    }
    float ss = 0.f;
#pragma unroll
    for (int n = 0; n < 4; ++n)
#pragma unroll
        for (int jj = 0; jj < 4; ++jj) ss += acc[n][jj] * acc[n][jj];
    ss += __shfl_xor(ss, 16); ss += __shfl_xor(ss, 32);
    float* ssq = (float*)(smem + O_SSQ);
    if (fq == 0) ssq[vh * 64 + 16 * tb + fr] = ss;
    __syncthreads();
    const float tot = ssq[16 * tb + fr] + ssq[64 + 16 * tb + fr];
    const float rs = rsqrtf(tot * (1.f / 128.f) + EPS);
#pragma unroll
    for (int n = 0; n < 4; ++n) {
        const int v0 = 16 * (4 * vh + n) + 4 * fq;
        const uint2 gr = grv[n];
        const f32x4 wv = wvv[n];
        const float g0 = siluf_(__uint_as_float(gr.x << 16)), g1 = siluf_(__uint_as_float(gr.x & 0xffff0000u)), g2 = siluf_(__uint_as_float(gr.y << 16)), g3 = siluf_(__uint_as_float(gr.y & 0xffff0000u));
        uint2 o; o.x = pack_bf16x2(acc[n][0] * rs * wv[0] * g0, acc[n][1] * rs * wv[1] * g1); o.y = pack_bf16x2(acc[n][2] * rs * wv[2] * g2, acc[n][3] * rs * wv[3] * g3);
        *(uint2*)(ob + trow * 1024 + h * 128 + v0) = o;
    }
    __syncthreads();
}


constexpr int LDS_BAR_OFF = GEMM_LDS_BYTES;
constexpr int LDS_PREF_OFF = GEMM_LDS_BYTES + 256;
constexpr int LDS_CNT_OFF = LDS_PREF_OFF + 1040;
constexpr int LDS_LIST_OFF = GEMM_LDS_BYTES + 256 + 2304;
constexpr int LDS_T2E_OFF = LDS_LIST_OFF + 4096;
constexpr int LDS_TOTAL = LDS_T2E_OFF + 1536;

DEV void phase_mod(const Params& p, char* smem) {
    const int tid = opaque_tid(), ks = tid >> 3, sub = tid & 7;
    float* red = (float*)smem;
    for (int cb = blockIdx.x; cb < 256; cb += gridDim.x) {
        const int j0 = cb * 24;
        float a0 = 0.f, a1 = 0.f, a2 = 0.f;
#pragma unroll 4
        for (int i = 0; i < 16; ++i) {
            const int k = ks + 64 * i;
            const float sc = siluf_(p.c[k]);
            const float* w = p.w_ada + (size_t)k * (6 * D) + j0 + 3 * sub;
            a0 += sc * w[0]; a1 += sc * w[1]; a2 += sc * w[2];
        }
        red[ks * 24 + 3 * sub] = a0; red[ks * 24 + 3 * sub + 1] = a1; red[ks * 24 + 3 * sub + 2] = a2;
        __syncthreads();
        if (tid < 24) { float sacc = p.b_ada[j0 + tid]; for (int q = 0; q < 64; ++q) sacc += red[q * 24 + tid]; p.mod[j0 + tid] = sacc; }
        __syncthreads();
    }
}

DEV void phase_norm1(const Params& p) {
    const int tid_ = opaque_tid(), lane = tid_ & 63, gw = blockIdx.x * 8 + (tid_ >> 6), nw = gridDim.x * 8;
    float wsc[16], shv[16];
#pragma unroll
    for (int i = 0; i < 4; ++i) {
        const int c = i * 256 + lane * 4;
        const float4 w = *(const float4*)(p.npm + c), sc = *(const float4*)(p.mod + D + c), sh = *(const float4*)(p.mod + c);
        wsc[4 * i] = w.x * (1.f + sc.x); wsc[4 * i + 1] = w.y * (1.f + sc.y); wsc[4 * i + 2] = w.z * (1.f + sc.z); wsc[4 * i + 3] = w.w * (1.f + sc.w);
        shv[4 * i] = sh.x; shv[4 * i + 1] = sh.y; shv[4 * i + 2] = sh.z; shv[4 * i + 3] = sh.w;
    }
    float4 v[4];
    if (gw < T) {
#pragma unroll
        for (int i = 0; i < 4; ++i) v[i] = *(const float4*)(p.x + (size_t)gw * D + i * 256 + lane * 4);
    }
    for (int row = gw; row < T; row += nw) {
        const int nrow = row + nw < T ? row + nw : row;
        float4 vn[4];
#pragma unroll
        for (int i = 0; i < 4; ++i) vn[i] = *(const float4*)(p.x + (size_t)nrow * D + i * 256 + lane * 4);
        float ss = 0.f;
#pragma unroll
        for (int i = 0; i < 4; ++i) ss += v[i].x * v[i].x + v[i].y * v[i].y + v[i].z * v[i].z + v[i].w * v[i].w;
        ss = wave_sum(ss);
        const float rs = rsqrtf(ss * (1.f / D) + EPS);
#pragma unroll
        for (int i = 0; i < 4; ++i) {
            const int c = i * 256 + lane * 4;
            uint2 o; o.x = pack_bf16x2(v[i].x * rs * wsc[4 * i] + shv[4 * i], v[i].y * rs * wsc[4 * i + 1] + shv[4 * i + 1]);
            o.y = pack_bf16x2(v[i].z * rs * wsc[4 * i + 2] + shv[4 * i + 2], v[i].w * rs * wsc[4 * i + 3] + shv[4 * i + 3]);
            *(uint2*)(p.h1 + (size_t)row * D + c) = o;
        }
#pragma unroll
        for (int i = 0; i < 4; ++i) v[i] = vn[i];
    }
}

DEV void phase_conv(const Params& p) {
    const int gt = blockIdx.x * 512 + opaque_tid(), nt = gridDim.x * 512;
    const int c8 = (gt & 63) * 8;
    float w[3][8];
#pragma unroll
    for (int j = 0; j < 3; ++j) { const float4 w0 = *(const float4*)(p.conv_w + j * 512 + c8), w1 = *(const float4*)(p.conv_w + j * 512 + c8 + 4);
        w[j][0] = w0.x; w[j][1] = w0.y; w[j][2] = w0.z; w[j][3] = w0.w; w[j][4] = w1.x; w[j][5] = w1.y; w[j][6] = w1.z; w[j][7] = w1.w; }
    uint4 cc[3], cx[3], cb;
#define CONV_LOAD(t_, CC, CX, CB) do { _Pragma("unroll") for (int j = 0; j < 3; ++j) { const int tt = (t_) - 2 + j, tc = tt < 0 ? 0 : tt; \
        CC[j] = *(const uint4*)(p.proj + (size_t)tc * NP + OFF_CC + c8); CX[j] = *(const uint4*)(p.proj + (size_t)tc * NP + OFF_CX + c8); } \
        CB = *(const uint4*)(p.proj + (size_t)(t_) * NP + OFF_CB + c8); } while (0)
    if (gt < T * 64) CONV_LOAD(gt >> 6, cc, cx, cb);
    for (int idx = gt; idx < T * 64; idx += nt) {
        const int t = idx >> 6, tn = (idx + nt < T * 64) ? ((idx + nt) >> 6) : t;
        uint4 ccn[3], cxn[3], cbn;
        CONV_LOAD(tn, ccn, cxn, cbn);
        float acc[8];
#pragma unroll
        for (int q = 0; q < 8; ++q) acc[q] = 0.f;
#pragma unroll
        for (int j = 0; j < 3; ++j) {
            const float mk = (t - 2 + j >= 0) ? 1.f : 0.f;
            acc[0] += mk * w[j][0] * lo_bf(cc[j].x) * lo_bf(cx[j].x); acc[1] += mk * w[j][1] * hi_bf(cc[j].x) * hi_bf(cx[j].x);
            acc[2] += mk * w[j][2] * lo_bf(cc[j].y) * lo_bf(cx[j].y); acc[3] += mk * w[j][3] * hi_bf(cc[j].y) * hi_bf(cx[j].y);
            acc[4] += mk * w[j][4] * lo_bf(cc[j].z) * lo_bf(cx[j].z); acc[5] += mk * w[j][5] * hi_bf(cc[j].z) * hi_bf(cx[j].z);
            acc[6] += mk * w[j][6] * lo_bf(cc[j].w) * lo_bf(cx[j].w); acc[7] += mk * w[j][7] * hi_bf(cc[j].w) * hi_bf(cx[j].w);
        }
        uint4 o;
        o.x = pack_bf16x2(lo_bf(cb.x) * acc[0], hi_bf(cb.x) * acc[1]); o.y = pack_bf16x2(lo_bf(cb.y) * acc[2], hi_bf(cb.y) * acc[3]);
        o.z = pack_bf16x2(lo_bf(cb.z) * acc[4], hi_bf(cb.z) * acc[5]); o.w = pack_bf16x2(lo_bf(cb.w) * acc[6], hi_bf(cb.w) * acc[7]);
        *(uint4*)(p.a1 + (size_t)t * 1024 + c8) = o;
#pragma unroll
        for (int j = 0; j < 3; ++j) { cc[j] = ccn[j]; cx[j] = cxn[j]; }
        cb = cbn;
    }
#undef CONV_LOAD
}

DEV void phase_conv_rows(const Params& p, int j) {
    const int tid = opaque_tid(), c8 = (tid & 63) * 8, tb = j * 64 + (tid >> 6);
    float w[3][8];
#pragma unroll
    for (int q = 0; q < 3; ++q) { const float4 w0 = *(const float4*)(p.conv_w + q * 512 + c8), w1 = *(const float4*)(p.conv_w + q * 512 + c8 + 4);
        w[q][0] = w0.x; w[q][1] = w0.y; w[q][2] = w0.z; w[q][3] = w0.w; w[q][4] = w1.x; w[q][5] = w1.y; w[q][6] = w1.z; w[q][7] = w1.w; }
    uint4 cc[3], cx[3], cb;
#define CONV_LOAD(t_, CC, CX, CB) do { _Pragma("unroll") for (int q = 0; q < 3; ++q) { const int tt = (t_) - 2 + q, tc = tt < 0 ? 0 : tt; \
        CC[q] = *(const uint4*)(p.proj + (size_t)tc * NP + OFF_CC + c8); CX[q] = *(const uint4*)(p.proj + (size_t)tc * NP + OFF_CX + c8); } \
        CB = *(const uint4*)(p.proj + (size_t)(t_) * NP + OFF_CB + c8); } while (0)
    CONV_LOAD(tb, cc, cx, cb);
#pragma unroll 1
    for (int k = 0; k < 8; ++k) {
        const int t = tb + 8 * k, tn = k < 7 ? t + 8 : t;
        uint4 ccn[3], cxn[3], cbn;
        CONV_LOAD(tn, ccn, cxn, cbn);
        float acc[8];
#pragma unroll
        for (int q = 0; q < 8; ++q) acc[q] = 0.f;
#pragma unroll
        for (int q = 0; q < 3; ++q) {
            const float mk = (t - 2 + q >= 0) ? 1.f : 0.f;
            acc[0] += mk * w[q][0] * lo_bf(cc[q].x) * lo_bf(cx[q].x); acc[1] += mk * w[q][1] * hi_bf(cc[q].x) * hi_bf(cx[q].x);
            acc[2] += mk * w[q][2] * lo_bf(cc[q].y) * lo_bf(cx[q].y); acc[3] += mk * w[q][3] * hi_bf(cc[q].y) * hi_bf(cx[q].y);
            acc[4] += mk * w[q][4] * lo_bf(cc[q].z) * lo_bf(cx[q].z); acc[5] += mk * w[q][5] * hi_bf(cc[q].z) * hi_bf(cx[q].z);
            acc[6] += mk * w[q][6] * lo_bf(cc[q].w) * lo_bf(cx[q].w); acc[7] += mk * w[q][7] * hi_bf(cc[q].w) * hi_bf(cx[q].w);
        }
        uint4 o;
        o.x = pack_bf16x2(lo_bf(cb.x) * acc[0], hi_bf(cb.x) * acc[1]); o.y = pack_bf16x2(lo_bf(cb.y) * acc[2], hi_bf(cb.y) * acc[3]);
        o.z = pack_bf16x2(lo_bf(cb.z) * acc[4], hi_bf(cb.z) * acc[5]); o.w = pack_bf16x2(lo_bf(cb.w) * acc[6], hi_bf(cb.w) * acc[7]);
        *(uint4*)(p.a1 + (size_t)t * 1024 + c8) = o;
#pragma unroll
        for (int q = 0; q < 3; ++q) { cc[q] = ccn[q]; cx[q] = cxn[q]; }
        cb = cbn;
    }
#undef CONV_LOAD
}

DEV void phase_mid(const Params& p) {
    const int tid_ = opaque_tid(), lane = tid_ & 63, gw = blockIdx.x * 8 + (tid_ >> 6), nw = gridDim.x * 8;
    float gwm[16], wsc[16], shv[16];
#pragma unroll
    for (int i = 0; i < 4; ++i) {
        const int c = i * 256 + lane * 4;
        const float4 g1 = *(const float4*)(p.mod + 2 * D + c), w = *(const float4*)(p.npostm + c), w2 = *(const float4*)(p.npf + c), sc = *(const float4*)(p.mod + 4 * D + c), sh = *(const float4*)(p.mod + 3 * D + c);
        gwm[4 * i] = g1.x * w.x; gwm[4 * i + 1] = g1.y * w.y; gwm[4 * i + 2] = g1.z * w.z; gwm[4 * i + 3] = g1.w * w.w;
        wsc[4 * i] = w2.x * (1.f + sc.x); wsc[4 * i + 1] = w2.y * (1.f + sc.y); wsc[4 * i + 2] = w2.z * (1.f + sc.z); wsc[4 * i + 3] = w2.w * (1.f + sc.w);
        shv[4 * i] = sh.x; shv[4 * i + 1] = sh.y; shv[4 * i + 2] = sh.z; shv[4 * i + 3] = sh.w;
    }
    uint2 yr[4]; float4 xr[4];
    if (gw < T) {
#pragma unroll
        for (int i = 0; i < 4; ++i) { yr[i] = *(const uint2*)(p.y + (size_t)gw * D + i * 256 + lane * 4); xr[i] = *(const float4*)(p.x + (size_t)gw * D + i * 256 + lane * 4); }
    }
    for (int row = gw; row < T; row += nw) {
        const int nrow = row + nw < T ? row + nw : row;
        uint2 yn[4]; float4 xn[4];
#pragma unroll
        for (int i = 0; i < 4; ++i) { yn[i] = *(const uint2*)(p.y + (size_t)nrow * D + i * 256 + lane * 4); xn[i] = *(const float4*)(p.x + (size_t)nrow * D + i * 256 + lane * 4); }
        float yv[16], xv[16]; float ss = 0.f;
#pragma unroll
        for (int i = 0; i < 4; ++i) {
            yv[4 * i] = lo_bf(yr[i].x); yv[4 * i + 1] = hi_bf(yr[i].x); yv[4 * i + 2] = lo_bf(yr[i].y); yv[4 * i + 3] = hi_bf(yr[i].y);
#pragma unroll
            for (int j = 0; j < 4; ++j) ss += yv[4 * i + j] * yv[4 * i + j];
        }
        ss = wave_sum(ss);
        const float rs = rsqrtf(ss * (1.f / D) + EPS);
        float ss2 = 0.f;
#pragma unroll
        for (int i = 0; i < 4; ++i) {
            const int c = i * 256 + lane * 4;
            float4 o;
            o.x = xr[i].x + gwm[4 * i] * (yv[4 * i] * rs); o.y = xr[i].y + gwm[4 * i + 1] * (yv[4 * i + 1] * rs); o.z = xr[i].z + gwm[4 * i + 2] * (yv[4 * i + 2] * rs); o.w = xr[i].w + gwm[4 * i + 3] * (yv[4 * i + 3] * rs);
            xv[4 * i] = o.x; xv[4 * i + 1] = o.y; xv[4 * i + 2] = o.z; xv[4 * i + 3] = o.w;
            ss2 += o.x * o.x + o.y * o.y + o.z * o.z + o.w * o.w;
            { uint2 xo; xo.x = pack_bf16x2(o.x, o.y); xo.y = pack_bf16x2(o.z, o.w); *(uint2*)(p.y + (size_t)row * D + c) = xo; }
        }
        ss2 = wave_sum(ss2);
        const float rs2 = rsqrtf(ss2 * (1.f / D) + EPS);
#pragma unroll
        for (int i = 0; i < 4; ++i) {
            const int c = i * 256 + lane * 4;
            uint2 o; o.x = pack_bf16x2(xv[4 * i] * rs2 * wsc[4 * i] + shv[4 * i], xv[4 * i + 1] * rs2 * wsc[4 * i + 1] + shv[4 * i + 1]);
            o.y = pack_bf16x2(xv[4 * i + 2] * rs2 * wsc[4 * i + 2] + shv[4 * i + 2], xv[4 * i + 3] * rs2 * wsc[4 * i + 3] + shv[4 * i + 3]);
            *(uint2*)(p.h2 + (size_t)row * D + c) = o;
        }
#pragma unroll
        for (int i = 0; i < 4; ++i) { yr[i] = yn[i]; xr[i] = xn[i]; }
    }
}

template <int CTRL> DEV float dpp_f(float v) { return __builtin_bit_cast(float, __builtin_amdgcn_update_dpp(0, __builtin_bit_cast(int, v), CTRL, 0xf, 0xf, true)); }
DEV float row16_max(float v) {
    v = fmaxf(v, dpp_f<0xB1>(v)); v = fmaxf(v, dpp_f<0x4E>(v)); v = fmaxf(v, dpp_f<0x141>(v)); v = fmaxf(v, dpp_f<0x140>(v)); return v;
}
DEV float wave_max_uniform(float v) {
    v = row16_max(v);
    const float r0 = __builtin_bit_cast(float, __builtin_amdgcn_readlane(__builtin_bit_cast(int, v), 0)), r1 = __builtin_bit_cast(float, __builtin_amdgcn_readlane(__builtin_bit_cast(int, v), 16));
    const float r2 = __builtin_bit_cast(float, __builtin_amdgcn_readlane(__builtin_bit_cast(int, v), 32)), r3 = __builtin_bit_cast(float, __builtin_amdgcn_readlane(__builtin_bit_cast(int, v), 48));
    return fmaxf(fmaxf(r0, r1), fmaxf(r2, r3));
}
DEV void phase_route(const Params& p) {
    const int tid_ = opaque_tid(), lane = tid_ & 63, half = lane >> 5, hl = lane & 31, g = hl >> 2;
    const int gw = blockIdx.x * 8 + (tid_ >> 6), nw = gridDim.x * 8;
    const float4 rb0 = *(const float4*)(p.rbias + hl * 8), rb1 = *(const float4*)(p.rbias + hl * 8 + 4);
    int tok = gw * 2 + half;
    float4 l0 = make_float4(0.f, 0.f, 0.f, 0.f), l1 = l0;
    if (tok < T) { l0 = *(const float4*)(p.logits + (size_t)tok * E + hl * 8); l1 = *(const float4*)(p.logits + (size_t)tok * E + hl * 8 + 4); }
    int ppos = 0, pek = 0, pslot = -1; float pw = 0.f;
    for (; tok < T; tok += 2 * nw) {
        float s[8], v[8];
        s[0] = sigmoidf_(l0.x); s[1] = sigmoidf_(l0.y); s[2] = sigmoidf_(l0.z); s[3] = sigmoidf_(l0.w); s[4] = sigmoidf_(l1.x); s[5] = sigmoidf_(l1.y); s[6] = sigmoidf_(l1.z); s[7] = sigmoidf_(l1.w);
        const int tn = tok + 2 * nw;
        if (tn < T) { l0 = *(const float4*)(p.logits + (size_t)tn * E + hl * 8); l1 = *(const float4*)(p.logits + (size_t)tn * E + hl * 8 + 4); }
        v[0] = s[0] + rb0.x; v[1] = s[1] + rb0.y; v[2] = s[2] + rb0.z; v[3] = s[3] + rb0.w; v[4] = s[4] + rb1.x; v[5] = s[5] + rb1.y; v[6] = s[6] + rb1.z; v[7] = s[7] + rb1.w;
        float m1 = -INFINITY, m2 = -INFINITY;
#pragma unroll
        for (int j = 0; j < 8; ++j) { const float n1 = fmaxf(m1, v[j]), n2 = fmaxf(fminf(m1, v[j]), m2); m1 = n1; m2 = n2; }
#define RT_MERGE(CTRL) do { const float o1 = dpp_f<CTRL>(m1), o2 = dpp_f<CTRL>(m2); const float n1 = fmaxf(m1, o1), n2 = fmaxf(fminf(m1, o1), fmaxf(m2, o2)); m1 = n1; m2 = n2; } while (0)
        RT_MERGE(0xB1); RT_MERGE(0x4E);
#undef RT_MERGE
        const float gs = m1 + m2;
        int rank = 0;
#pragma unroll
        for (int q = 0; q < 8; ++q) { const float gj = __shfl(gs, (lane & 32) + q * 4); rank += (gj > gs || (gj == gs && q < g)) ? 1 : 0; }
        const bool gsel = rank < 4;
#pragma unroll
        for (int j = 0; j < 8; ++j) v[j] = gsel ? v[j] : -INFINITY;
        float wk = 0.f, wsum = 0.f; int ek = 0;
#pragma unroll 1
        for (int r = 0; r < TOPK; ++r) {
            float lm = fmaxf(fmaxf(fmaxf(v[0], v[1]), fmaxf(v[2], v[3])), fmaxf(fmaxf(v[4], v[5]), fmaxf(v[6], v[7])));
            float mx = row16_max(lm);
            mx = fmaxf(mx, __shfl_xor(mx, 16));
            const unsigned long long bal = __ballot(lm == mx);
            const int ownA = __builtin_ctz((unsigned)bal), ownB = 32 + __builtin_ctz((unsigned)(bal >> 32));
            const int own = half ? ownB : ownA;
            int sub = 7;
#pragma unroll
            for (int j = 6; j >= 0; --j) sub = (v[j] == mx) ? j : sub;
            float sv_l = s[7];
#pragma unroll
            for (int j = 6; j >= 0; --j) sv_l = (sub == j) ? s[j] : sv_l;
            const int osub = __shfl(sub, own);
            const float sv = __shfl(sv_l, own);
            const bool mine = lane == own;
#pragma unroll
            for (int j = 0; j < 8; ++j) v[j] = (mine && osub == j) ? -INFINITY : v[j];
            wsum += sv;
            if (hl == r) { wk = sv; ek = (own & 31) * 8 + osub; }
        }
        int pos = 0;
        if (hl < TOPK) pos = (int)atomicAdd(&p.counts[ek << 5], 1u);
        if (hl < TOPK && pslot >= 0) { p.lslot[(size_t)pek * T + ppos] = pslot; p.lw[(size_t)pek * T + ppos] = pw; }
        ppos = pos; pek = ek; pslot = tok * TOPK + hl; pw = wk / (wsum + 1e-20f) * 2.5f;
    }
    if (hl < TOPK && pslot >= 0) { p.lslot[(size_t)pek * T + ppos] = pslot; p.lw[(size_t)pek * T + ppos] = pw; }
}

DEV void phase_final(const Params& p) {
    const int tid_ = opaque_tid(), lane = tid_ & 63, gw = blockIdx.x * 8 + (tid_ >> 6), nw = gridDim.x * 8;
    float gwf[16];
#pragma unroll
    for (int i = 0; i < 4; ++i) {
        const int c = i * 256 + lane * 4;
        const float4 g2 = *(const float4*)(p.mod + 5 * D + c), w = *(const float4*)(p.npostf + c);
        gwf[4 * i] = g2.x * w.x; gwf[4 * i + 1] = g2.y * w.y; gwf[4 * i + 2] = g2.z * w.z; gwf[4 * i + 3] = g2.w * w.w;
    }
    uint2 sh[4], xr[4], ys[4][TOPK];
#define FIN_LOAD(r_, SH, XR, YS) do { _Pragma("unroll") for (int i = 0; i < 4; ++i) { const int c = i * 256 + lane * 4; SH[i] = *(const uint2*)(p.shout + (size_t)(r_) * D + c); XR[i] = *(const uint2*)(p.y + (size_t)(r_) * D + c); \
        _Pragma("unroll") for (int k = 0; k < TOPK; ++k) YS[i][k] = *(const uint2*)(p.yslot + ((size_t)(r_) * TOPK + k) * D + c); } } while (0)
    if (gw < T) FIN_LOAD(gw, sh, xr, ys);
    for (int row = gw; row < T; row += nw) {
        const int nrow = row + nw < T ? row + nw : row;
        uint2 shn[4], xrn[4], ysn[4][TOPK];
        FIN_LOAD(nrow, shn, xrn, ysn);
        float mv[16]; float ss = 0.f;
#pragma unroll
        for (int i = 0; i < 4; ++i) {
            float a0 = lo_bf(sh[i].x), a1 = hi_bf(sh[i].x), a2 = lo_bf(sh[i].y), a3 = hi_bf(sh[i].y);
#pragma unroll
            for (int k = 0; k < TOPK; ++k) { const uint2 q = ys[i][k]; a0 += lo_bf(q.x); a1 += hi_bf(q.x); a2 += lo_bf(q.y); a3 += hi_bf(q.y); }
            mv[4 * i] = a0; mv[4 * i + 1] = a1; mv[4 * i + 2] = a2; mv[4 * i + 3] = a3;
            ss += a0 * a0 + a1 * a1 + a2 * a2 + a3 * a3;
        }
        ss = wave_sum(ss);
        const float rs = rsqrtf(ss * (1.f / D) + EPS);
#pragma unroll
        for (int i = 0; i < 4; ++i) {
            const int c = i * 256 + lane * 4;
            float4 o; o.x = lo_bf(xr[i].x); o.y = hi_bf(xr[i].x); o.z = lo_bf(xr[i].y); o.w = hi_bf(xr[i].y);
            o.x += gwf[4 * i] * (mv[4 * i] * rs); o.y += gwf[4 * i + 1] * (mv[4 * i + 1] * rs); o.z += gwf[4 * i + 2] * (mv[4 * i + 2] * rs); o.w += gwf[4 * i + 3] * (mv[4 * i + 3] * rs);
            *(float4*)(p.out + (size_t)row * D + c) = o;
        }
#pragma unroll
        for (int i = 0; i < 4; ++i) { sh[i] = shn[i]; xr[i] = xrn[i];
#pragma unroll
            for (int k = 0; k < TOPK; ++k) ys[i][k] = ysn[i][k]; }
    }
#undef FIN_LOAD
}

DEV bool dense_unit(int r, int nM, int nN, int& pm, int& pn) {
    const int b = blockIdx.x, G = gridDim.x;
    if ((G & 7) == 0 && (nM & 7) == 0) {
        const int per = nM >> 3, nlb = G >> 3, li = r * nlb + (b >> 3);
        if (li >= per * nN) return false;
        pm = (b & 7) * per + li % per; pn = li / per; return true;
    }
    const int u = r * G + b; if (u >= nM * nN) return false;
    pm = u / nN; pn = u % nN; return true;
}
struct DenseSched {
    const char* A; const char* Bt; int K; int nN;
    DEV bool next(int i, g8::Unit& u) const { int pm, pn; if (!dense_unit(i, T / 256, nN, pm, pn)) return false;
        u.A = A + (size_t)pm * 256 * K * 2; u.B = Bt + (size_t)pn * 256 * K * 2; u.i0 = pm; u.i1 = pn; u.i2 = 0; u.i3 = 0; return true; }
    DEV unsigned rowoff(const g8::Unit&, int) const { return 0u; }
};
struct SubSched {
    const char* A; const char* Bt; int K; int nN; int b0;
    DEV bool next(int i, g8::Unit& u) const { const int nb = (int)gridDim.x - b0, v = i * nb + ((int)blockIdx.x - b0); if (v >= 64 * nN) return false; const int pm = v / nN, pn = v % nN;
        u.A = A + (size_t)pm * 256 * K * 2; u.B = Bt + (size_t)pn * 256 * K * 2; u.i0 = pm; u.i1 = pn; u.i2 = 0; u.i3 = 0; return true; }
    DEV unsigned rowoff(const g8::Unit&, int) const { return 0u; }
};

DEV int perm_expert(int j) { return (j & 31) * 8 + (j >> 5); }
DEV void build_pref(const Params& p, char* smem) {
    int* sp = (int*)(smem + LDS_PREF_OFF);
    const int tid = opaque_tid();
    if (tid < 256) { sp[tid + 1] = (int)((p.counts[perm_expert(tid) << 5] + 255u) >> 8); ((int*)(smem + LDS_CNT_OFF))[tid] = (int)p.counts[tid << 5]; }
    if (tid == 0) sp[0] = 0;
    __syncthreads();
    for (int off = 1; off < 256; off <<= 1) {
        int v = 0;
        if (tid < 256 && tid + 1 - off >= 1) v = sp[tid + 1 - off];
        __syncthreads();
        if (tid < 256) sp[tid + 1] += v;
        __syncthreads();
    }    if (tid < 256) { short* t2e = (short*)(smem + LDS_T2E_OFF); for (int t = sp[tid]; t < sp[tid + 1]; ++t) t2e[t] = (short)tid; }
    __syncthreads();
}
template <int NT, int K, bool BYSLOT>
struct ExpSched {
    const int* sp; const unsigned* counts; const int* lslot; const char* A; const char* Bt; size_t bt_estride;
    DEV bool next(int i, g8::Unit& u) const {
        const int G = gridDim.x, b = blockIdx.x;
        int tile, pn, lo, hi;
        if ((G & 7) == 0) { const int xl = b & 7, li = i * (G >> 3) + (b >> 3); pn = li % NT; tile = sp[32 * xl] + li / NT; if (tile >= sp[32 * xl + 32]) return false; lo = 32 * xl; hi = 32 * xl + 32; }
        else { const int li = i * G + b; pn = li % NT; tile = li / NT; if (tile >= sp[256]) return false; lo = 0; hi = 256; }
        while (hi - lo > 1) { const int mid = (lo + hi) >> 1; if (sp[mid] <= tile) lo = mid; else hi = mid; }
        const int e = perm_expert(lo);
        u.A = A; u.B = Bt + (size_t)e * bt_estride + (size_t)pn * 256 * K * 2;
        u.i0 = e; u.i1 = (tile - sp[lo]) * 256; u.i2 = (int)counts[e << 5]; u.i3 = pn; return true;
    }
    DEV unsigned rowoff(const g8::Unit& u, int row) const {
        int rr = u.i1 + row; rr = rr < u.i2 ? rr : u.i2 - 1;
        const int slot = lslot[(size_t)u.i0 * T + rr];
        return (unsigned)(BYSLOT ? slot : (slot >> 3)) * (unsigned)(K * 2);
    }
};


template <int NT, int K, bool BYSLOT, bool TILEA = false>
struct ExpSchedF {
    const int* sp; const unsigned* counts; const int* lslot; const char* A; const float* W0; const float* W1; size_t estride; int colstep; int half1;
    DEV bool next(int i, g8::UnitF& u) const {
        const int G = (int)gridDim.x, b = (int)blockIdx.x, q = (G & 7) == 0 ? (b & 7) * (G >> 3) + (b >> 3) : b;
        const int nitems = sp[256], full = nitems / G;
        int item, pn;
        if (i < full * NT) { item = (i / NT) * G + q; pn = i - (i / NT) * NT; }
        else { const int it = i * G + q; item = it / NT; pn = it - item * NT; }
        if (item >= nitems) return false;
        const int lo = __builtin_amdgcn_readfirstlane((int)((const short*)((const char*)sp + (LDS_T2E_OFF - LDS_PREF_OFF)))[item]);
        const int e = perm_expert(lo);
        u.A = TILEA ? A + (size_t)item * 256 * K * 2 : A;
        u.B0 = W0 + (size_t)e * estride + pn * colstep; u.B1 = W1 + (size_t)e * estride + pn * colstep + half1;
        u.i0 = e; u.i1 = (item - sp[lo]) * 256; u.i2 = sp[260 + e]; u.i3 = pn | (item << 4); return true;
    }
    DEV unsigned rowoff(const g8::UnitF& u, int row) const {
        int rr = u.i1 + row; rr = rr < u.i2 ? rr : u.i2 - 1;
        const int slot = lslot[(size_t)u.i0 * T + rr];
        return (unsigned)(BYSLOT ? slot : (slot >> 3)) * (unsigned)(K * 2);
    }
    const float* lwp;
    DEV const int* list0(const g8::UnitF& u) const { return lslot + (size_t)u.i0 * T + u.i1; }
    DEV const float* list1(const g8::UnitF& u) const { return lwp + (size_t)u.i0 * T + u.i1; }
};


struct PEpiStoreBf16 { bf16_t* C; int ldc; int row0; int col0;
    DEV void operator()(int r, int c, f32x4 v0, f32x4 v1) const { uint4 o; o.x = pack_bf16x2(v0[0], v0[1]); o.y = pack_bf16x2(v0[2], v0[3]); o.z = pack_bf16x2(v1[0], v1[1]); o.w = pack_bf16x2(v1[2], v1[3]);
        *(uint4*)(C + (size_t)(row0 + r) * ldc + col0 + c) = o; } };
struct PEpiProj { bf16_t* C; size_t gstride; int ldc; int row0; int wt;
    DEV void operator()(int r, int c, f32x4 v0, f32x4 v1) const { uint4 o; o.x = pack_bf16x2(v0[0], v0[1]); o.y = pack_bf16x2(v0[2], v0[3]); o.z = pack_bf16x2(v1[0], v1[1]); o.w = pack_bf16x2(v1[2], v1[3]);
        bf16_t* q = C + (size_t)(c >> 7) * gstride + (size_t)(row0 + r) * ldc + (c & 127);
        if (wt) st16_wt(q, o); else *(uint4*)q = o; } };
struct PMidRatio { const bf16_t* proj; int row0; int col0;
    DEV static float rt(float ga, float gb) { return (1.f + __expf(-gb)) * __builtin_amdgcn_rcpf(1.f + __expf(-ga)); }
    DEV void load(int r, int c, uint4& a, uint4& b) const { const size_t row = row0 + r; a = *(const uint4*)(proj + row * NP + OFF_GA + col0 + c); b = *(const uint4*)(proj + row * NP + OFF_GB + col0 + c); }
    DEV void apply(const uint4& a, const uint4& b, f32x4& v0, f32x4& v1) const {
        v0[0] *= rt(lo_bf(a.x), lo_bf(b.x)); v0[1] *= rt(hi_bf(a.x), hi_bf(b.x)); v0[2] *= rt(lo_bf(a.y), lo_bf(b.y)); v0[3] *= rt(hi_bf(a.y), hi_bf(b.y));
        v1[0] *= rt(lo_bf(a.z), lo_bf(b.z)); v1[1] *= rt(hi_bf(a.z), hi_bf(b.z)); v1[2] *= rt(lo_bf(a.w), lo_bf(b.w)); v1[3] *= rt(hi_bf(a.w), hi_bf(b.w)); } };
struct PMidMerge { static constexpr bool on = true; const bf16_t* proj;
    DEV PMidRatio make(const g8::Unit& u) const { return PMidRatio{proj, u.i0 * 256, u.i1 * 256}; } };
struct PEpiGateF { static constexpr bool pre = true; bf16_t* M; const bf16_t* proj; int row0; int col0;
    DEV void load(int r, int c, uint4& gr) const { gr = *(const uint4*)(proj + (size_t)(row0 + r) * NP + OFF_GB + col0 + c); }
    DEV void store(int r, int c, const uint4& gr, f32x4 v0, f32x4 v1) const { const size_t row = row0 + r;
        uint4 o; o.x = pack_bf16x2(sigmoidf_(lo_bf(gr.x)) * v0[0], sigmoidf_(hi_bf(gr.x)) * v0[1]); o.y = pack_bf16x2(sigmoidf_(lo_bf(gr.y)) * v0[2], sigmoidf_(hi_bf(gr.y)) * v0[3]);
        o.z = pack_bf16x2(sigmoidf_(lo_bf(gr.z)) * v1[0], sigmoidf_(hi_bf(gr.z)) * v1[1]); o.w = pack_bf16x2(sigmoidf_(lo_bf(gr.w)) * v1[2], sigmoidf_(hi_bf(gr.w)) * v1[3]);
        *(uint4*)(M + row * D + col0 + c) = o; } };
struct PEpiGateA { bf16_t* M; const bf16_t* proj; int row0; int col0;
    DEV void operator()(int r, int c, f32x4 v0, f32x4 v1) const { const size_t row = row0 + r; const uint4 gr = *(const uint4*)(proj + row * NP + OFF_GA + col0 + c);
        uint4 o; o.x = pack_bf16x2(sigmoidf_(lo_bf(gr.x)) * v0[0], sigmoidf_(hi_bf(gr.x)) * v0[1]); o.y = pack_bf16x2(sigmoidf_(lo_bf(gr.y)) * v0[2], sigmoidf_(hi_bf(gr.y)) * v0[3]);
        o.z = pack_bf16x2(sigmoidf_(lo_bf(gr.z)) * v1[0], sigmoidf_(hi_bf(gr.z)) * v1[1]); o.w = pack_bf16x2(sigmoidf_(lo_bf(gr.w)) * v1[2], sigmoidf_(hi_bf(gr.w)) * v1[3]);
        *(uint4*)(M + row * D + col0 + c) = o; } };
struct PEpiGateB { bf16_t* M; const bf16_t* proj; int row0; int col0;
    DEV void operator()(int r, int c, f32x4 v0, f32x4 v1) const { const size_t row = row0 + r; const uint4 gr = *(const uint4*)(proj + row * NP + OFF_GB + col0 + c); const uint4 mo = *(const uint4*)(M + row * D + col0 + c);
        uint4 o; o.x = pack_bf16x2(lo_bf(mo.x) + sigmoidf_(lo_bf(gr.x)) * v0[0], hi_bf(mo.x) + sigmoidf_(hi_bf(gr.x)) * v0[1]); o.y = pack_bf16x2(lo_bf(mo.y) + sigmoidf_(lo_bf(gr.y)) * v0[2], hi_bf(mo.y) + sigmoidf_(hi_bf(gr.y)) * v0[3]);
        o.z = pack_bf16x2(lo_bf(mo.z) + sigmoidf_(lo_bf(gr.z)) * v1[0], hi_bf(mo.z) + sigmoidf_(hi_bf(gr.z)) * v1[1]); o.w = pack_bf16x2(lo_bf(mo.w) + sigmoidf_(lo_bf(gr.w)) * v1[2], hi_bf(mo.w) + sigmoidf_(hi_bf(gr.w)) * v1[3]);
        *(uint4*)(M + row * D + col0 + c) = o; } };

struct HEpiSwiGLUSlot {
    bf16_t* act; const int* lslot; int base; int cnt; int r0; int col0;
    DEV void apply(const f32x4 (&acc)[2][2][4][2], int wr, int wc, int fr, int fq) const {
        int sl[2][4];
#pragma unroll
        for (int ai = 0; ai < 2; ++ai)
#pragma unroll
            for (int m = 0; m < 4; ++m) { int rr = r0 + 128 * ai + 64 * wr + 16 * m + fr; rr = rr < cnt ? rr : cnt - 1; sl[ai][m] = lslot[base + rr]; }
#pragma unroll
        for (int ai = 0; ai < 2; ++ai)
#pragma unroll
            for (int m = 0; m < 4; ++m) asm volatile("" : "+v"(sl[ai][m]));
#pragma unroll
        for (int ai = 0; ai < 2; ++ai)
#pragma unroll
            for (int m = 0; m < 4; ++m) { const int rr = r0 + 128 * ai + 64 * wr + 16 * m + fr; if (rr < cnt) {
                const f32x4 g0 = acc[ai][0][m][0], u0 = acc[ai][1][m][0], g1 = acc[ai][0][m][1], u1 = acc[ai][1][m][1];
                uint4 o; o.x = pack_bf16x2(siluf_(g0[0]) * u0[0], siluf_(g0[1]) * u0[1]); o.y = pack_bf16x2(siluf_(g0[2]) * u0[2], siluf_(g0[3]) * u0[3]);
                o.z = pack_bf16x2(siluf_(g1[0]) * u1[0], siluf_(g1[1]) * u1[1]); o.w = pack_bf16x2(siluf_(g1[2]) * u1[2], siluf_(g1[3]) * u1[3]);
                *(uint4*)(act + (size_t)sl[ai][m] * FF + col0 + 32 * wc + 8 * fq) = o; } } } };
struct HEpiSwiGLUTile {
    bf16_t* act; int rowbase; int col0;
    DEV void apply(const f32x4 (&acc)[2][2][4][2], int wr, int wc, int fr, int fq) const {
#pragma unroll
        for (int ai = 0; ai < 2; ++ai)
#pragma unroll
            for (int m = 0; m < 4; ++m) { const size_t row = (size_t)(rowbase + 128 * ai + 64 * wr + 16 * m + fr);
                const f32x4 g0 = acc[ai][0][m][0], u0 = acc[ai][1][m][0], g1 = acc[ai][0][m][1], u1 = acc[ai][1][m][1];
                uint4 o; o.x = pack_bf16x2(siluf_(g0[0]) * u0[0], siluf_(g0[1]) * u0[1]); o.y = pack_bf16x2(siluf_(g0[2]) * u0[2], siluf_(g0[3]) * u0[3]);
                o.z = pack_bf16x2(siluf_(g1[0]) * u1[0], siluf_(g1[1]) * u1[1]); o.w = pack_bf16x2(siluf_(g1[2]) * u1[2], siluf_(g1[3]) * u1[3]);
                *(uint4*)(act + row * FF + col0 + 32 * wc + 8 * fq) = o; } } };
struct HEpiSlot {
    bf16_t* yslot; int cnt; int r0; int col0;
    DEV void apply(const f32x4 (&acc)[2][2][4][2], int wr, int wc, int fr, int fq, const LAS int* lst) const {
#pragma unroll
        for (int ai = 0; ai < 2; ++ai)
#pragma unroll
            for (int m = 0; m < 4; ++m) { const int rl = 128 * ai + 64 * wr + 16 * m + fr; const int sl = lst[rl]; const float w = __int_as_float(lst[256 + rl]);
                if (r0 + rl < cnt) { bf16_t* rowp = yslot + (size_t)sl * D + col0 + 32 * wc + 8 * fq;
#pragma unroll
                for (int bj = 0; bj < 2; ++bj) { const f32x4 v0 = acc[ai][bj][m][0], v1 = acc[ai][bj][m][1];
                    uint4 o; o.x = pack_bf16x2(w * v0[0], w * v0[1]); o.y = pack_bf16x2(w * v0[2], w * v0[3]); o.z = pack_bf16x2(w * v1[0], w * v1[1]); o.w = pack_bf16x2(w * v1[2], w * v1[3]);
                    *(uint4*)(rowp + 128 * bj) = o; } } } } };

struct FEpiP9 { float* logits; bf16_t* acts; int row0; int pn;
    DEV void operator()(int r, int c, f32x4 v0, f32x4 v1) const {
        if (pn == 0) { float* q = logits + (size_t)(row0 + r) * E + c; *(f32x4*)q = v0; *(f32x4*)(q + 16) = v1; }
        else { uint2 o; o.x = pack_bf16x2(siluf_(v0[0]) * v1[0], siluf_(v0[1]) * v1[1]); o.y = pack_bf16x2(siluf_(v0[2]) * v1[2], siluf_(v0[3]) * v1[3]);
               *(uint2*)(acts + (size_t)(row0 + r) * FF + (pn - 1) * 128 + (c >> 5) * 16 + (c & 15)) = o; } } };

DEV void cvt_tile(const float* src, bf16_t* dst, int ld, int dstK, int pair, int k0, int n0, int lane) {
    const int nq = lane & 15, kq = lane >> 4;
    const float* sp_ = src + (size_t)(k0 + 8 * kq) * ld + n0 + 4 * nq;
    float4 v[8];
#pragma unroll
    for (int r = 0; r < 8; ++r) v[r] = *(const float4*)(sp_ + (size_t)r * ld);
#pragma unroll
    for (int q = 0; q < 4; ++q) {
        const int n = n0 + 4 * nq + q;
        const int c32 = n & 31;
        const int row = pair == 3 ? ((n & ~31) + ((c32 >> 2) & 1) * 16 + (c32 >> 3) * 4 + (c32 & 3)) : pair ? (((n >> 4) * 2 + (pair - 1)) * 16 + (n & 15)) : n;
        float e[8];
#pragma unroll
        for (int r = 0; r < 8; ++r) e[r] = q == 0 ? v[r].x : q == 1 ? v[r].y : q == 2 ? v[r].z : v[r].w;
        uint4 o; o.x = pack_bf16x2(e[0], e[1]); o.y = pack_bf16x2(e[2], e[3]); o.z = pack_bf16x2(e[4], e[5]); o.w = pack_bf16x2(e[6], e[7]);
        *(uint4*)(dst + (size_t)row * dstK + k0 + 8 * kq) = o;
    }
}
DEV void phase_convert(const Params& p) {
    const int tid_ = opaque_tid(), lane = tid_ & 63, gw = blockIdx.x * 8 + (tid_ >> 6), nw = gridDim.x * 8;
    constexpr int R0 = 2816, R1 = R0 + 256, R2 = R1 + 256, R3 = R2 + 512, R4 = R3 + 128, R5 = R4 + 128, R6 = R5 + 128, R7 = R6 + 128, R8 = R7 + 32768, R9 = R8 + 32768, R10 = R9 + 32768;
    for (int t = gw; t < R7; t += nw) {
        const float* src; bf16_t* dst; int K, N, pair, loc, dK = 0;
        if (t < R0) { src = p.w_in; dst = p.WinT; K = 1024; N = NIN; pair = 3; loc = t; }
        else if (t < R1) { src = p.w_conv_out; dst = p.WcoT; K = 512; N = D; pair = 3; loc = t - R0; dK = 1024; }
        else if (t < R2) { src = p.w_hgrn_out; dst = p.WcoT + 512; K = 512; N = D; pair = 3; loc = t - R1; dK = 1024; }
        else if (t < R3) { src = p.w_o; dst = p.WoT; K = 1024; N = D; pair = 3; loc = t - R2; }
        else if (t < R4) { src = p.w_router; dst = p.WrsT; K = 1024; N = E; pair = 0; loc = t - R3; }
        else if (t < R5) { src = p.wgs; dst = p.WrsT + (size_t)256 * 1024; K = 1024; N = FF; pair = 1; loc = t - R4; }
        else if (t < R6) { src = p.wus; dst = p.WrsT + (size_t)256 * 1024; K = 1024; N = FF; pair = 2; loc = t - R5; }
        else if (t < R7) { src = p.wds; dst = p.WdsT; K = 256; N = D; pair = 3; loc = t - R6; }
        else if (t < R8) { const int l = t - R7, e = l >> 7; src = p.wge + (size_t)e * D * FF; dst = p.WgeuT + (size_t)e * 512 * 1024; K = 1024; N = FF; pair = 1; loc = l & 127; }
        else if (t < R9) { const int l = t - R8, e = l >> 7; src = p.wue + (size_t)e * D * FF; dst = p.WgeuT + (size_t)e * 512 * 1024; K = 1024; N = FF; pair = 2; loc = l & 127; }
        else { const int l = t - R9, e = l >> 7; src = p.wde + (size_t)e * FF * D; dst = p.WdeT + (size_t)e * 1024 * 256; K = 256; N = D; pair = 0; loc = l & 127; }
        const int nnt = N >> 6, kt = loc / nnt, ntile = loc % nnt;
        cvt_tile(src, dst, N, dK ? dK : K, pair, kt * 32, ntile * 64, lane);
    }
}

__global__ void __launch_bounds__(512, 2) k_mega(Params p) {
    asm volatile("s_nop 0\n\ts_nop 0\n\ts_nop 0\n\ts_nop 0");
    extern __shared__ __attribute__((aligned(16))) char smem[];
    volatile LAS unsigned* st = (volatile LAS unsigned*)(smem + LDS_BAR_OFF);
    LAS unsigned char* lds = (LAS unsigned char*)smem;
    if (threadIdx.x == 0) { st[0] = 0u; st[1] = 0u; st[2] = 0u; st[3] = 0u; }
    __syncthreads();
    const XcdBarrier bar = xcd_barrier_post(p.bar, st);

    phase_mod(p, smem);
    phase_convert(p);
    xcd_barrier(bar);
    phase_norm1(p);
    xcd_barrier(bar);
    unsigned* const pub = p.counts + 8448;
    int np2 = 0;
    g8::gemm_stream<false, true>(lds, D, DenseSched{(const char*)p.h1, (const char*)p.WinT, D, NIN / 256},
        [&](const g8::Unit& u) { const int col0 = u.i1 * 256; const bool hx = col0 >= 1536 && col0 < 3584;
            if (np2 == 3 && threadIdx.x == 0) (void)xb_add(pub, 1u);
            ++np2;
            const size_t off = hx ? (size_t)T * NP + (size_t)((col0 - 1536) >> 7) * T * 128 : (size_t)(col0 < 1536 ? col0 : col0 - 2048);
            return PEpiProj{p.proj + off, hx ? (size_t)T * 128 : (size_t)128, hx ? 128 : NP, u.i0 * 256, u.i1 < 12 ? 1 : 0}; });
    asm volatile("s_waitcnt vmcnt(0)" ::: "memory");
    __syncthreads();
    if (threadIdx.x == 0) {
        if (np2 <= 3) (void)xb_add(pub, 1u);
        XB_SPIN(xb_ld(pub) < gridDim.x, p.bar);
        __builtin_amdgcn_fence(__ATOMIC_ACQUIRE, "agent");
        asm volatile("s_waitcnt vmcnt(0)" ::: "memory");
    }
    __syncthreads();
    {
        const int G = (int)gridDim.x, b = (int)blockIdx.x;
        int c0, c1, u0, u1;
        if (G == 256) { const bool shortb = (b >> 3) >= 16;
            if (shortb) { const int sidx = ((b >> 3) - 16) * 8 + (b & 7); c0 = 2 * sidx; c1 = c0 + 2; u0 = 5 * sidx; u1 = u0 + 5; }
            else { const int lidx = (b >> 3) * 8 + (b & 7); c0 = 0; c1 = 0; u0 = 640 + 3 * lidx; u1 = u0 + 3; } }
        else { const int pc = (256 + G - 1) / G, pu = (1024 + G - 1) / G; c0 = b * pc; c1 = c0 + pc; if (c1 > 256) c1 = 256; if (c0 > 256) c0 = 256; u0 = b * pu; u1 = u0 + pu; if (u1 > 1024) u1 = 1024; if (u0 > 1024) u0 = 1024; }
        for (int it = c0; it < c1; ++it) phase_conv_rows(p, it);
        const bf16_t* hg = p.proj + (size_t)T * NP;
        const int tid1 = opaque_tid(), d1 = tid1 & 127, seg1 = tid1 >> 7;
        float lb4a, lb4b, lb4c, lb4d;
        { const float* l = p.lbt + d1; lb4a = 1.f / (1.f + __expf(l[512] - l[0])); lb4b = 1.f / (1.f + __expf(l[640] - l[128])); lb4c = 1.f / (1.f + __expf(l[768] - l[256])); lb4d = 1.f / (1.f + __expf(l[896] - l[384])); }
        int u = u0; const int ue = u1;
        unsigned short rf[16], ri[16];
        if (u < ue) { hgrn_load16(hg, (u >> 2) * 64, seg1, HX_F * 4 + (u & 3), d1, rf); hgrn_load16(hg, (u >> 2) * 64, seg1, HX_I * 4 + (u & 3), d1, ri); }
        for (; u < ue; ++u) {
            const int un = u + 1 < ue ? u + 1 : u;
            unsigned short rfn[16], rin[16];
            hgrn_load16(hg, (un >> 2) * 64, seg1, HX_F * 4 + (un & 3), d1, rfn); hgrn_load16(hg, (un >> 2) * 64, seg1, HX_I * 4 + (un & 3), d1, rin);
            { const int hc = u & 3; hgrn_phase1(smem, hc == 0 ? lb4a : hc == 1 ? lb4b : hc == 2 ? lb4c : lb4d, p.kcT, p.dec, u >> 2, hc, rf, ri); }
#pragma unroll
            for (int i = 0; i < 16; ++i) { rf[i] = rfn[i]; ri[i] = rin[i]; }
        }
    }
    xcd_barrier(bar);
    {
        const int tsc = opaque_tid();
        if (tsc < 256) for (int e = blockIdx.x * 256 + tsc; e < 65536; e += gridDim.x * 256) hgrn_phase2(p.kcT, p.dec, p.ST, e);
    }
    xcd_barrier(bar);
    {
        const bf16_t* hg = p.proj + (size_t)T * NP;
        const int tid3 = opaque_tid(), d3 = tid3 & 127, seg3 = tid3 >> 7;
        float lb4a, lb4b, lb4c, lb4d;
        { const float* l = p.lbt + d3; lb4a = 1.f / (1.f + __expf(l[512] - l[0])); lb4b = 1.f / (1.f + __expf(l[640] - l[128])); lb4c = 1.f / (1.f + __expf(l[768] - l[256])); lb4d = 1.f / (1.f + __expf(l[896] - l[384])); }
        int u = blockIdx.x, par = 0;
        unsigned short rf[16], rq[16], ri[16];
        if (u < 1024) {
            hgrn_stage_S(smem, 49152, p.ST, u >> 2, u & 3);
            hgrn_load16(hg, (u >> 2) * 64, seg3, HX_F * 4 + (u & 3), d3, rf); hgrn_load16(hg, (u >> 2) * 64, seg3, HX_Q * 4 + (u & 3), d3, rq); hgrn_load16(hg, (u >> 2) * 64, seg3, HX_I * 4 + (u & 3), d3, ri);
        }
        for (; u < 1024; u += gridDim.x) {
            const int un = u + (int)gridDim.x < 1024 ? u + (int)gridDim.x : u;
            asm volatile("s_waitcnt vmcnt(4)" ::: "memory");
            unsigned short rfn[16], rqn[16], rin[16];
            hgrn_stage_S(smem, par ? 49152 : 98304, p.ST, un >> 2, un & 3);
            hgrn_load16(hg, (un >> 2) * 64, seg3, HX_F * 4 + (un & 3), d3, rfn); hgrn_load16(hg, (un >> 2) * 64, seg3, HX_Q * 4 + (un & 3), d3, rqn); hgrn_load16(hg, (un >> 2) * 64, seg3, HX_I * 4 + (un & 3), d3, rin);
            { const int hc = u & 3; hgrn_phase3(smem, par ? 98304 : 49152, hg, hc == 0 ? lb4a : hc == 1 ? lb4b : hc == 2 ? lb4c : lb4d, p.hnw, p.a1 + 512, u >> 2, hc, rf, rq, ri); }
#pragma unroll
            for (int i = 0; i < 16; ++i) { rf[i] = rfn[i]; rq[i] = rqn[i]; ri[i] = rin[i]; }
            par ^= 1;
        }
        asm volatile("s_waitcnt vmcnt(0)" ::: "memory");
        __syncthreads();
    }
    xcd_barrier(bar);
    g8::gemm_stream<false, true>(lds, 1024, DenseSched{(const char*)p.a1, (const char*)p.WcoT, 1024, D / 256},
        [&](const g8::Unit& u) { return PEpiGateF{p.m, p.proj, u.i0 * 256, u.i1 * 256}; }, PMidMerge{p.proj});
    xcd_barrier(bar);
    g8::gemm_stream<false, true>(lds, D, DenseSched{(const char*)p.m, (const char*)p.WoT, D, D / 256},
        [&](const g8::Unit& u) { return PEpiStoreBf16{p.y, D, u.i0 * 256, u.i1 * 256}; });
    xcd_barrier(bar);
    phase_mid(p);
    xcd_barrier(bar);
    g8::gemm_stream<false, false>(lds, D, DenseSched{(const char*)p.h2, (const char*)p.WrsT, D, 3},
        [&](const g8::Unit& u) { return FEpiP9{p.logits, p.acts, u.i0 * 256, u.i1}; });
    xcd_barrier(bar);
    phase_route(p);
    g8::gemm_stream<false, true>(lds, FF, DenseSched{(const char*)p.acts, (const char*)p.WdsT, FF, D / 256},
        [&](const g8::Unit& u) { return PEpiStoreBf16{p.shout, D, u.i0 * 256, u.i1 * 256}; });
    xcd_barrier(bar);
    build_pref(p, smem);
    g8::gemm_stream_fb<true, false>(lds, D, FF, ExpSchedF<2, D, false>{(const int*)(smem + LDS_PREF_OFF), p.counts, p.lslot, (const char*)p.h2, p.wge, p.wue, (size_t)D * FF, 128, 0, p.lw},
        [&](const g8::UnitF& u) { return HEpiSwiGLUTile{p.WgeuT, (u.i3 >> 4) * 256, (u.i3 & 15) * 128}; });
    xcd_barrier(bar);
    g8::gemm_stream_fb<false, true>(lds, FF, D, ExpSchedF<4, FF, true, true>{(const int*)(smem + LDS_PREF_OFF), p.counts, p.lslot, (const char*)p.WgeuT, p.wde, p.wde, (size_t)FF * D, 256, 128, p.lw},
        [&](const g8::UnitF& u) { return HEpiSlot{p.yslot, u.i2, u.i1, (u.i3 & 15) * 256}; });
    xcd_barrier(bar);
    phase_final(p);
}

extern "C" void kernel_launch(void* const* d_in, const int* in_sizes, int n_in, void* d_out, int out_size, void* d_ws, size_t ws_size, hipStream_t stream) {
    Params p; memset(&p, 0, sizeof(p));
    p.x = (const float*)d_in[0]; p.c = (const float*)d_in[1]; p.w_ada = (const float*)d_in[2]; p.b_ada = (const float*)d_in[3];
    p.npm = (const float*)d_in[4]; p.npostm = (const float*)d_in[5]; p.w_in = (const float*)d_in[6]; p.conv_w = (const float*)d_in[7];
    p.w_conv_out = (const float*)d_in[8]; p.lbt = (const float*)d_in[9]; p.hnw = (const float*)d_in[10]; p.w_hgrn_out = (const float*)d_in[11];
    p.w_o = (const float*)d_in[12]; p.npf = (const float*)d_in[13]; p.npostf = (const float*)d_in[14]; p.w_router = (const float*)d_in[15];
    p.rbias = (const float*)d_in[16]; p.wge = (const float*)d_in[17]; p.wue = (const float*)d_in[18]; p.wde = (const float*)d_in[19];
    p.wgs = (const float*)d_in[20]; p.wus = (const float*)d_in[21]; p.wds = (const float*)d_in[22];
    p.out = (float*)d_out;
    char* base = (char*)d_ws; size_t off = 0;
    auto take = [&](size_t bytes) { char* r = base + off; off += (bytes + 255) & ~(size_t)255; return r; };
    char* ctrl = take(65536);
    p.bar = (unsigned*)ctrl; p.counts = (unsigned*)(ctrl + 16384);
    p.mod = (float*)take(6 * D * 4);
    p.WinT = (bf16_t*)take((size_t)NIN * D * 2);
    p.WcoT = (bf16_t*)take((size_t)D * 512 * 2);
    p.WhoT = (bf16_t*)take((size_t)D * 512 * 2);
    p.WoT = (bf16_t*)take((size_t)D * D * 2);
    p.WrsT = (bf16_t*)take((size_t)768 * D * 2);
    p.WdsT = (bf16_t*)take((size_t)D * FF * 2);
    p.WgeuT = (bf16_t*)take((size_t)E * 512 * D * 2);
    p.WdeT = (bf16_t*)take((size_t)E * D * FF * 2);
    char* r1 = take((size_t)T * NIN * 2 + (size_t)256 * 65536 * 4 + (size_t)256 * 65536 * 2);
    p.proj = (bf16_t*)r1; p.kcT = (float*)(r1 + (size_t)T * NIN * 2); p.ST = (bf16_t*)(r1 + (size_t)T * NIN * 2 + (size_t)256 * 65536 * 4);
    p.yslot = (bf16_t*)r1;
    p.dec = (float*)take((size_t)256 * 512 * 4);
    char* r2 = take((size_t)3 * T * D * 2);
    p.h1 = (bf16_t*)r2; p.m = (bf16_t*)(r2 + (size_t)T * D * 2); p.y = (bf16_t*)(r2 + (size_t)2 * T * D * 2);
    p.act = (bf16_t*)r2;
    p.a1 = (bf16_t*)take((size_t)T * 512 * 2);
    p.ob = (bf16_t*)take((size_t)T * 512 * 2);
    p.h2 = (bf16_t*)take((size_t)T * D * 2);
    p.logits = (float*)take((size_t)T * E * 4);
    p.lslot = (int*)take((size_t)E * T * 4);
    p.lw = (float*)take((size_t)E * T * 4);
    p.acts = (bf16_t*)take((size_t)T * FF * 2);
    p.shout = (bf16_t*)take((size_t)T * D * 2);

    static int grid = 0;
    if (!grid) {
        (void)hipFuncSetAttribute((const void*)k_mega, hipFuncAttributeMaxDynamicSharedMemorySize, LDS_TOTAL);
        int dev = 0, cus = 0, per_cu = 0;
        (void)hipGetDevice(&dev);
        (void)hipDeviceGetAttribute(&cus, hipDeviceAttributeMultiprocessorCount, dev);
        (void)hipOccupancyMaxActiveBlocksPerMultiprocessor(&per_cu, (const void*)k_mega, 512, LDS_TOTAL);
        if (cus <= 0) cus = 256;
        grid = cus * (per_cu < 1 ? per_cu : 1);
        if (grid <= 0) grid = cus;
    }
    (void)hipMemsetAsync(ctrl, 0, 65536, stream);
    k_mega<<<grid, 512, LDS_TOTAL, stream>>>(p);
}
```
